# Optimizing an MI355X kernel written in HIP

```python
import math
import jax, jax.numpy as jnp
from jax import lax
import numpy as np

D_MODEL = 1024
BATCH = 8
SEQ = 4096
DEPTH = 1

GMLP_WIDTH = 1024
GMLP_GROUPS = 8
GMLP_CHUNK = 128
HEAD_DIM = 64
DILATED_PATTERNS = ((128, 1), (512, 4), (2048, 16))
HEADS_PER_GROUP = 4
N_ATTN_HEADS = HEADS_PER_GROUP * len(DILATED_PATTERNS)
ATTN_WIDTH = N_ATTN_HEADS * HEAD_DIM
ATTN_OUT_WIDTH = HEADS_PER_GROUP * HEAD_DIM
IN_PROJ_WIDTH = 2 * GMLP_WIDTH + 3 * ATTN_WIDTH + 2 * D_MODEL
N_EXPERTS = 256
TOP_K = 8
N_EXPERT_GROUPS = 8
TOPK_GROUPS = 4
EXPERT_DIM = 256
ROUTED_SCALE = 2.5
MOE_BLOCK = 128
ALPHA = (2.0 * DEPTH) ** 0.25
BETA = (8.0 * DEPTH) ** -0.25
LN_EPS = 1e-5

kernel_name = 'hybrid_gmlp_dilated_alibi_moe_deepnorm'


def alibi_slopes(n):
    def pow2_slopes(m):
        start = 2.0 ** (-8.0 / m)
        return [start ** (i + 1) for i in range(m)]
    p = 2 ** int(math.floor(math.log2(n)))
    s = pow2_slopes(p)
    if p < n:
        s = s + pow2_slopes(2 * p)[0::2][: n - p]
    s = sorted(s, reverse=True)
    return jnp.asarray(np.array(s, dtype=np.float32))


def layer_norm(x, g, b):
    xf = x.astype(jnp.float32)
    mu = xf.mean(-1, keepdims=True)
    var = jnp.square(xf - mu).mean(-1, keepdims=True)
    y = (xf - mu) * lax.rsqrt(var + LN_EPS) * g.astype(jnp.float32) + b.astype(jnp.float32)
    return y.astype(x.dtype)


def dilated_window_attention(q, k, v, slopes, window, dilation):
    B, S, H, Dh = q.shape
    blk = window // dilation
    span = blk * dilation
    L = -(-S // span) * span
    nb = L // span

    def to_blocks(t):
        t = jnp.pad(t.astype(jnp.float32), ((0, 0), (0, L - S), (0, 0), (0, 0)))
        t = t.reshape(B, L // dilation, dilation, H, Dh).transpose(0, 2, 1, 3, 4)
        return t.reshape(B, dilation, nb, blk, H, Dh)

    def with_prev(t):
        prev = jnp.pad(t[:, :, :-1], ((0, 0), (0, 0), (1, 0), (0, 0), (0, 0), (0, 0)))
        return jnp.concatenate([prev, t], axis=3)

    qb = to_blocks(q)
    kc = with_prev(to_blocks(k))
    vc = with_prev(to_blocks(v))
    s = jnp.einsum('brnqhd,brnkhd->brnhqk', qb, kc) * (Dh ** -0.5)
    qi = jnp.arange(blk)[:, None]
    ki = jnp.arange(2 * blk)[None, :]
    delta = blk + qi - ki
    band = (delta >= 0) & (delta <= blk)
    not_before_start = (jnp.arange(nb)[:, None, None] > 0) | (ki[None] >= blk)
    valid = band[None] & not_before_start
    bias = -slopes[:, None, None] * (delta * dilation).astype(jnp.float32)[None]
    s = jnp.where(valid[None, None, :, None], s + bias[None, None, None], -jnp.inf)
    m = s.max(-1, keepdims=True)
    p = jnp.exp(s - m)
    den = p.sum(-1, keepdims=True)
    o = jnp.einsum('brnhqk,brnkhd->brnqhd', p, vc) / den.transpose(0, 1, 2, 4, 3, 5)
    lse = (m + jnp.log(den)).transpose(0, 1, 2, 4, 3, 5)

    def from_blocks(t):
        c = t.shape[-1]
        t = t.reshape(B, dilation, L // dilation, H, c).transpose(0, 2, 1, 3, 4)
        return t.reshape(B, L, H, c)[:, :S]

    return from_blocks(o), from_blocks(lse)[..., 0]


def hybrid_mixer(x, in_w, in_b, gmlp_norm_g, gmlp_norm_b, spatial_w, spatial_b,
                 proj_a_w, proj_b_w, out_w):
    B, S, D = x.shape
    h = x @ in_w + in_b
    cuts = [GMLP_WIDTH, 2 * GMLP_WIDTH, 2 * GMLP_WIDTH + ATTN_WIDTH,
            2 * GMLP_WIDTH + 2 * ATTN_WIDTH, 2 * GMLP_WIDTH + 3 * ATTN_WIDTH,
            2 * GMLP_WIDTH + 3 * ATTN_WIDTH + D_MODEL]
    u, v, q, k, vv, gate_a, gate_b = jnp.split(h, cuts, axis=-1)

    u = jax.nn.gelu(u, approximate=False)
    v = layer_norm(jax.nn.gelu(v, approximate=False), gmlp_norm_g, gmlp_norm_b)
    vc = v.reshape(B, S // GMLP_CHUNK, GMLP_CHUNK, GMLP_GROUPS, GMLP_WIDTH // GMLP_GROUPS)
    causal = jnp.tril(jnp.ones((GMLP_CHUNK, GMLP_CHUNK), dtype=bool))
    ws = jnp.where(causal[None], spatial_w, 0.0)
    vmix = jnp.einsum('gts,bnsgc->bntgc', ws, vc) + spatial_b.T[None, None, :, :, None]
    y_a = (u * vmix.reshape(B, S, GMLP_WIDTH)) @ proj_a_w

    q = q.reshape(B, S, N_ATTN_HEADS, HEAD_DIM)
    k = k.reshape(B, S, N_ATTN_HEADS, HEAD_DIM)
    vv = vv.reshape(B, S, N_ATTN_HEADS, HEAD_DIM)
    slopes = alibi_slopes(N_ATTN_HEADS)
    outs, lses = [], []
    for g, (window, dilation) in enumerate(DILATED_PATTERNS):
        sl = slice(g * HEADS_PER_GROUP, (g + 1) * HEADS_PER_GROUP)
        o, lse = dilated_window_attention(q[:, :, sl], k[:, :, sl], vv[:, :, sl],
                                          slopes[sl], window, dilation)
        outs.append(o)
        lses.append(lse)
    w_pat = jax.nn.softmax(jnp.stack(lses, axis=0), axis=0)
    y_b = jnp.sum(w_pat[..., None] * jnp.stack(outs, axis=0), axis=0)
    y_b = y_b.reshape(B, S, ATTN_OUT_WIDTH).astype(x.dtype) @ proj_b_w

    merged = jax.nn.sigmoid(gate_a) * y_a + jax.nn.sigmoid(gate_b) * y_b
    return merged @ out_w


def moe_ffn(x, router_w, router_bias, w_gate, w_up, w_down, sw_gate, sw_up, sw_down):
    B, S, D = x.shape
    T = B * S
    xf = x.reshape(T, D)
    scores = jax.nn.sigmoid(xf.astype(jnp.float32) @ router_w.astype(jnp.float32))
    biased = scores + router_bias.astype(jnp.float32)
    grp = biased.reshape(T, N_EXPERT_GROUPS, N_EXPERTS // N_EXPERT_GROUPS)
    grp_score = lax.top_k(grp, 2)[0].sum(-1)
    _, top_grp = lax.top_k(grp_score, TOPK_GROUPS)
    grp_mask = jax.nn.one_hot(top_grp, N_EXPERT_GROUPS, dtype=jnp.float32).sum(1) > 0
    expert_mask = jnp.repeat(grp_mask, N_EXPERTS // N_EXPERT_GROUPS, axis=1)
    _, top_e = lax.top_k(jnp.where(expert_mask, biased, -jnp.inf), TOP_K)
    gate = jnp.take_along_axis(scores, top_e, axis=1)
    gate = gate / gate.sum(-1, keepdims=True) * ROUTED_SCALE

    A = T * TOP_K
    n_blocks = (A + N_EXPERTS * (MOE_BLOCK - 1) + MOE_BLOCK - 1) // MOE_BLOCK
    rows = n_blocks * MOE_BLOCK
    e_flat = top_e.reshape(A).astype(jnp.int32)
    g_flat = gate.reshape(A)
    t_flat = jnp.arange(A, dtype=jnp.int32) // TOP_K
    order = jnp.argsort(e_flat)
    e_sorted = e_flat[order]
    counts = jnp.bincount(e_flat, length=N_EXPERTS).astype(jnp.int32)
    padded = (counts + MOE_BLOCK - 1) // MOE_BLOCK * MOE_BLOCK
    start = jnp.cumsum(counts) - counts
    pend = jnp.cumsum(padded)
    pstart = pend - padded
    dest = pstart[e_sorted] + jnp.arange(A, dtype=jnp.int32) - start[e_sorted]
    row_tok = jnp.zeros((rows,), jnp.int32).at[dest].set(t_flat[order])
    row_gate = jnp.zeros((rows,), jnp.float32).at[dest].set(g_flat[order])
    block_e = jnp.minimum(
        jnp.searchsorted(pend, jnp.arange(n_blocks, dtype=jnp.int32) * MOE_BLOCK, side='right'),
        N_EXPERTS - 1)

    def expert_block(args):
        tok, g, e = args
        xb = xf[tok]
        hb = jax.nn.silu(xb @ w_gate[e]) * (xb @ w_up[e])
        return (hb @ w_down[e]).astype(jnp.float32) * g[:, None]

    y_rows = lax.map(expert_block, (row_tok.reshape(n_blocks, MOE_BLOCK),
                                    row_gate.reshape(n_blocks, MOE_BLOCK), block_e))
    routed = jax.ops.segment_sum(y_rows.reshape(rows, D), row_tok, num_segments=T)
    shared = (jax.nn.silu(xf @ sw_gate) * (xf @ sw_up)) @ sw_down
    return (routed.astype(x.dtype) + shared).reshape(B, S, D)


def setup_inputs(seed: int = 0) -> dict:
    key = jax.random.key(seed)
    ks = jax.random.split(key, 24)
    f32 = jnp.float32

    def nrm(k, shape, scale):
        return jax.random.normal(k, shape, f32) * scale

    L = DEPTH
    return {
        'x': nrm(ks[0], (BATCH, SEQ, D_MODEL), 1.0),
        'in_w': nrm(ks[1], (L, D_MODEL, IN_PROJ_WIDTH), D_MODEL ** -0.5),
        'in_b': nrm(ks[2], (L, IN_PROJ_WIDTH), 0.01),
        'gmlp_norm_g': 1.0 + nrm(ks[3], (L, GMLP_WIDTH), 0.01),
        'gmlp_norm_b': nrm(ks[4], (L, GMLP_WIDTH), 0.01),
        'spatial_w': nrm(ks[5], (L, GMLP_GROUPS, GMLP_CHUNK, GMLP_CHUNK), GMLP_CHUNK ** -0.5),
        'spatial_b': 1.0 + nrm(ks[6], (L, GMLP_GROUPS, GMLP_CHUNK), 0.01),
        'proj_a_w': nrm(ks[7], (L, GMLP_WIDTH, D_MODEL), GMLP_WIDTH ** -0.5),
        'proj_b_w': nrm(ks[8], (L, ATTN_OUT_WIDTH, D_MODEL), ATTN_OUT_WIDTH ** -0.5),
        'out_w': nrm(ks[9], (L, D_MODEL, D_MODEL), D_MODEL ** -0.5 * BETA),
        'ln1_g': 1.0 + nrm(ks[10], (L, D_MODEL), 0.01),
        'ln1_b': nrm(ks[11], (L, D_MODEL), 0.01),
        'router_w': nrm(ks[12], (L, D_MODEL, N_EXPERTS), D_MODEL ** -0.5),
        'router_bias': nrm(ks[13], (L, N_EXPERTS), 0.01),
        'expert_w_gate': nrm(ks[14], (L, N_EXPERTS, D_MODEL, EXPERT_DIM), D_MODEL ** -0.5),
        'expert_w_up': nrm(ks[15], (L, N_EXPERTS, D_MODEL, EXPERT_DIM), D_MODEL ** -0.5),
        'expert_w_down': nrm(ks[16], (L, N_EXPERTS, EXPERT_DIM, D_MODEL), EXPERT_DIM ** -0.5 * BETA),
        'shared_w_gate': nrm(ks[17], (L, D_MODEL, EXPERT_DIM), D_MODEL ** -0.5),
        'shared_w_up': nrm(ks[18], (L, D_MODEL, EXPERT_DIM), D_MODEL ** -0.5),
        'shared_w_down': nrm(ks[19], (L, EXPERT_DIM, D_MODEL), EXPERT_DIM ** -0.5 * BETA),
        'ln2_g': 1.0 + nrm(ks[20], (L, D_MODEL), 0.01),
        'ln2_b': nrm(ks[21], (L, D_MODEL), 0.01),
    }


def reference(x, in_w, in_b, gmlp_norm_g, gmlp_norm_b, spatial_w, spatial_b, proj_a_w,
              proj_b_w, out_w, ln1_g, ln1_b, router_w, router_bias, expert_w_gate,
              expert_w_up, expert_w_down, shared_w_gate, shared_w_up, shared_w_down,
              ln2_g, ln2_b):
    for l in range(DEPTH):
        mix = hybrid_mixer(x, in_w[l], in_b[l], gmlp_norm_g[l], gmlp_norm_b[l], spatial_w[l],
                           spatial_b[l], proj_a_w[l], proj_b_w[l], out_w[l])
        x = layer_norm(ALPHA * x + mix, ln1_g[l], ln1_b[l])
        ffn = moe_ffn(x, router_w[l], router_bias[l], expert_w_gate[l], expert_w_up[l],
                      expert_w_down[l], shared_w_gate[l], shared_w_up[l], shared_w_down[l])
        x = layer_norm(ALPHA * x + ffn, ln2_g[l], ln2_b[l])
    return x
```

```cpp
#include <hip/hip_runtime.h>
#include <cstdio>
#include <cstdint>
#include <cmath>

#ifndef USE_FAST_ATTN
#define USE_FAST_ATTN 1
#endif
#ifndef CONV_IN_ATTN
#define CONV_IN_ATTN 1
#endif
#ifndef ATTN_WAVES
#define ATTN_WAVES 5
#endif
#ifndef MK_N_LAUNCHES
#define MK_N_LAUNCHES 1
#endif

#ifndef USE_BF16
#define USE_BF16 1
#endif
#if USE_BF16
typedef __bf16 h16;
typedef __bf16 f16x8 __attribute__((ext_vector_type(8)));
typedef __bf16 f16x4 __attribute__((ext_vector_type(4)));
typedef __bf16 f16x2 __attribute__((ext_vector_type(2)));
#define MFMA16(a, b, c) __builtin_amdgcn_mfma_f32_16x16x32_bf16(a, b, c, 0, 0, 0)
#define MFMA32(a, b, c) __builtin_amdgcn_mfma_f32_32x32x16_bf16(a, b, c, 0, 0, 0)
#else
typedef _Float16 h16;
typedef _Float16 f16x8 __attribute__((ext_vector_type(8)));
typedef _Float16 f16x4 __attribute__((ext_vector_type(4)));
typedef _Float16 f16x2 __attribute__((ext_vector_type(2)));
#define MFMA16(a, b, c) MFMA16(a, b, c)
#define MFMA32(a, b, c) MFMA32(a, b, c)
#endif
typedef float f32x4 __attribute__((ext_vector_type(4)));
typedef float f32x2 __attribute__((ext_vector_type(2)));
typedef unsigned u32x4 __attribute__((ext_vector_type(4)));
typedef unsigned u32x2 __attribute__((ext_vector_type(2)));
#define LAS __attribute__((address_space(3)))

constexpr int T = 32768, DM = 1024, NIN = 6400, SEQ = 4096;
constexpr int NEXP = 256, TOPK = 8, EDIM = 256, NASG = T * TOPK;
constexpr int MAXTILES = 1408, MAXROWS = MAXTILES * 256;
constexpr int C_U = 0, C_V = 1024, C_Q = 2048, C_K = 2816, C_VV = 3584, C_GA = 4352, C_GB = 5376;
constexpr float ALPHA = 1.189207115002721f;
constexpr float LN_EPS = 1e-5f;
constexpr float ROUTED_SCALE = 2.5f;
constexpr int NWAVES = 8, NTHREADS = 512;
constexpr int LDS_BYTES = 147456;

constexpr size_t MiB = 1u << 20;
constexpr size_t WS_CTL = 0, CTL_ZERO_BYTES = 1 * MiB;
constexpr size_t WS_WIN = 1 * MiB;
constexpr size_t WS_WA = 14 * MiB;
constexpr size_t WS_WO = 16 * MiB;
constexpr size_t WS_WB = 18 * MiB;
constexpr size_t WS_WR = 19 * MiB;
constexpr size_t WS_WC = 19 * MiB + 512 * 1024;
constexpr size_t WS_ASGE = 20 * MiB;
constexpr size_t WS_ASGP = 21 * MiB;
constexpr size_t WS_GATE = 22 * MiB;
constexpr size_t WS_ROWTOK = 23 * MiB;
constexpr size_t WS_ROWDST = 24 * MiB + 512 * 1024;
constexpr size_t WS_TILEE = 26 * MiB;
constexpr size_t WS_W2T = 27 * MiB;
constexpr size_t WS_X16 = 156 * MiB;
constexpr size_t WS_X1 = WS_X16;
constexpr size_t WS_YB = 220 * MiB;
constexpr size_t WS_Z = 236 * MiB;
constexpr size_t WS_LOGIT = 236 * MiB;
constexpr size_t WS_MERGED = 300 * MiB;
constexpr size_t WS_W1T = 364 * MiB;
constexpr size_t WS_H = 621 * MiB;
constexpr size_t WS_HID = 848 * MiB;
constexpr size_t WS_Y = 220 * MiB;
constexpr size_t WS_AO = 300 * MiB;
constexpr size_t WS_LSE = 1021 * MiB;
constexpr size_t WS_XBUF = 621 * MiB;
constexpr size_t WS_END = 1024 * MiB;
static_assert(WS_H + (size_t)T * NIN * 2 <= WS_END && WS_HID + (size_t)MAXROWS * 256 * 2 <= WS_END && WS_Y + (size_t)(NASG + T) * 1024 * 2 <= WS_HID, "ws map");
static_assert(WS_W1T + (size_t)257 * 512 * 1024 * 2 <= WS_H && WS_W2T + (size_t)257 * 1024 * 256 * 2 <= WS_X16, "ws map 2");
constexpr int CW_NT = 8;
constexpr int CW_CNT = 64;
constexpr int CW_BAR = 4096;
constexpr int CW_CONVQ = 1024;
constexpr int CW_PANEL = 16384;

__device__ __forceinline__ f16x8 pack8(f32x4 a, f32x4 b) {
    f16x8 r;
    r[0] = (h16)a[0]; r[1] = (h16)a[1]; r[2] = (h16)a[2]; r[3] = (h16)a[3];
    r[4] = (h16)b[0]; r[5] = (h16)b[1]; r[6] = (h16)b[2]; r[7] = (h16)b[3];
    return r;
}
__device__ __forceinline__ float sigmoidf_(float x) { return __builtin_amdgcn_rcpf(1.0f + __builtin_amdgcn_exp2f(x * -1.4426950408889634f)); }
__device__ __forceinline__ float gelu_erf(float x) { return 0.5f * x * (1.0f + erff(x * 0.7071067811865476f)); }
__device__ __forceinline__ f32x2 gelu_pk(f32x2 v) {
    const f32x2 av = __builtin_elementwise_abs(v), d = av * 0.2316418882f + 1.0f;
    f32x2 t; t.x = __builtin_amdgcn_rcpf(d.x); t.y = __builtin_amdgcn_rcpf(d.y);
    f32x2 q = t * 0.5307027145f + (-0.7265760135f); q = q * t + 0.7107068705f; q = q * t + (-0.142248368f); q = q * t + 0.127414796f; q = q * t;
    const f32x2 s = (v * v) * (-0.72134752044f);
    f32x2 e; e.x = __builtin_amdgcn_exp2f(s.x); e.y = __builtin_amdgcn_exp2f(s.y);
    const f32x2 m = v * (q * e), r = v - m;
    f32x2 o; o.x = v.x < 0.f ? m.x : r.x; o.y = v.y < 0.f ? m.y : r.y; return o;
}
__device__ __forceinline__ float wave_sum(float v) {
#pragma unroll
    for (int o = 1; o < 64; o <<= 1) v += __shfl_xor(v, o);
    return v;
}
__device__ __forceinline__ float wave_max(float v) {
#pragma unroll
    for (int o = 1; o < 64; o <<= 1) v = fmaxf(v, __shfl_xor(v, o));
    return v;
}

#define XB_TMO      128
#define XB_XCNT(j)  (256  + 64 * (j))
#define XB_XSUB(j)  (1280 + 64 * (j))
#define XB_XGEN(j)  (2304 + 64 * (j))
#define XB_TOP      3328
#define XB_TOPGEN   3392
#define XCD_BAR_WORDS 3456
#define XB_SPIN_CAP (1u << 22)
__device__ __forceinline__ unsigned xb_ld(unsigned* p)              { return __hip_atomic_load(p, __ATOMIC_RELAXED, __HIP_MEMORY_SCOPE_AGENT); }
__device__ __forceinline__ unsigned xb_add(unsigned* p, unsigned v) { return __hip_atomic_fetch_add(p, v, __ATOMIC_RELAXED, __HIP_MEMORY_SCOPE_AGENT); }
__device__ __forceinline__ unsigned xb_xcc_id() { return (unsigned)__builtin_amdgcn_s_getreg((3 << 11) | 20) & 0xFu; }
#define XB_SPIN(cond, bar) do { unsigned _sp = 0; while (cond) { __builtin_amdgcn_s_sleep(1); \
    if ((++_sp & 255u) == 0u) { if (xb_ld(&(bar)[XB_TMO])) break; if (_sp > XB_SPIN_CAP) { atomicAdd(&(bar)[XB_TMO], 1u); break; } } } } while (0)
struct XcdBarrier { unsigned* bar; unsigned x; volatile LAS unsigned* st; };
__device__ __forceinline__ XcdBarrier xcd_barrier_post(unsigned* bar, volatile LAS unsigned* st) {
    XcdBarrier b; b.bar = bar; b.x = xb_xcc_id(); b.st = st;
    if (threadIdx.x == 0) (void)xb_add(&bar[XB_XCNT(b.x)], 1u);
    return b;
}
__device__ __forceinline__ void xcd_barrier_complete(unsigned* bar, unsigned x, unsigned& nloc, unsigned& nx) {
    const unsigned G = gridDim.x * gridDim.y * gridDim.z;
    unsigned sum, cnt, mine, sp = 0u;
    for (;;) {
        sum = 0u; cnt = 0u; mine = 0u;
#pragma unroll
        for (unsigned j = 0; j < 16; ++j) { const unsigned c = xb_ld(&bar[XB_XCNT(j)]); sum += c; cnt += (c > 0u) ? 1u : 0u; mine = (j == x) ? c : mine; }
        if (sum == G) break;
        __builtin_amdgcn_s_sleep(1);
        if ((++sp & 255u) == 0u) { if (xb_ld(&bar[XB_TMO])) break; if (sp > XB_SPIN_CAP) { atomicAdd(&bar[XB_TMO], 1u); break; } }
    }
    nloc = mine > 0u ? mine : 1u; nx = cnt > 0u ? cnt : 1u;
}
__device__ __forceinline__ void xcd_barrier(const XcdBarrier& b) {
    asm volatile("s_waitcnt vmcnt(0)" ::: "memory");
    __syncthreads();
    if (threadIdx.x == 0) {
        unsigned* bar = b.bar;
        __builtin_amdgcn_s_waitcnt(0);
        unsigned nloc = b.st[0], nx = b.st[1];
        if (nloc == 0u) { xcd_barrier_complete(bar, b.x, nloc, nx); b.st[0] = nloc; b.st[1] = nx; }
        const unsigned old = xb_add(&bar[XB_XSUB(b.x)], 1u);
        const unsigned gen = old / nloc;
        if (old + 1u == (gen + 1u) * nloc) {
            __builtin_amdgcn_fence(__ATOMIC_RELEASE, "agent");
            asm volatile("s_waitcnt vmcnt(0)" ::: "memory");
            const unsigned og = xb_add(&bar[XB_TOP], 1u);
            const unsigned tg = og / nx;
            if (og + 1u == (tg + 1u) * nx) xb_add(&bar[XB_TOPGEN], 1u);
            else XB_SPIN(xb_ld(&bar[XB_TOPGEN]) == tg, bar);
            __builtin_amdgcn_fence(__ATOMIC_ACQUIRE, "agent");
            xb_add(&bar[XB_XGEN(b.x)], 1u);
            asm volatile("s_waitcnt vmcnt(0)" ::: "memory");
        } else {
            XB_SPIN(xb_ld(&bar[XB_XGEN(b.x)]) == gen, bar);
            __builtin_amdgcn_fence(__ATOMIC_ACQUIRE, "agent");
            asm volatile("s_waitcnt vmcnt(0)" ::: "memory");
        }
    }
    __syncthreads();
}

struct Args { const float* in[22]; float* out; unsigned char* ws; int ph_lo, ph_hi; };
struct Frame {
    unsigned char* lds;
    unsigned* ctl;
    int tid, lane, wave, G, bid;
    const float *x, *in_w, *in_b, *gn_g, *gn_b, *sp_w, *sp_b, *pa_w, *pb_w, *out_w, *ln1_g, *ln1_b, *r_w, *r_b, *e_wg, *e_wu, *e_wd, *s_wg, *s_wu, *s_wd, *ln2_g, *ln2_b;
    float* out;
    h16 *WinT, *WaT, *WoT, *WbT, *WrT, *W1t, *W2t, *x16, *x1, *yb, *z, *merged, *h, *hid;
    unsigned char* y;
    float *logit, *gate, *lse;
    h16* ao; h16* Wc;
    int *asg_e, *asg_pos, *row_tok, *row_dst, *tile_e;
};

struct Unit { int pm, pn; };
template <class Prob, class Epi>
__device__ __forceinline__ void gemm_simple(const Prob& P, const Epi& E) {
    const int tid = threadIdx.x, wid = tid >> 6, lane = tid & 63, wr = wid >> 2, wc = wid & 3, fr = lane & 15, fq = lane >> 4;
    const int K = P.K;
    Unit u;
    for (int i = 0; P.next(i, u); ++i) {
        f32x4 acc[2][2][4][2];
#pragma unroll
        for (int a = 0; a < 2; ++a)
#pragma unroll
            for (int b = 0; b < 2; ++b)
#pragma unroll
                for (int m = 0; m < 4; ++m)
#pragma unroll
                    for (int n = 0; n < 2; ++n) acc[a][b][m][n] = (f32x4){0.f, 0.f, 0.f, 0.f};
        int ao[2][4];
#pragma unroll
        for (int ai = 0; ai < 2; ++ai)
#pragma unroll
            for (int m = 0; m < 4; ++m) ao[ai][m] = P.aoff(u, 128 * ai + 64 * wr + 16 * m + fr) + 8 * fq;
        const h16* ab = P.abase();
        const h16* bt = P.bt(u) + (size_t)(Epi::ADJ ? (64 * wc + 16 * (fr >> 2) + (fr & 3)) : (32 * wc + 8 * (fr >> 2) + (fr & 3))) * K + 8 * fq;
        for (int k0 = 0; k0 < K; k0 += 32) {
            f16x8 af[2][4], wf[2][2];
#pragma unroll
            for (int ai = 0; ai < 2; ++ai)
#pragma unroll
                for (int m = 0; m < 4; ++m) af[ai][m] = *(const f16x8*)(ab + ao[ai][m] + k0);
#pragma unroll
            for (int bj = 0; bj < 2; ++bj)
#pragma unroll
                for (int n = 0; n < 2; ++n) wf[bj][n] = *(const f16x8*)(bt + (size_t)((Epi::ADJ ? 8 : 128) * bj + 4 * n) * K + k0);
#pragma unroll
            for (int ai = 0; ai < 2; ++ai)
#pragma unroll
                for (int bj = 0; bj < 2; ++bj)
#pragma unroll
                    for (int m = 0; m < 4; ++m)
#pragma unroll
                        for (int n = 0; n < 2; ++n)
                            acc[ai][bj][m][n] = MFMA16(wf[bj][n], af[ai][m], acc[ai][bj][m][n]);
        }
        if constexpr (!Epi::AFTER_DRAIN) E(acc, u, wr, wc, fr, fq);
    }
}

namespace fg {
constexpr int BK = 64, HALF = 128, HTB = HALF * BK * 2, STAGE_BYTES = 8 * HTB;
__device__ __forceinline__ int lds_byte(int r, int c) { const int st = (r >> 4) * 2 + (c >> 5), rr = r & 15, cc = c & 31, ob = rr * 64 + cc * 2; return st * 1024 + (ob ^ (((ob >> 9) & 1) << 5)); }
__device__ __forceinline__ void stage_rc(int b, int& R, int& C) { const int st = b / 1024, sb = b % 1024, swz = sb ^ (((sb >> 9) & 1) << 5); R = (st >> 1) * 16 + swz / 64; C = (st & 1) * 32 + (swz % 64) / 2; }
__device__ __forceinline__ int perm32(int rho) { const int n = rho >> 4, i = rho & 15; return 8 * (i >> 2) + 4 * n + (i & 3); }

template <class Prob, class Epi>
__device__ __forceinline__ void gemm_fast(LAS unsigned char* lds, const Prob& P, const Epi& E) {
    const int tid = threadIdx.x, wid = __builtin_amdgcn_readfirstlane(tid >> 6), lane = tid & 63, wr = wid >> 2, wc = wid & 3, fr = lane & 15, fq = lane >> 4;
    const int K = P.K, nt = K / BK;
    unsigned voffB[2];
#pragma unroll
    for (int i = 0; i < 2; ++i) { int R, C; stage_rc(tid * 16 + i * 8192, R, C);
        const int Rb = Epi::ADJ ? (64 * (R >> 5) + 16 * ((R & 15) >> 2) + 4 * ((R >> 4) & 1) + (R & 3)) : ((R & ~31) + perm32(R & 31));
        voffB[i] = (unsigned)(Rb * K + C) * 2u; }
    const size_t kstep = (size_t)(BK * 2);
    const size_t hstep = (size_t)(Epi::ADJ ? 8 : HALF) * K * 2;
    const unsigned ldsw = (unsigned)wid * 1024u;
    const int aoff = lds_byte(wr * 64 + fr, fq * 8), boff = lds_byte(wc * 32 + fr, fq * 8);
#define FG_SA(b, h) (((b) * 2 + (h)) * HTB)
#define FG_SB(b, h) ((4 + (b) * 2 + (h)) * HTB)
#define FG_STAGEB(bufoff, gbase) do { _Pragma("unroll") for (int _i = 0; _i < 2; ++_i) \
        __builtin_amdgcn_global_load_lds((const unsigned*)((const char*)(gbase) + voffB[_i]), (LAS unsigned*)(lds + (bufoff) + ldsw + _i * 8192), 16, 0, 0); } while (0)
#define FG_STAGEA(bufoff, gbase, vo, h) do { _Pragma("unroll") for (int _i = 0; _i < 2; ++_i) \
        __builtin_amdgcn_global_load_lds((const unsigned*)((const char*)(gbase) + (vo)[h][_i]), (LAS unsigned*)(lds + (bufoff) + ldsw + _i * 8192), 16, 0, 0); } while (0)
#define FG_LDA(dst, b, h) do { _Pragma("unroll") for (int m = 0; m < 4; ++m) _Pragma("unroll") for (int k = 0; k < 2; ++k) dst[m][k] = *(const LAS f16x8*)(lds + FG_SA(b, h) + aoff + m * 2048 + k * 1024); } while (0)
#define FG_LDB(dst, b, h) do { _Pragma("unroll") for (int n = 0; n < 2; ++n) _Pragma("unroll") for (int k = 0; k < 2; ++k) dst[n][k] = *(const LAS f16x8*)(lds + FG_SB(b, h) + boff + n * 2048 + k * 1024); } while (0)
#define FG_MMA(ai, bj, At, Bt) do { __builtin_amdgcn_s_setprio(1); _Pragma("unroll") for (int m = 0; m < 4; ++m) _Pragma("unroll") for (int n = 0; n < 2; ++n) _Pragma("unroll") for (int k = 0; k < 2; ++k) \
        acc[ai][bj][m][n] = MFMA16(Bt[n][k], At[m][k], acc[ai][bj][m][n]); __builtin_amdgcn_s_setprio(0); } while (0)
#define FG_WAIT_V(n) asm volatile("s_waitcnt vmcnt(" #n ")" ::: "memory")
#define FG_WAIT_L(n) asm volatile("s_waitcnt lgkmcnt(" #n ")" ::: "memory")
#define FG_BAR __builtin_amdgcn_s_barrier()
#define FG_SCHED __builtin_amdgcn_sched_barrier(0)
#define FG_VOFF(dst, u) do { _Pragma("unroll") for (int _i = 0; _i < 2; ++_i) { int _R, _C; stage_rc(tid * 16 + _i * 8192, _R, _C); _Pragma("unroll") for (int _h = 0; _h < 2; ++_h) dst[_h][_i] = (unsigned)(P.aoff(u, 128 * _h + _R) + _C) * 2u; } } while (0)
    Unit cur, nxt; int ui = 0;
    if (!P.next(0, cur)) return;
    f32x4 acc[2][2][4][2];
#pragma unroll
    for (int a = 0; a < 2; ++a)
#pragma unroll
        for (int b = 0; b < 2; ++b)
#pragma unroll
            for (int m = 0; m < 4; ++m)
#pragma unroll
                for (int n = 0; n < 2; ++n) acc[a][b][m][n] = (f32x4){0.f, 0.f, 0.f, 0.f};
    f16x8 At[4][2], B0[2][2], B1[2][2];
    unsigned vc[2][2], vn[2][2], vs[2][2];
    FG_VOFF(vc, cur);
    const char* Ab = (const char*)P.abase();
    const char* cB = (const char*)P.bt(cur);
    FG_STAGEB(FG_SB(0, 0), cB); FG_STAGEB(FG_SB(0, 1), cB + hstep); FG_STAGEA(FG_SA(0, 0), Ab, vc, 0); FG_STAGEA(FG_SA(0, 1), Ab, vc, 1);
    if (wr == 1) FG_BAR;
    FG_WAIT_V(2); FG_BAR;
    FG_STAGEB(FG_SB(1, 0), cB + kstep); FG_STAGEA(FG_SA(1, 0), Ab + kstep, vc, 0); FG_STAGEB(FG_SB(1, 1), cB + hstep + kstep);
    FG_WAIT_V(6); FG_BAR;
    for (;;) {
        const bool has_next = P.next(ui + 1, nxt);
        const char* nB = cB;
        if (has_next) { FG_VOFF(vn, nxt); nB = (const char*)P.bt(nxt); }
        else {
#pragma unroll
            for (int _h = 0; _h < 2; ++_h)
#pragma unroll
                for (int _i = 0; _i < 2; ++_i) vn[_h][_i] = vc[_h][_i];
        }
        for (int t = 0; t < nt; t += 2) {
            const bool last = (t == nt - 2);
            const char* a1 = Ab + (size_t)(t + 1) * kstep;
            const char* a2 = last ? Ab : Ab + (size_t)(t + 2) * kstep; const char* b2 = last ? nB : cB + (size_t)(t + 2) * kstep;
            const char* a3 = a2 + kstep; const char* b3 = b2 + kstep;
#pragma unroll
            for (int _h = 0; _h < 2; ++_h)
#pragma unroll
                for (int _i = 0; _i < 2; ++_i) vs[_h][_i] = last ? vn[_h][_i] : vc[_h][_i];
            FG_LDB(B0, 0, 0); FG_LDB(B1, 0, 1); FG_SCHED; FG_LDA(At, 0, 0); FG_STAGEA(FG_SA(1, 1), a1, vc, 1);
            FG_WAIT_V(8); FG_WAIT_L(0); FG_BAR; FG_MMA(0, 0, At, B0); FG_MMA(0, 1, At, B1); FG_BAR; FG_SCHED;
            FG_LDA(At, 0, 1); FG_STAGEB(FG_SB(0, 0), b2); FG_STAGEB(FG_SB(0, 1), b2 + hstep); FG_STAGEA(FG_SA(0, 0), a2, vs, 0);
            FG_WAIT_V(8); FG_WAIT_L(0); FG_BAR; FG_MMA(1, 0, At, B0); FG_MMA(1, 1, At, B1); FG_BAR; FG_SCHED;
            FG_LDB(B0, 1, 0); FG_LDB(B1, 1, 1); FG_SCHED; FG_LDA(At, 1, 0); FG_STAGEA(FG_SA(0, 1), a2, vs, 1);
            FG_WAIT_V(8); FG_WAIT_L(0); FG_BAR; FG_MMA(0, 0, At, B0); FG_MMA(0, 1, At, B1); FG_BAR; FG_SCHED;
            FG_LDA(At, 1, 1); FG_STAGEB(FG_SB(1, 0), b3); FG_STAGEB(FG_SB(1, 1), b3 + hstep); FG_STAGEA(FG_SA(1, 0), a3, vs, 0);
            FG_WAIT_V(8); FG_WAIT_L(0); FG_BAR; FG_MMA(1, 0, At, B0); FG_MMA(1, 1, At, B1); FG_BAR; FG_SCHED;
        }
        if (wr == 0) FG_BAR;
        if constexpr (!Epi::AFTER_DRAIN) E(acc, cur, wr, wc, fr, fq);
        if (!has_next) break;
#pragma unroll
        for (int a = 0; a < 2; ++a)
#pragma unroll
            for (int b = 0; b < 2; ++b)
#pragma unroll
                for (int m = 0; m < 4; ++m)
#pragma unroll
                    for (int n = 0; n < 2; ++n) acc[a][b][m][n] = (f32x4){0.f, 0.f, 0.f, 0.f};
        cur = nxt; cB = nB; ++ui;
#pragma unroll
        for (int _h = 0; _h < 2; ++_h)
#pragma unroll
            for (int _i = 0; _i < 2; ++_i) vc[_h][_i] = vn[_h][_i];
        if (wr == 1) FG_BAR;
    }
    FG_WAIT_V(0);
    FG_BAR;
    if constexpr (Epi::AFTER_DRAIN) E.fused(acc, cur, wr, wc, fr, fq, lds, wid, lane);
#undef FG_SA
#undef FG_SB
#undef FG_STAGEA
#undef FG_STAGEB
#undef FG_LDA
#undef FG_LDB
#undef FG_MMA
#undef FG_WAIT_V
#undef FG_WAIT_L
#undef FG_BAR
#undef FG_SCHED
#undef FG_VOFF
}
}

__device__ __forceinline__ int xcd_remap(long L, int nwg) {
    const int q = nwg >> 3, r = nwg & 7, xcd = (int)(L & 7), off = (int)(L >> 3);
    return (xcd < r ? xcd * (q + 1) : r * (q + 1) + (xcd - r) * q) + off;
}
struct ProbDense {
    const h16* A; const h16* Bt; int M, N, K; int G, c;
    __device__ __forceinline__ bool next(int i, Unit& u) const {
        const int nM = M / 256, nN = N / 256, nwg = nM * nN; const long L = (long)i * G + c; if (L >= (long)nwg) return false;
        const int w = (G & 7) ? (int)L : xcd_remap(L, nwg);
        const int nig = 8 * nN, gid = w / nig, fm = gid * 8, gsz = (nM - fm) < 8 ? (nM - fm) : 8, wi = w - gid * nig;
        u.pm = fm + wi % gsz; u.pn = wi / gsz; return true;
    }
    __device__ __forceinline__ const h16* abase() const { return A; }
    __device__ __forceinline__ int aoff(const Unit& u, int r) const { return (256 * u.pm + r) * K; }
    __device__ __forceinline__ const h16* bt(const Unit& u) const { return Bt + (size_t)(256 * u.pn) * K; }
};
struct ProbDenseR : ProbDense { int ri; __device__ __forceinline__ bool next(int i, Unit& u) const { return i == 0 ? ProbDense::next(ri, u) : false; } };
struct ProbMoe1 {
    const h16* X1; const h16* W1t; const int* row_tok; const int* tile_e; int NT; int K; int G, c;
    __device__ __forceinline__ bool next(int i, Unit& u) const {
        const int nwg = NT * 2; const long L = (long)i * G + c; if (L >= (long)nwg) return false;
        const int w = (G & 7) ? (int)L : xcd_remap(L, nwg);
        u.pm = w >> 1; u.pn = w & 1; return true;
    }
    __device__ __forceinline__ const h16* abase() const { return X1; }
    __device__ __forceinline__ int aoff(const Unit& u, int r) const { return row_tok[256 * u.pm + r] * 1024; }
    __device__ __forceinline__ const h16* bt(const Unit& u) const { return W1t + (size_t)tile_e[u.pm] * (512 * 1024) + (size_t)u.pn * (256 * 1024); }
};
struct ProbMoe2 {
    const h16* HID; const h16* W2t; const int* tile_e; int NT; int K; int G, c;
    __device__ __forceinline__ bool next(int i, Unit& u) const {
        const int nwg = NT * 4; const long L = (long)i * G + c; if (L >= (long)nwg) return false;
        const int w = (G & 7) ? (int)L : xcd_remap(L, nwg);
        u.pm = w >> 2; u.pn = w & 3; return true;
    }
    __device__ __forceinline__ const h16* abase() const { return HID; }
    __device__ __forceinline__ int aoff(const Unit& u, int r) const { return (256 * u.pm + r) * 256; }
    __device__ __forceinline__ const h16* bt(const Unit& u) const { return W2t + (size_t)tile_e[u.pm] * (1024 * 256) + (size_t)u.pn * (256 * 256); }
};

#define EPI_LOOP_BEGIN \
    _Pragma("unroll") for (int ai = 0; ai < 2; ++ai) _Pragma("unroll") for (int m = 0; m < 4; ++m) { const int row = 256 * u.pm + 128 * ai + 64 * wr + 16 * m + fr; \
    _Pragma("unroll") for (int bj = 0; bj < 2; ++bj) { const int col = 256 * u.pn + 128 * bj + 32 * wc + 8 * fq; f32x4 v0 = acc[ai][bj][m][0], v1 = acc[ai][bj][m][1];
#define EPI_LOOP_END } }

#define EPI_FENCE asm volatile("" ::: "memory")
struct EpiInProj {
    static constexpr bool AFTER_DRAIN = false; static constexpr bool ADJ = false;
    h16* H; const float* bias; int mode;
    __device__ __forceinline__ void operator()(const f32x4 (&acc)[2][2][4][2], const Unit& u, int wr, int wc, int fr, int fq) const {
        if (mode == 2) { asm volatile("" :: "v"(acc[0][0][0][0]), "v"(acc[1][1][3][1])); return; }
        f32x4 bv[2][2];
#pragma unroll
        for (int bj = 0; bj < 2; ++bj) { const int col = 256 * u.pn + 128 * bj + 32 * wc + 8 * fq; bv[bj][0] = *(const f32x4*)(bias + col); bv[bj][1] = *(const f32x4*)(bias + col + 4); }
        EPI_FENCE;
        EPI_LOOP_BEGIN
            v0 += bv[bj][0]; v1 += bv[bj][1];
            if (u.pn < 8) {
                const f32x2 a_ = gelu_pk((f32x2){v0[0], v0[1]}), b_ = gelu_pk((f32x2){v0[2], v0[3]}), c_ = gelu_pk((f32x2){v1[0], v1[1]}), d_ = gelu_pk((f32x2){v1[2], v1[3]});
                v0 = (f32x4){a_.x, a_.y, b_.x, b_.y}; v1 = (f32x4){c_.x, c_.y, d_.x, d_.y};
            }
            *(f16x8*)(H + (size_t)row * NIN + col) = pack8(v0, v1);
        EPI_LOOP_END
    }
};
struct EpiYb {
    static constexpr bool AFTER_DRAIN = false; static constexpr bool ADJ = false;
    h16* MG; const h16* H;
    __device__ __forceinline__ void operator()(const f32x4 (&acc)[2][2][4][2], const Unit& u, int wr, int wc, int fr, int fq) const {
        f16x8 g[2][4][2];
#pragma unroll
        for (int ai = 0; ai < 2; ++ai)
#pragma unroll
            for (int m = 0; m < 4; ++m)
#pragma unroll
                for (int bj = 0; bj < 2; ++bj) g[ai][m][bj] = *(const f16x8*)(H + (size_t)(256 * u.pm + 128 * ai + 64 * wr + 16 * m + fr) * NIN + C_GB + 256 * u.pn + 128 * bj + 32 * wc + 8 * fq);
        EPI_FENCE;
        EPI_LOOP_BEGIN
#pragma unroll
            for (int j = 0; j < 4; ++j) { v0[j] *= sigmoidf_((float)g[ai][m][bj][j]); v1[j] *= sigmoidf_((float)g[ai][m][bj][4 + j]); }
            *(f16x8*)(MG + (size_t)row * DM + col) = pack8(v0, v1);
        EPI_LOOP_END
    }
};
struct EpiYa {
    static constexpr bool AFTER_DRAIN = false; static constexpr bool ADJ = false;
    h16* MG; const h16* H;
    __device__ __forceinline__ void operator()(const f32x4 (&acc)[2][2][4][2], const Unit& u, int wr, int wc, int fr, int fq) const {
#pragma unroll
        for (int ai = 0; ai < 2; ++ai) {
            f16x8 g[4][2], t[4][2];
#pragma unroll
            for (int m = 0; m < 4; ++m)
#pragma unroll
                for (int bj = 0; bj < 2; ++bj) { const int row = 256 * u.pm + 128 * ai + 64 * wr + 16 * m + fr, col = 256 * u.pn + 128 * bj + 32 * wc + 8 * fq;
                    g[m][bj] = *(const f16x8*)(H + (size_t)row * NIN + C_GA + col); t[m][bj] = *(const f16x8*)(MG + (size_t)row * DM + col); }
            EPI_FENCE;
#pragma unroll
            for (int m = 0; m < 4; ++m)
#pragma unroll
                for (int bj = 0; bj < 2; ++bj) { const int row = 256 * u.pm + 128 * ai + 64 * wr + 16 * m + fr, col = 256 * u.pn + 128 * bj + 32 * wc + 8 * fq;
                    f32x4 v0 = acc[ai][bj][m][0], v1 = acc[ai][bj][m][1];
#pragma unroll
                    for (int j = 0; j < 4; ++j) { v0[j] = v0[j] * sigmoidf_((float)g[m][bj][j]) + (float)t[m][bj][j]; v1[j] = v1[j] * sigmoidf_((float)g[m][bj][4 + j]) + (float)t[m][bj][4 + j]; }
                    *(f16x8*)(MG + (size_t)row * DM + col) = pack8(v0, v1); }
            EPI_FENCE;
        }
    }
};
struct EpiOutW {
    static constexpr bool AFTER_DRAIN = false; static constexpr bool ADJ = false;
    float* R; const float* X;
    __device__ __forceinline__ void operator()(const f32x4 (&acc)[2][2][4][2], const Unit& u, int wr, int wc, int fr, int fq) const {
#pragma unroll
        for (int ai = 0; ai < 2; ++ai)
#pragma unroll
            for (int mh = 0; mh < 2; ++mh) {
                f32x4 xv[2][2][2];
#pragma unroll
                for (int mm = 0; mm < 2; ++mm)
#pragma unroll
                    for (int bj = 0; bj < 2; ++bj) { const int m = 2 * mh + mm; const int row = 256 * u.pm + 128 * ai + 64 * wr + 16 * m + fr, col = 256 * u.pn + 128 * bj + 32 * wc + 8 * fq;
                        xv[mm][bj][0] = *(const f32x4*)(X + (size_t)row * DM + col); xv[mm][bj][1] = *(const f32x4*)(X + (size_t)row * DM + col + 4); }
                EPI_FENCE;
#pragma unroll
                for (int mm = 0; mm < 2; ++mm)
#pragma unroll
                    for (int bj = 0; bj < 2; ++bj) { const int m = 2 * mh + mm; const int row = 256 * u.pm + 128 * ai + 64 * wr + 16 * m + fr, col = 256 * u.pn + 128 * bj + 32 * wc + 8 * fq;
                        *(f32x4*)(R + (size_t)row * DM + col) = xv[mm][bj][0] * ALPHA + acc[ai][bj][m][0]; *(f32x4*)(R + (size_t)row * DM + col + 4) = xv[mm][bj][1] * ALPHA + acc[ai][bj][m][1]; }
                EPI_FENCE;
            }
    }
};
struct PanelStats {
    unsigned long long* xbuf;
    unsigned* cnt;
    float eps;
    __device__ __forceinline__ void run(const f32x4 (&v)[2][2][4][2], const Unit& u, int wr, int wc, int fr, int fq, LAS unsigned char* lds, int wid, int lane) const {
        LAS f32x2* P = (LAS f32x2*)lds;
        LAS f32x2* S = (LAS f32x2*)(lds + 8192);
#pragma unroll
        for (int ai = 0; ai < 2; ++ai)
#pragma unroll
            for (int m = 0; m < 4; ++m) {
                float s = 0.f;
#pragma unroll
                for (int bj = 0; bj < 2; ++bj)
#pragma unroll
                    for (int n = 0; n < 2; ++n) { const f32x4 x = v[ai][bj][m][n]; s += (x[0] + x[1]) + (x[2] + x[3]); }
                s += __shfl_xor(s, 16); s += __shfl_xor(s, 32);
                const float mw = s * (1.0f / 64.0f); float q = 0.f;
#pragma unroll
                for (int bj = 0; bj < 2; ++bj)
#pragma unroll
                    for (int n = 0; n < 2; ++n) { const f32x4 d = v[ai][bj][m][n] - mw; q += (d[0] * d[0] + d[1] * d[1]) + (d[2] * d[2] + d[3] * d[3]); }
                q += __shfl_xor(q, 16); q += __shfl_xor(q, 32);
                if (fq == 0) P[(ai * 128 + wr * 64 + m * 16 + fr) * 4 + wc] = (f32x2){mw, q};
            }
        asm volatile("s_waitcnt lgkmcnt(0)" ::: "memory"); __builtin_amdgcn_s_barrier(); asm volatile("" ::: "memory");
        const int row = wid * 32 + (lane & 31);
        if (lane < 32) {
            const f32x2 a = P[row * 4 + 0], b = P[row * 4 + 1], c = P[row * 4 + 2], d = P[row * 4 + 3];
            const float mt = (a.x + b.x + c.x + d.x) * 0.25f;
            const float da = a.x - mt, db = b.x - mt, dc = c.x - mt, dd = d.x - mt;
            const float m2 = (a.y + b.y) + (c.y + d.y) + 64.0f * ((da * da + db * db) + (dc * dc + dd * dd));
            unsigned long long* slot = xbuf + ((size_t)(u.pm * 256 + row) * 4 + u.pn);
            __hip_atomic_store(slot, ((unsigned long long)__float_as_uint(m2) << 32) | __float_as_uint(mt), __ATOMIC_RELAXED, __HIP_MEMORY_SCOPE_AGENT);
        }
        asm volatile("s_waitcnt vmcnt(0)" ::: "memory");
        if (lane == 0) __hip_atomic_fetch_add(cnt + 64 * u.pm, 1u, __ATOMIC_RELAXED, __HIP_MEMORY_SCOPE_AGENT);
        if (wid == 0) {
            unsigned sp = 0;
            while ((unsigned)__builtin_amdgcn_readfirstlane(__hip_atomic_load(cnt + 64 * u.pm, __ATOMIC_RELAXED, __HIP_MEMORY_SCOPE_AGENT)) < 32u) { __builtin_amdgcn_s_sleep(2); if (++sp > (1u << 22)) break; }
            __builtin_amdgcn_fence(__ATOMIC_ACQUIRE, "agent");
        }
        asm volatile("s_waitcnt vmcnt(0) lgkmcnt(0)" ::: "memory"); __builtin_amdgcn_s_barrier(); asm volatile("" ::: "memory");
        if (lane < 32) {
            const unsigned long long* slot = xbuf + (size_t)(u.pm * 256 + row) * 4; float mt[4], m2[4]; float ms = 0.f;
#pragma unroll
            for (int t = 0; t < 4; ++t) { const unsigned long long w = __hip_atomic_load(slot + t, __ATOMIC_RELAXED, __HIP_MEMORY_SCOPE_AGENT); mt[t] = __uint_as_float((unsigned)w); m2[t] = __uint_as_float((unsigned)(w >> 32)); ms += mt[t]; }
            const float mean = ms * 0.25f; float q = 0.f;
#pragma unroll
            for (int t = 0; t < 4; ++t) { const float dm = mt[t] - mean; q += m2[t] + 256.0f * dm * dm; }
            S[row] = (f32x2){mean, 1.0f / sqrtf(q * (1.0f / 1024.0f) + eps)};
        }
        asm volatile("s_waitcnt lgkmcnt(0)" ::: "memory"); __builtin_amdgcn_s_barrier(); asm volatile("" ::: "memory");
    }
};
struct EpiLn1 {
    static constexpr bool AFTER_DRAIN = true; static constexpr bool ADJ = false;
    h16* X1; const float* X; const float* g; const float* b; PanelStats st;
    __device__ __forceinline__ void operator()(const f32x4 (&)[2][2][4][2], const Unit&, int, int, int, int) const {}
    __device__ __forceinline__ void fused(f32x4 (&acc)[2][2][4][2], const Unit& u, int wr, int wc, int fr, int fq, LAS unsigned char* lds, int wid, int lane) const {
#pragma unroll
        for (int ai = 0; ai < 2; ++ai)
#pragma unroll
            for (int mh = 0; mh < 2; ++mh) {
                f32x4 xv[2][2][2];
#pragma unroll
                for (int mm = 0; mm < 2; ++mm)
#pragma unroll
                    for (int bj = 0; bj < 2; ++bj) { const int m = 2 * mh + mm; const int row = 256 * u.pm + 128 * ai + 64 * wr + 16 * m + fr, col = 256 * u.pn + 128 * bj + 32 * wc + 8 * fq;
                        xv[mm][bj][0] = *(const f32x4*)(X + (size_t)row * DM + col); xv[mm][bj][1] = *(const f32x4*)(X + (size_t)row * DM + col + 4); }
#pragma unroll
                for (int mm = 0; mm < 2; ++mm)
#pragma unroll
                    for (int bj = 0; bj < 2; ++bj) { const int m = 2 * mh + mm; acc[ai][bj][m][0] += xv[mm][bj][0] * ALPHA; acc[ai][bj][m][1] += xv[mm][bj][1] * ALPHA; }
                asm volatile("" : "+v"(acc[ai][0][2 * mh][0]), "+v"(acc[ai][0][2 * mh + 1][0]), "+v"(acc[ai][1][2 * mh][0]), "+v"(acc[ai][1][2 * mh + 1][0]));
            }
        st.run(acc, u, wr, wc, fr, fq, lds, wid, lane);
        const LAS f32x2* S = (const LAS f32x2*)(lds + 8192);
        f32x4 gv[2][2], bv[2][2];
#pragma unroll
        for (int bj = 0; bj < 2; ++bj) { const int col = 256 * u.pn + 128 * bj + 32 * wc + 8 * fq; gv[bj][0] = *(const f32x4*)(g + col); gv[bj][1] = *(const f32x4*)(g + col + 4); bv[bj][0] = *(const f32x4*)(b + col); bv[bj][1] = *(const f32x4*)(b + col + 4); }
        EPI_FENCE;
#pragma unroll
        for (int ai = 0; ai < 2; ++ai)
#pragma unroll
            for (int m = 0; m < 4; ++m) { const int rl = 128 * ai + 64 * wr + 16 * m + fr; const f32x2 sr = S[rl]; const int row = 256 * u.pm + rl;
#pragma unroll
                for (int bj = 0; bj < 2; ++bj) { const int col = 256 * u.pn + 128 * bj + 32 * wc + 8 * fq;
                    const f32x4 o0 = (acc[ai][bj][m][0] - sr.x) * sr.y * gv[bj][0] + bv[bj][0], o1 = (acc[ai][bj][m][1] - sr.x) * sr.y * gv[bj][1] + bv[bj][1];
                    *(f16x8*)(X1 + (size_t)row * DM + col) = pack8(o0, o1); } }
    }
};
struct EpiLogit {
    static constexpr bool AFTER_DRAIN = false; static constexpr bool ADJ = false;
    float* L;
    __device__ __forceinline__ void operator()(const f32x4 (&acc)[2][2][4][2], const Unit& u, int wr, int wc, int fr, int fq) const {
        EPI_LOOP_BEGIN
            *(f32x4*)(L + (size_t)row * NEXP + col) = v0; *(f32x4*)(L + (size_t)row * NEXP + col + 4) = v1;
        EPI_LOOP_END
    }
};
struct EpiMoe1 {
    static constexpr bool AFTER_DRAIN = false; static constexpr bool ADJ = false;
    h16* HID;
    __device__ __forceinline__ void operator()(const f32x4 (&acc)[2][2][4][2], const Unit& u, int wr, int wc, int fr, int fq) const {
#pragma unroll
        for (int ai = 0; ai < 2; ++ai)
#pragma unroll
            for (int m = 0; m < 4; ++m) {
                const int row = 256 * u.pm + 128 * ai + 64 * wr + 16 * m + fr; const int col = 128 * u.pn + 32 * wc + 8 * fq;
                f32x4 g0 = acc[ai][0][m][0], g1 = acc[ai][0][m][1], u0 = acc[ai][1][m][0], u1 = acc[ai][1][m][1];
#pragma unroll
                for (int j = 0; j < 4; ++j) { g0[j] = g0[j] * sigmoidf_(g0[j]) * u0[j]; g1[j] = g1[j] * sigmoidf_(g1[j]) * u1[j]; }
                *(f16x8*)(HID + (size_t)row * EDIM + col) = pack8(g0, g1);
            }
    }
};
constexpr float Y_SCALE = 64.0f, Y_INV = 1.0f / 64.0f;
__device__ __forceinline__ unsigned pk4_fp8(f32x4 v) { int w = 0; w = __builtin_amdgcn_cvt_pk_fp8_f32(v[0] * Y_SCALE, v[1] * Y_SCALE, w, false); w = __builtin_amdgcn_cvt_pk_fp8_f32(v[2] * Y_SCALE, v[3] * Y_SCALE, w, true); return (unsigned)w; }
struct EpiMoe2 {
    static constexpr bool AFTER_DRAIN = false; static constexpr bool ADJ = true;
    unsigned char* Y; const int* row_dst; int mode;
    __device__ __forceinline__ void operator()(const f32x4 (&acc)[2][2][4][2], const Unit& u, int wr, int wc, int fr, int fq) const {
        if (mode == 2) { asm volatile("" :: "v"(acc[0][0][0][0]), "v"(acc[1][1][3][1])); return; }
        int dsts[2][4];
#pragma unroll
        for (int ai = 0; ai < 2; ++ai)
#pragma unroll
            for (int m = 0; m < 4; ++m) dsts[ai][m] = row_dst[256 * u.pm + 128 * ai + 64 * wr + 16 * m + fr];
        EPI_FENCE;
        const int col = 256 * u.pn + 64 * wc + 16 * fq;
#pragma unroll
        for (int ai = 0; ai < 2; ++ai)
#pragma unroll
            for (int m = 0; m < 4; ++m) {
                const int dst = dsts[ai][m];
                if (dst >= 0) {
                    u32x4 w; w[0] = pk4_fp8(acc[ai][0][m][0]); w[1] = pk4_fp8(acc[ai][0][m][1]); w[2] = pk4_fp8(acc[ai][1][m][0]); w[3] = pk4_fp8(acc[ai][1][m][1]);
                    if (mode == 0) *(u32x4*)(Y + (size_t)dst * DM + col) = w; else asm volatile("" :: "v"(w));
                }
            }
    }
};

__device__ __forceinline__ void tr_item(const float* W, int K, int N, int k0, int n0, h16* dst, float* scr, int lane) {
    (void)scr;
    const int lk = lane & 7, ln = lane >> 3;
    const float* src = W + (size_t)(k0 + 8 * lk) * N + n0 + 4 * ln;
    f32x4 v[8];
#pragma unroll
    for (int i = 0; i < 8; ++i) v[i] = __builtin_nontemporal_load((const f32x4*)(src + (size_t)i * N));
#pragma unroll
    for (int j = 0; j < 4; ++j) { f16x8 o;
#pragma unroll
        for (int i = 0; i < 8; ++i) o[i] = (h16)v[i][j];
        *(f16x8*)(dst + (size_t)(4 * ln + j) * K + k0 + 8 * lk) = o; }
}
__device__ __forceinline__ void conv_item_addr(const Frame& F, int it, const float*& src, int& K, int& N, int& k0, int& n0, h16*& dst) {
    const int e = it / 384; int r = it - e * 384;
    const float* wg = e < 256 ? F.e_wg + (size_t)e * 1024 * 256 : F.s_wg;
    const float* wu = e < 256 ? F.e_wu + (size_t)e * 1024 * 256 : F.s_wu;
    const float* wd = e < 256 ? F.e_wd + (size_t)e * 256 * 1024 : F.s_wd;
    h16* w1 = F.W1t + (size_t)e * 512 * 1024; h16* w2 = F.W2t + (size_t)e * 1024 * 256;
    if (r < 128) { const int kb = r >> 3, nb = r & 7; n0 = 32 * nb; k0 = 64 * kb; src = wg; K = 1024; N = 256; dst = w1 + (size_t)((n0 >> 7) * 256 + (n0 & 127)) * 1024; return; } r -= 128;
    if (r < 128) { const int kb = r >> 3, nb = r & 7; n0 = 32 * nb; k0 = 64 * kb; src = wu; K = 1024; N = 256; dst = w1 + (size_t)((n0 >> 7) * 256 + 128 + (n0 & 127)) * 1024; return; } r -= 128;
    { const int kb = r >> 5, nb = r & 31; n0 = 32 * nb; k0 = 64 * kb; src = wd; K = 256; N = 1024; dst = w2 + (size_t)n0 * 256; }
}
__device__ __forceinline__ void conv_experts(Frame& F, int gw, int NGW) {
    const int lane = F.lane, lk = lane & 7, ln = lane >> 3;
    constexpr int NIT = 257 * 384, NF = 3;
    for (int it = gw; it < NIT; it += NF * NGW) {
        f32x4 v[NF][8]; h16* d[NF]; int Kd[NF], kd[NF]; bool ok[NF];
#pragma unroll
        for (int u = 0; u < NF; ++u) {
            const int itu = it + u * NGW; ok[u] = itu < NIT;
            const float* sp; int N0, n0;
            conv_item_addr(F, ok[u] ? itu : it, sp, Kd[u], N0, kd[u], n0, d[u]);
            const float* p = sp + (size_t)(kd[u] + 8 * lk) * N0 + n0 + 4 * ln;
#pragma unroll
            for (int i = 0; i < 8; ++i) v[u][i] = __builtin_nontemporal_load((const f32x4*)(p + (size_t)i * N0));
        }
#pragma unroll
        for (int u = 0; u < NF; ++u) {
            if (ok[u]) {
#pragma unroll
                for (int j = 0; j < 4; ++j) { f16x8 o;
#pragma unroll
                    for (int i = 0; i < 8; ++i) o[i] = (h16)v[u][i][j];
                    __builtin_nontemporal_store(o, (f16x8*)(d[u] + (size_t)(4 * ln + j) * Kd[u] + kd[u] + 8 * lk)); }
            }
        }
    }
}
__device__ __forceinline__ void conv_experts_dyn(Frame& F) {
    const int lane = F.lane, lk = lane & 7, ln = lane >> 3;
    constexpr int NIT = 257 * 384, NF = 3, CH = 12, PER = NIT / 8;
    const int x = F.bid & 7; unsigned* ctr = F.ctl + CW_CONVQ + 64 * x;
    const int lo = x * PER, hi = (x == 7) ? NIT : lo + PER;
    for (;;) {
        unsigned b0 = 0;
        if (lane == 0) b0 = __hip_atomic_fetch_add(ctr, (unsigned)CH, __ATOMIC_RELAXED, __HIP_MEMORY_SCOPE_AGENT);
        const int base = lo + (int)__builtin_amdgcn_readfirstlane(b0);
        if (base >= hi) break;
        const int end = base + CH < hi ? base + CH : hi;
        for (int it = base; it < end; it += NF) {
            f32x4 v[NF][8]; h16* d[NF]; int Kd[NF], kd[NF]; bool ok[NF];
#pragma unroll
            for (int u = 0; u < NF; ++u) {
                const int itu = it + u; ok[u] = itu < end;
                const float* sp; int N0, n0;
                conv_item_addr(F, ok[u] ? itu : it, sp, Kd[u], N0, kd[u], n0, d[u]);
                const float* p = sp + (size_t)(kd[u] + 8 * lk) * N0 + n0 + 4 * ln;
#pragma unroll
                for (int i = 0; i < 8; ++i) v[u][i] = __builtin_nontemporal_load((const f32x4*)(p + (size_t)i * N0));
            }
#pragma unroll
            for (int u = 0; u < NF; ++u) {
                if (ok[u]) {
#pragma unroll
                    for (int j = 0; j < 4; ++j) { f16x8 o;
#pragma unroll
                        for (int i = 0; i < 8; ++i) o[i] = (h16)v[u][i][j];
                        __builtin_nontemporal_store(o, (f16x8*)(d[u] + (size_t)(4 * ln + j) * Kd[u] + kd[u] + 8 * lk)); }
                }
            }
        }
    }
}
__device__ __forceinline__ void ph_prologue(Frame& F) {
    float* scr = (float*)(F.lds + F.wave * 16384);
    const int gw = F.bid * NWAVES + F.wave, NGW = F.G * NWAVES;
    constexpr int I_IN = 16 * 200, I_A = 16 * 32, I_B = 4 * 32, I_O = 16 * 32, I_R = 16 * 8, I_SMALL = I_IN + I_A + I_B + I_O + I_R;
    for (int it = gw; it < I_SMALL; it += NGW) {
        int r = it;
        if (r < I_IN) { const int kb = r / 200, nb = r % 200; tr_item(F.in_w, 1024, NIN, 64 * kb, 32 * nb, F.WinT + (size_t)(32 * nb) * 1024, scr, F.lane); continue; } r -= I_IN;
        if (r < I_A) { const int kb = r / 32, nb = r % 32; tr_item(F.pa_w, 1024, 1024, 64 * kb, 32 * nb, F.WaT + (size_t)(32 * nb) * 1024, scr, F.lane); continue; } r -= I_A;
        if (r < I_B) { const int kb = r / 32, nb = r % 32; tr_item(F.pb_w, 256, 1024, 64 * kb, 32 * nb, F.WbT + (size_t)(32 * nb) * 256, scr, F.lane); continue; } r -= I_B;
        if (r < I_O) { const int kb = r / 32, nb = r % 32; tr_item(F.out_w, 1024, 1024, 64 * kb, 32 * nb, F.WoT + (size_t)(32 * nb) * 1024, scr, F.lane); continue; } r -= I_O;
        { const int kb = r / 8, nb = r % 8; tr_item(F.r_w, 1024, 256, 64 * kb, 32 * nb, F.WrT + (size_t)(32 * nb) * 1024, scr, F.lane); }
    }
#if !CONV_IN_ATTN
    conv_experts(F, F.bid * NWAVES + F.wave, F.G * NWAVES);
#endif
    for (int i = F.bid * NTHREADS + F.tid; i < 8 * 128 * 128; i += F.G * NTHREADS) { const int tt = (i >> 7) & 127, ss = i & 127; F.Wc[i] = (ss <= tt) ? (h16)F.sp_w[i] : (h16)0.f; }
    const size_t nth = (size_t)F.G * NTHREADS; const size_t n8 = (size_t)T * DM / 8;
    for (size_t i = (size_t)F.bid * NTHREADS + F.tid; i < n8; i += 4 * nth) {
        f32x4 a[4], b[4];
#pragma unroll
        for (int u = 0; u < 4; ++u) { const size_t j = i + u * nth; if (j < n8) { a[u] = __builtin_nontemporal_load((const f32x4*)(F.x + j * 8)); b[u] = __builtin_nontemporal_load((const f32x4*)(F.x + j * 8 + 4)); } }
#pragma unroll
        for (int u = 0; u < 4; ++u) { const size_t j = i + u * nth; if (j < n8) *(f16x8*)(F.x16 + j * 8) = pack8(a[u], b[u]); }
    }
}

__device__ __forceinline__ void ph_attn_simple(Frame& F) {
    float* pl = (float*)(F.lds) + F.wave * 512;
    const int gw = F.bid * NWAVES + F.wave, NGW = F.G * NWAVES;
    const int lane = F.lane;
    for (int it = gw; it < T * 4; it += NGW) {
        const int t = it >> 2, hg = it & 3; const int s = t & (SEQ - 1);
        float sc[3][3];
        float mx = -INFINITY;
#pragma unroll
        for (int g = 0; g < 3; ++g) {
            const int hh = 4 * g + hg; const int dil = (g == 0) ? 1 : (g == 1 ? 4 : 16);
            const float slope = exp2f(hh < 8 ? -0.5f * (float)(hh + 1) : -(float)(hh - 3));
            const h16* qp = F.h + (size_t)t * NIN + C_Q + hh * 64;
            f16x8 q[8];
#pragma unroll
            for (int j = 0; j < 8; ++j) q[j] = *(const f16x8*)(qp + 8 * j);
#pragma unroll
            for (int r = 0; r < 3; ++r) {
                const int delta = lane + 64 * r; const bool valid = (r < 2 || lane == 0) && (s - delta * dil >= 0);
                float v = -INFINITY;
                if (valid) {
                    const h16* kp = F.h + (size_t)(t - delta * dil) * NIN + C_K + hh * 64;
                    float d = 0.f;
#pragma unroll
                    for (int j = 0; j < 8; ++j) { const f16x8 kk = *(const f16x8*)(kp + 8 * j);
#pragma unroll
                        for (int e = 0; e < 8; ++e) d += (float)q[j][e] * (float)kk[e]; }
                    v = d * 0.125f - slope * (float)(delta * dil);
                }
                sc[g][r] = v; mx = fmaxf(mx, v);
            }
        }
        mx = wave_max(mx);
        float lsum = 0.f;
#pragma unroll
        for (int g = 0; g < 3; ++g)
#pragma unroll
            for (int r = 0; r < 3; ++r) {
                const float p = (sc[g][r] == -INFINITY) ? 0.f : __expf(sc[g][r] - mx);
                lsum += p;
                if (r < 2 || lane == 0) pl[g * 129 + lane + 64 * r] = p;
            }
        lsum = wave_sum(lsum);
        __builtin_amdgcn_s_waitcnt(0xc07f); asm volatile("" ::: "memory");
        float o = 0.f;
#pragma unroll
        for (int g = 0; g < 3; ++g) {
            const int hh = 4 * g + hg; const int dil = (g == 0) ? 1 : (g == 1 ? 4 : 16);
            int nk = s / dil + 1; if (nk > 129) nk = 129;
            const h16* vp = F.h + (size_t)t * NIN + C_VV + hh * 64 + lane;
            for (int delta = 0; delta < nk; ++delta) o += pl[g * 129 + delta] * (float)vp[-(long)delta * dil * NIN];
        }
        F.yb[(size_t)t * 256 + hg * 64 + lane] = (h16)(o / lsum);
        asm volatile("" ::: "memory");
    }
}

typedef float f32x16 __attribute__((ext_vector_type(16)));
typedef short v4i16_t __attribute__((ext_vector_type(4)));
__device__ __forceinline__ int crow(int r, int hi) { return (r & 3) + 8 * (r >> 2) + 4 * hi; }
__device__ __forceinline__ void ph_attn_fast(Frame& F, LAS unsigned char* ldsb) {
    const int lane = F.lane, q = lane & 31, hi = lane >> 5;
    LAS unsigned char* vl = ldsb + F.wave * 16640;
    const int vcu = (F.G % 8 == 0) ? (F.bid % 8) * (F.G / 8) + F.bid / 8 : F.bid;
    constexpr int NTASK = 8 * 12 * 32 * 4;
#if CONV_IN_ATTN
    constexpr int NA = ATTN_WAVES;
    if (F.wave >= NA) { conv_experts_dyn(F); return; }
#else
    constexpr int NA = NWAVES;
#endif
    const int R = (NTASK + F.G * NA - 1) / (F.G * NA);
    const int li = lane & 15;
    const int tr_base = (4 * hi + (li >> 2)) * 64 + (16 * ((lane >> 4) & 1) + 4 * (li & 3)) * 2;
    const int vw_kv = lane >> 3, vw_c = lane & 7;
    const int vw_off = (vw_c >> 2) * 2112 + vw_kv * 64 + (vw_c & 3) * 16;
    for (int it = 0; it < R; ++it) {
        const int task = (vcu * R + it) * NA + F.wave;
        if (task >= NTASK) break;
        const int unit = task >> 2, a = task & 3, bh = unit >> 5, blk = unit & 31;
        const int b = bh / 12, hh = bh - b * 12, g = hh >> 2, dsh = 2 * g, dil = 1 << dsh;
        const int n = blk >> dsh, r = blk & (dil - 1);
        const int Iq0 = n * 128 + 32 * a, Ik0 = Iq0 - 128;
        const int nskip = Ik0 < 0 ? ((-Ik0) >> 5) : 0;
        const float slope = exp2f(hh < 8 ? -0.5f * (float)(hh + 1) : -(float)(hh - 3));
        const float c1 = 0.125f * 1.4426950408889634f, c2 = slope * (float)dil * 1.4426950408889634f;
        const h16* hb = F.h + (size_t)b * SEQ * NIN + (size_t)r * NIN + hh * 64;
        const size_t rs = (size_t)dil * NIN;
        f16x8 qf[4];
        { const h16* qp = hb + (size_t)(Iq0 + q) * rs + C_Q + 8 * hi;
#pragma unroll
          for (int s4 = 0; s4 < 4; ++s4) qf[s4] = *(const f16x8*)(qp + 16 * s4); }
        f32x16 S[5];
        LAS unsigned char* kt0 = vl + 8448;
#define ATT_K_BATCH(KB0, NB) { f16x8 kg[NB][4]; \
            _Pragma("unroll") for (int kb = 0; kb < NB; ++kb) _Pragma("unroll") for (int i = 0; i < 4; ++i) \
                kg[kb][i] = *(const f16x8*)(hb + (size_t)(Ik0 + 32 * (KB0 + kb) + 8 * i + vw_kv) * rs + C_K + 8 * vw_c); \
            _Pragma("unroll") for (int kb = 0; kb < NB; ++kb) { LAS unsigned char* kt = kt0 + ((KB0 + kb) & 1) * 4096; \
                _Pragma("unroll") for (int i = 0; i < 4; ++i) { const int kv_ = 8 * i + vw_kv; *(LAS f16x8*)(kt + kv_ * 128 + ((vw_c ^ ((kv_ >> 1) & 7)) << 4)) = kg[kb][i]; } \
                _Pragma("unroll") for (int e = 0; e < 16; ++e) S[KB0 + kb][e] = 0.f; \
                _Pragma("unroll") for (int s4 = 0; s4 < 4; ++s4) { const f16x8 kf_ = *(const LAS f16x8*)(kt + q * 128 + (((2 * s4 + hi) ^ ((q >> 1) & 7)) << 4)); \
                    S[KB0 + kb] = MFMA32(kf_, qf[s4], S[KB0 + kb]); } } }
        ATT_K_BATCH(0, 3)
        ATT_K_BATCH(3, 2)
#undef ATT_K_BATCH
        f16x8 vgA[3][4], vgB[2][4];
#pragma unroll
        for (int kb = 0; kb < 3; ++kb) {
            const int kbc = kb;
#pragma unroll
            for (int i = 0; i < 4; ++i) vgA[kb][i] = *(const f16x8*)(hb + (size_t)(Ik0 + 32 * kbc + 8 * i + vw_kv) * rs + C_VV + 8 * vw_c);
        }
        int qq = q; asm volatile("" : "+v"(qq));
        const float nb = -c2 * (float)(qq + 128 - 4 * hi);
        const int qrel = qq - 4 * hi;
        float m = -INFINITY;
#pragma unroll
        for (int kb = 0; kb < 5; ++kb)
#pragma unroll
            for (int e = 0; e < 16; ++e) {
                const int ec = (e & 3) + 8 * (e >> 2);
                float v = __builtin_fmaf(S[kb][e], c1, __builtin_fmaf(c2, (float)(32 * kb + ec), nb));
                bool ok = kb >= nskip;
                if (kb == 0) ok = ok && (ec >= qrel);
                if (kb == 4) ok = ok && (ec <= qrel);
                v = ok ? v : -INFINITY;
                S[kb][e] = v; m = fmaxf(m, v);
            }
        m = fmaxf(m, __shfl_xor(m, 32));
        float l = 0.f;
        f16x8 pf[5][2];
#pragma unroll
        for (int kb = 0; kb < 5; ++kb)
#pragma unroll
            for (int e = 0; e < 16; ++e) { const float p = __builtin_amdgcn_exp2f(S[kb][e] - m); l += p; pf[kb][e >> 3][e & 7] = (h16)p; }
        l += __shfl_xor(l, 32);
#pragma unroll
        for (int kb = 3; kb < 5; ++kb) {
            const int kbc = kb;
#pragma unroll
            for (int i = 0; i < 4; ++i) vgB[kb - 3][i] = *(const f16x8*)(hb + (size_t)(Ik0 + 32 * kbc + 8 * i + vw_kv) * rs + C_VV + 8 * vw_c);
        }
        f32x16 O[2];
#pragma unroll
        for (int e = 0; e < 16; ++e) { O[0][e] = 0.f; O[1][e] = 0.f; }
#pragma unroll
        for (int kb = 0; kb < 5; ++kb) {
            LAS unsigned char* vb = vl + (kb & 1) * 4224;
#pragma unroll
            for (int i = 0; i < 4; ++i) *(LAS f16x8*)(vb + vw_off + i * 512) = (kb < 3) ? vgA[kb < 3 ? kb : 0][i] : vgB[kb >= 3 ? kb - 3 : 0][i];
#pragma unroll
            for (int s2 = 0; s2 < 2; ++s2) {
#pragma unroll
                for (int db = 0; db < 2; ++db) {
                    const v4i16_t lo = __builtin_amdgcn_ds_read_tr16_b64_v4i16((LAS v4i16_t*)(vb + tr_base + db * 2112 + s2 * 1024));
                    const v4i16_t hi4 = __builtin_amdgcn_ds_read_tr16_b64_v4i16((LAS v4i16_t*)(vb + tr_base + db * 2112 + s2 * 1024 + 512));
                    typedef short s16x8 __attribute__((ext_vector_type(8)));
                    const s16x8 vv = (s16x8){lo[0], lo[1], lo[2], lo[3], hi4[0], hi4[1], hi4[2], hi4[3]};
                    O[db] = MFMA32(__builtin_bit_cast(f16x8, vv), pf[kb][s2], O[db]);
                }
            }
        }
        const float rl = 1.0f / l;
        const size_t tq = (size_t)b * SEQ + (size_t)(Iq0 + q) * dil + r;
        {
            LAS unsigned char* ot = vl;
#pragma unroll
            for (int db = 0; db < 2; ++db)
#pragma unroll
                for (int r4 = 0; r4 < 4; ++r4) { f16x4 w;
#pragma unroll
                    for (int e = 0; e < 4; ++e) w[e] = (h16)(O[db][4 * r4 + e] * rl);
                    const int d0 = 32 * db + 8 * r4 + 4 * hi;
                    *(LAS f16x4*)(ot + q * 128 + ((((d0 >> 3) ^ (q & 7)) << 4) | ((d0 & 7) * 2))) = w; }
#pragma unroll
            for (int j = 0; j < 4; ++j) { const int row = 8 * j + (lane >> 3), ch = lane & 7;
                const f16x8 v = *(const LAS f16x8*)(ot + row * 128 + ((ch ^ (row & 7)) << 4));
                const size_t tr = (size_t)b * SEQ + (size_t)(Iq0 + row) * dil + r;
                *(f16x8*)(F.ao + tr * 768 + hh * 64 + 8 * ch) = v; }
        }
        if (hi == 0) F.lse[tq * 12 + hh] = (m + __builtin_amdgcn_logf(l)) * 0.6931471805599453f;
    }
#if CONV_IN_ATTN
    conv_experts_dyn(F);
#endif
}
__device__ __forceinline__ void attn_merge_chunk(Frame& F, int t0) {
    for (int idx = F.tid; idx < 4096; idx += NTHREADS) {
        const int c = idx & 7, hg = (idx >> 3) & 3, t = t0 + (idx >> 5);
        const float l0 = F.lse[(size_t)t * 12 + hg], l1 = F.lse[(size_t)t * 12 + 4 + hg], l2 = F.lse[(size_t)t * 12 + 8 + hg];
        const float mx = fmaxf(l0, fmaxf(l1, l2)); float w0 = __expf(l0 - mx), w1 = __expf(l1 - mx), w2 = __expf(l2 - mx); const float inv = 1.0f / (w0 + w1 + w2);
        w0 *= inv; w1 *= inv; w2 *= inv;
        const h16* ap = F.ao + (size_t)t * 768 + hg * 64 + 8 * c;
        const f16x8 a0 = *(const f16x8*)ap, a1 = *(const f16x8*)(ap + 256), a2 = *(const f16x8*)(ap + 512);
        f16x8 o;
#pragma unroll
        for (int e = 0; e < 8; ++e) o[e] = (h16)(w0 * (float)a0[e] + w1 * (float)a1[e] + w2 * (float)a2[e]);
        *(f16x8*)(F.yb + (size_t)t * 256 + hg * 64 + 8 * c) = o;
    }
}

__device__ __forceinline__ void ph_gmlp_simple(Frame& F) {
    float* Vl = (float*)F.lds;
    float* Wl = Vl + 128 * 128;
    float* st = Wl + 128 * 129;
    const int tid = F.tid, lane = F.lane, wave = F.wave;
    for (int ch = F.bid; ch < T / 128; ch += F.G) {
        const int t0 = ch * 128;
#if USE_FAST_ATTN
        attn_merge_chunk(F, t0);
#endif
        for (int i = 0; i < 16; ++i) {
            const int tl = wave * 16 + i; const h16* vp = F.h + (size_t)(t0 + tl) * NIN + C_V;
            const f16x8 a = *(const f16x8*)(vp + 8 * lane), b = *(const f16x8*)(vp + 512 + 8 * lane);
            float s = 0.f;
#pragma unroll
            for (int j = 0; j < 8; ++j) s += (float)a[j] + (float)b[j];
            const float mean = wave_sum(s) * (1.f / 1024.f);
            float q = 0.f;
#pragma unroll
            for (int j = 0; j < 8; ++j) { const float da = (float)a[j] - mean, db = (float)b[j] - mean; q += da * da + db * db; }
            const float rstd = 1.f / sqrtf(wave_sum(q) * (1.f / 1024.f) + LN_EPS);
            if (lane == 0) { st[tl * 2] = mean; st[tl * 2 + 1] = rstd; }
        }
        __syncthreads();
        for (int g = 0; g < 8; ++g) {
            {
                const int sr = tid >> 2, c0 = (tid & 3) * 32; const float mean = st[sr * 2], rstd = st[sr * 2 + 1];
                const h16* vp = F.h + (size_t)(t0 + sr) * NIN + C_V + g * 128 + c0;
#pragma unroll
                for (int j = 0; j < 4; ++j) { const f16x8 a = *(const f16x8*)(vp + 8 * j);
#pragma unroll
                    for (int e = 0; e < 8; ++e) { const int c = c0 + 8 * j + e; Vl[sr * 128 + c] = ((float)a[e] - mean) * rstd * F.gn_g[g * 128 + c] + F.gn_b[g * 128 + c]; } }
            }
            for (int idx = tid; idx < 128 * 128; idx += NTHREADS) { const int tt = idx >> 7, ss = idx & 127; Wl[tt * 129 + ss] = (ss <= tt) ? F.sp_w[(size_t)g * 16384 + idx] : 0.f; }
            __syncthreads();
            {
                const int tt = tid >> 2, c0 = (tid & 3) * 32; float acc[32];
#pragma unroll
                for (int j = 0; j < 32; ++j) acc[j] = 0.f;
                for (int ss = 0; ss < 128; ++ss) { const float w = Wl[tt * 129 + ss];
#pragma unroll
                    for (int j = 0; j < 32; ++j) acc[j] += w * Vl[ss * 128 + c0 + j]; }
                const float sb = F.sp_b[g * 128 + tt];
                const h16* up = F.h + (size_t)(t0 + tt) * NIN + C_U + g * 128 + c0; h16* zp = F.z + (size_t)(t0 + tt) * DM + g * 128 + c0;
#pragma unroll
                for (int j = 0; j < 4; ++j) { const f16x8 uu = *(const f16x8*)(up + 8 * j); f16x8 o;
#pragma unroll
                    for (int e = 0; e < 8; ++e) o[e] = (h16)((float)uu[e] * (acc[8 * j + e] + sb));
                    *(f16x8*)(zp + 8 * j) = o; }
            }
            __syncthreads();
        }
    }
}

constexpr int GM_CB = 8256, GM_IMG = 4 * GM_CB;
__device__ __forceinline__ void gmlp_stage(Frame& F, LAS unsigned char* img, const LAS float* st, int t0, int g) {
#pragma unroll
    for (int i = 0; i < 4; ++i) {
        const int idx = F.tid + i * NTHREADS; const int sr = idx >> 4, cc = idx & 15;
        const f16x8 v = *(const f16x8*)(F.h + (size_t)(t0 + sr) * NIN + C_V + g * 128 + 8 * cc);
        const float mean = st[sr * 2], rstd = st[sr * 2 + 1];
        const f32x4 g0 = *(const f32x4*)(F.gn_g + g * 128 + 8 * cc), g1 = *(const f32x4*)(F.gn_g + g * 128 + 8 * cc + 4);
        const f32x4 b0 = *(const f32x4*)(F.gn_b + g * 128 + 8 * cc), b1 = *(const f32x4*)(F.gn_b + g * 128 + 8 * cc + 4);
        f16x8 o;
#pragma unroll
        for (int e = 0; e < 4; ++e) { o[e] = (h16)(((float)v[e] - mean) * rstd * g0[e] + b0[e]); o[4 + e] = (h16)(((float)v[4 + e] - mean) * rstd * g1[e] + b1[e]); }
        *(LAS f16x8*)(img + (cc >> 2) * GM_CB + sr * 64 + (cc & 3) * 16) = o;
    }
}
__device__ __forceinline__ void ph_gmlp_fast(Frame& F, LAS unsigned char* ldsb) {
    LAS float* st = (LAS float*)ldsb;
    LAS unsigned char* img0 = ldsb + 1024;
    const int tid = F.tid, lane = F.lane, wave = F.wave, hi = lane >> 5, li = lane & 15;
    const int cb = wave & 3, half = wave >> 2;
    const int tbA = half ? 1 : 0, tbB = half ? 2 : 3;
    const int nA = 2 * (tbA + 1), nB = 2 * (tbB + 1);
    const int tr_base = cb * GM_CB + (8 * hi + (li >> 2)) * 64 + (16 * ((lane >> 4) & 1) + 4 * (li & 3)) * 2;
    for (int ch = F.bid; ch < T / 128; ch += F.G) {
        const int t0 = ch * 128;
        attn_merge_chunk(F, t0);
        for (int i0 = 0; i0 < 16; i0 += 8) {
            f16x8 a[8], b[8];
#pragma unroll
            for (int i = 0; i < 8; ++i) { const h16* vp = F.h + (size_t)(t0 + wave * 16 + i0 + i) * NIN + C_V; a[i] = *(const f16x8*)(vp + 8 * lane); b[i] = *(const f16x8*)(vp + 512 + 8 * lane); }
#pragma unroll
            for (int i = 0; i < 8; ++i) {
                const int tl = wave * 16 + i0 + i;
                float s_ = 0.f;
#pragma unroll
                for (int j = 0; j < 8; ++j) s_ += (float)a[i][j] + (float)b[i][j];
                const float mean = wave_sum(s_) * (1.f / 1024.f);
                float qv = 0.f;
#pragma unroll
                for (int j = 0; j < 8; ++j) { const float da = (float)a[i][j] - mean, db = (float)b[i][j] - mean; qv += da * da + db * db; }
                const float rstd = 1.f / sqrtf(wave_sum(qv) * (1.f / 1024.f) + LN_EPS);
                if (lane == 0) { st[tl * 2] = mean; st[tl * 2 + 1] = rstd; }
            }
        }
        __syncthreads();
        gmlp_stage(F, img0, st, t0, 0);
        __syncthreads();
        for (int g = 0; g < 8; ++g) {
            LAS unsigned char* img = img0 + (g & 1) * GM_IMG;
            LAS unsigned char* outb = img0 + 2 * GM_IMG + (g & 1) * 32768;
            if (g < 7) gmlp_stage(F, img0 + ((g + 1) & 1) * GM_IMG, st, t0, g + 1);
            f32x16 DA, DB;
#pragma unroll
            for (int e = 0; e < 16; ++e) { DA[e] = 0.f; DB[e] = 0.f; }
            const h16* wa = F.Wc + (size_t)g * 16384 + (size_t)(32 * tbA + (lane & 31)) * 128 + 8 * hi;
            const h16* wb = F.Wc + (size_t)g * 16384 + (size_t)(32 * tbB + (lane & 31)) * 128 + 8 * hi;
#pragma unroll
            for (int ks = 0; ks < 8; ++ks) {
                if (ks < nB) {
                    const v4i16_t lo = __builtin_amdgcn_ds_read_tr16_b64_v4i16((LAS v4i16_t*)(img + tr_base + ks * 1024));
                    const v4i16_t hi4 = __builtin_amdgcn_ds_read_tr16_b64_v4i16((LAS v4i16_t*)(img + tr_base + ks * 1024 + 256));
                    typedef short s16x8 __attribute__((ext_vector_type(8)));
                    const s16x8 vv = (s16x8){lo[0], lo[1], lo[2], lo[3], hi4[0], hi4[1], hi4[2], hi4[3]};
                    const f16x8 af = __builtin_bit_cast(f16x8, vv);
                    const f16x8 bfB = *(const f16x8*)(wb + 16 * ks);
                    DB = MFMA32(af, bfB, DB);
                    if (ks < nA) { const f16x8 bfA = *(const f16x8*)(wa + 16 * ks); DA = MFMA32(af, bfA, DA); }
                }
            }
#pragma unroll
            for (int w2 = 0; w2 < 2; ++w2) {
                const int tb = w2 ? tbB : tbA; const int tt = 32 * tb + (lane & 31);
                const float sb = F.sp_b[g * 128 + tt];
#pragma unroll
                for (int r4 = 0; r4 < 4; ++r4) { f16x4 o;
#pragma unroll
                    for (int e = 0; e < 4; ++e) o[e] = (h16)((w2 ? DB[4 * r4 + e] : DA[4 * r4 + e]) + sb);
                    *(LAS f16x4*)(outb + tt * 256 + (((4 * cb + r4) ^ (tt & 15)) << 4) + 8 * hi) = o; }
            }
            __syncthreads();
#pragma unroll
            for (int i = 0; i < 4; ++i) {
                const int idx = tid + i * NTHREADS; const int tt = idx >> 4, cc = idx & 15;
                const f16x8 vm = *(const LAS f16x8*)(outb + tt * 256 + ((cc ^ (tt & 15)) << 4));
                const f16x8 uu = *(const f16x8*)(F.h + (size_t)(t0 + tt) * NIN + C_U + g * 128 + 8 * cc);
                f16x8 o;
#pragma unroll
                for (int e = 0; e < 8; ++e) o[e] = (h16)((float)uu[e] * (float)vm[e]);
                *(f16x8*)(F.z + (size_t)(t0 + tt) * DM + g * 128 + 8 * cc) = o;
            }
        }
        __syncthreads();
    }
}

__device__ __forceinline__ void ph_ln1(Frame& F) {
    const int gw = F.bid * NWAVES + F.wave, NGW = F.G * NWAVES, lane = F.lane;
    for (int m = gw; m < T; m += NGW) {
        const f32x4* rp = (const f32x4*)(F.out + (size_t)m * DM) + lane;
        f32x4 v[4]; float s = 0.f;
#pragma unroll
        for (int j = 0; j < 4; ++j) { v[j] = rp[64 * j]; s += (v[j][0] + v[j][1]) + (v[j][2] + v[j][3]); }
        const float mean = wave_sum(s) * (1.f / DM); float q = 0.f;
#pragma unroll
        for (int j = 0; j < 4; ++j) { v[j] = v[j] - mean; q += (v[j][0] * v[j][0] + v[j][1] * v[j][1]) + (v[j][2] * v[j][2] + v[j][3] * v[j][3]); }
        const float rstd = 1.f / sqrtf(wave_sum(q) * (1.f / DM) + LN_EPS);
#pragma unroll
        for (int j = 0; j < 4; ++j) { const int c = 4 * lane + 256 * j; const f32x4 g = *(const f32x4*)(F.ln1_g + c), b = *(const f32x4*)(F.ln1_b + c);
            const f32x4 o = v[j] * rstd * g + b; f16x4 w; w[0] = (h16)o[0]; w[1] = (h16)o[1]; w[2] = (h16)o[2]; w[3] = (h16)o[3];
            *(f16x4*)(F.x1 + (size_t)m * DM + c) = w; }
    }
}

template <int CTRL> __device__ __forceinline__ float dppf(float v) { const int b_ = __builtin_bit_cast(int, v); return __builtin_bit_cast(float, __builtin_amdgcn_update_dpp(b_, b_, CTRL, 0xF, 0xF, false)); }
__device__ __forceinline__ void ph_route1(Frame& F) {
    int* cnt = (int*)F.lds; int* base = cnt + 256; int* ebuf = base + 256; int* pbuf = ebuf + 1024;
    const int tid = F.tid, lane = F.lane, wave = F.wave;
    for (int ch = F.bid; ch < T / 128; ch += F.G) {
        if (tid < 256) cnt[tid] = 0;
        __syncthreads();
        for (int i = 0; i < 16; ++i) {
            const int tl = wave * 16 + i, t = ch * 128 + tl;
            const f32x4 lg = *(const f32x4*)(F.logit + (size_t)t * NEXP + 4 * lane);
            const f32x4 rb = *(const f32x4*)(F.r_b + 4 * lane);
            float sc[4], mv[4];
#pragma unroll
            for (int j = 0; j < 4; ++j) { sc[j] = sigmoidf_(lg[j]); mv[j] = sc[j] + rb[j]; }
            float m1 = fmaxf(mv[0], mv[1]), m2 = fminf(mv[0], mv[1]);
#pragma unroll
            for (int j = 2; j < 4; ++j) { const float v = mv[j]; m2 = fmaxf(m2, fminf(m1, v)); m1 = fmaxf(m1, v); }
            { float o1 = dppf<0xB1>(m1), o2 = dppf<0xB1>(m2); m2 = fmaxf(fminf(m1, o1), fmaxf(m2, o2)); m1 = fmaxf(m1, o1); }
            { float o1 = dppf<0x4E>(m1), o2 = dppf<0x4E>(m2); m2 = fmaxf(fminf(m1, o1), fmaxf(m2, o2)); m1 = fmaxf(m1, o1); }
            { float o1 = dppf<0x141>(m1), o2 = dppf<0x141>(m2); m2 = fmaxf(fminf(m1, o1), fmaxf(m2, o2)); m1 = fmaxf(m1, o1); }
            const float gs = m1 + m2; const int grp = lane >> 3;
            int rank = 0;
#pragma unroll
            for (int g = 0; g < 8; ++g) { const float og = __builtin_bit_cast(float, __builtin_amdgcn_readlane(__builtin_bit_cast(int, gs), g * 8)); rank += (og > gs || (og == gs && g < grp)) ? 1 : 0; }
            const bool gsel = rank < 4;
#pragma unroll
            for (int j = 0; j < 4; ++j) mv[j] = gsel ? mv[j] : -INFINITY;
            int my_e = 0; float my_s = 0.f, ssum = 0.f;
            for (int k = 0; k < TOPK; ++k) {
                float bv = mv[0], bsc = sc[0]; int bi = 0;
#pragma unroll
                for (int j = 1; j < 4; ++j) if (mv[j] > bv) { bv = mv[j]; bi = j; bsc = sc[j]; }
                float r = bv;
                r = fmaxf(r, dppf<0xB1>(r)); r = fmaxf(r, dppf<0x4E>(r)); r = fmaxf(r, dppf<0x141>(r)); r = fmaxf(r, dppf<0x140>(r));
                const float r0 = __builtin_bit_cast(float, __builtin_amdgcn_readlane(__builtin_bit_cast(int, r), 0)), r1 = __builtin_bit_cast(float, __builtin_amdgcn_readlane(__builtin_bit_cast(int, r), 16));
                const float r2 = __builtin_bit_cast(float, __builtin_amdgcn_readlane(__builtin_bit_cast(int, r), 32)), r3 = __builtin_bit_cast(float, __builtin_amdgcn_readlane(__builtin_bit_cast(int, r), 48));
                const float M = fmaxf(fmaxf(r0, r1), fmaxf(r2, r3));
                const int L = __builtin_ctzll(__ballot(bv == M));
                const int be = 4 * L + __builtin_amdgcn_readlane(bi, L);
                const float sv = __builtin_bit_cast(float, __builtin_amdgcn_readlane(__builtin_bit_cast(int, bsc), L));
                if (lane == L) {
#pragma unroll
                    for (int j = 0; j < 4; ++j) if (bi == j) mv[j] = -INFINITY;
                }
                ssum += sv;
                if (lane == k) { my_e = be; my_s = sv; }
            }
            if (lane < TOPK) {
                const int lp = atomicAdd(&cnt[my_e], 1);
                ebuf[tl * 8 + lane] = my_e; pbuf[tl * 8 + lane] = lp;
                F.asg_e[t * 8 + lane] = my_e; F.gate[t * 8 + lane] = my_s / ssum * ROUTED_SCALE;
            }
        }
        __syncthreads();
        if (tid < 256) { const int c = cnt[tid]; base[tid] = c ? (int)__hip_atomic_fetch_add(F.ctl + CW_CNT + tid, (unsigned)c, __ATOMIC_RELAXED, __HIP_MEMORY_SCOPE_AGENT) : 0; }
        __syncthreads();
        for (int idx = tid; idx < 1024; idx += NTHREADS) F.asg_pos[ch * 1024 + idx] = base[ebuf[idx]] + pbuf[idx];
        __syncthreads();
    }
}
__device__ __forceinline__ void ph_route2(Frame& F) {
    int* pstart = (int*)F.lds; int* cn = pstart + 257;
    const int tid = F.tid;
    if (tid < 256) cn[tid] = (int)__hip_atomic_load(F.ctl + CW_CNT + tid, __ATOMIC_RELAXED, __HIP_MEMORY_SCOPE_AGENT);
    __syncthreads();
    if (tid == 0) { int run = T; for (int e = 0; e < 256; ++e) { pstart[e] = run; run += (cn[e] + 255) & ~255; } pstart[256] = run; }
    __syncthreads();
    for (int ch = F.bid; ch < T / 128; ch += F.G) {
        for (int idx = tid; idx < 1024; idx += NTHREADS) { const int a = ch * 1024 + idx; const int e = F.asg_e[a], row = pstart[e] + F.asg_pos[a]; F.row_tok[row] = a >> 3; F.row_dst[row] = a; }
        if (tid < 128) { const int r = ch * 128 + tid; F.row_tok[r] = r; F.row_dst[r] = NASG + r; }
    }
    for (int e = F.bid; e < 256; e += F.G) {
        const int p0 = pstart[e], c = cn[e], p1 = pstart[e + 1];
        for (int row = p0 + c + tid; row < p1; row += NTHREADS) { F.row_tok[row] = 0; F.row_dst[row] = -1; }
        for (int tl = (p0 >> 8) + tid; tl < (p1 >> 8); tl += NTHREADS) F.tile_e[tl] = e;
    }
    if (F.bid == 0) {
        if (tid < 128) F.tile_e[tid] = 256;
        if (tid == 0) F.ctl[CW_NT] = (unsigned)(pstart[256] >> 8);
    }
}

__device__ __forceinline__ void ph_combine(Frame& F, LAS unsigned char* ldsb) {
    const int gw = F.bid * NWAVES + F.wave, NGW = F.G * NWAVES, lane = F.lane;
    for (int tb = gw * 2; tb < T; tb += NGW * 2) {
        f16x8 xr[2][2]; u32x4 yr[2][9]; float gt[2][8];
#pragma unroll
        for (int u = 0; u < 2; ++u) {
            const int t = tb + u;
            const h16* xp = F.x1 + (size_t)t * DM + 16 * lane; const unsigned char* yp = F.y + (size_t)t * 8 * DM + 16 * lane; const unsigned char* sp = F.y + (size_t)(NASG + t) * DM + 16 * lane;
            xr[u][0] = *(const f16x8*)xp; xr[u][1] = *(const f16x8*)(xp + 8);
#pragma unroll
            for (int k = 0; k < 8; ++k) yr[u][k] = __builtin_nontemporal_load((const u32x4*)(yp + (size_t)k * DM));
            yr[u][8] = __builtin_nontemporal_load((const u32x4*)sp);
#pragma unroll
            for (int k = 0; k < 8; ++k) gt[u][k] = F.gate[t * 8 + k] * Y_INV;
        }
#pragma unroll
        for (int u = 0; u < 2; ++u) {
            const int t = tb + u;
            float acc[16];
            __builtin_amdgcn_sched_barrier(0);
#pragma unroll
            for (int d = 0; d < 4; ++d) {
                const f32x2 s0 = __builtin_amdgcn_cvt_pk_f32_fp8((int)yr[u][8][d], false), s1 = __builtin_amdgcn_cvt_pk_f32_fp8((int)yr[u][8][d], true);
                float a0 = s0.x * Y_INV, a1 = s0.y * Y_INV, a2 = s1.x * Y_INV, a3 = s1.y * Y_INV;
#pragma unroll
                for (int k = 0; k < 8; ++k) { const f32x2 p0 = __builtin_amdgcn_cvt_pk_f32_fp8((int)yr[u][k][d], false), p1 = __builtin_amdgcn_cvt_pk_f32_fp8((int)yr[u][k][d], true);
                    a0 += gt[u][k] * p0.x; a1 += gt[u][k] * p0.y; a2 += gt[u][k] * p1.x; a3 += gt[u][k] * p1.y; }
                acc[4 * d] = a0; acc[4 * d + 1] = a1; acc[4 * d + 2] = a2; acc[4 * d + 3] = a3;
            }
#pragma unroll
            for (int e = 0; e < 8; ++e) { acc[e] += ALPHA * (float)xr[u][0][e]; acc[8 + e] += ALPHA * (float)xr[u][1][e]; }
            float s = 0.f;
#pragma unroll
            for (int j = 0; j < 16; ++j) s += acc[j];
            const float mean = wave_sum(s) * (1.f / DM); float q = 0.f;
#pragma unroll
            for (int j = 0; j < 16; ++j) { acc[j] -= mean; q += acc[j] * acc[j]; }
            const float rstd = 1.f / sqrtf(wave_sum(q) * (1.f / DM) + LN_EPS);
            LAS float* stg = (LAS float*)ldsb + F.wave * 1024;
#pragma unroll
            for (int qd = 0; qd < 4; ++qd) { f32x4 o;
#pragma unroll
                for (int e = 0; e < 4; ++e) o[e] = acc[4 * qd + e] * rstd;
                *(LAS f32x4*)(stg + 16 * lane + 4 * qd) = o; }
#pragma unroll
            for (int j = 0; j < 4; ++j) { const int c = 4 * lane + 256 * j; const f32x4 v = *(const LAS f32x4*)(stg + c);
                const f32x4 g = *(const f32x4*)(F.ln2_g + c), b = *(const f32x4*)(F.ln2_b + c);
                *(f32x4*)(F.out + (size_t)t * DM + c) = v * g + b; }
        }
    }
}

#if USE_FAST_ATTN
#define ATTN_PHASE ph_attn_fast(F, (LAS unsigned char*)lds)
#else
#define ATTN_PHASE ph_attn_simple(F)
#endif
#ifndef USE_FAST_GMLP
#define USE_FAST_GMLP 1
#endif
#if USE_FAST_GMLP
#define GMLP_PHASE ph_gmlp_fast(F, (LAS unsigned char*)lds)
#else
#define GMLP_PHASE ph_gmlp_simple(F)
#endif
#ifndef PROBE_MODE
#define PROBE_MODE 0
#endif
#ifndef DUP_MASK
#define DUP_MASK 0
#endif
#ifndef USE_FAST_GEMM
#define USE_FAST_GEMM 1
#endif
#if USE_FAST_GEMM
#define GEMM(P, E) fg::gemm_fast((LAS unsigned char*)lds, P, E)
#else
#define GEMM(P, E) gemm_simple(P, E)
#endif
enum { PH_PRO = 0, PH_INPROJ, PH_ATTN, PH_GMLP, PH_YB, PH_YA, PH_OUTW, PH_LN1, PH_ROUTER, PH_ROUTE1, PH_ROUTE2, PH_MOE1, PH_MOE2, PH_COMBINE, N_PHASES };

__global__ void __launch_bounds__(NTHREADS, 2) mk_fwd(Args args) {
    extern __shared__ __attribute__((aligned(16))) unsigned char lds[];
    Frame F;
    F.lds = lds; F.tid = threadIdx.x; F.lane = F.tid & 63; F.wave = __builtin_amdgcn_readfirstlane(F.tid >> 6); F.G = gridDim.x; F.bid = blockIdx.x;
    unsigned char* ws = args.ws;
    F.ctl = (unsigned*)(ws + WS_CTL);
    F.x = args.in[0]; F.in_w = args.in[1]; F.in_b = args.in[2]; F.gn_g = args.in[3]; F.gn_b = args.in[4]; F.sp_w = args.in[5]; F.sp_b = args.in[6]; F.pa_w = args.in[7];
    F.pb_w = args.in[8]; F.out_w = args.in[9]; F.ln1_g = args.in[10]; F.ln1_b = args.in[11]; F.r_w = args.in[12]; F.r_b = args.in[13]; F.e_wg = args.in[14]; F.e_wu = args.in[15];
    F.e_wd = args.in[16]; F.s_wg = args.in[17]; F.s_wu = args.in[18]; F.s_wd = args.in[19]; F.ln2_g = args.in[20]; F.ln2_b = args.in[21];
    F.out = args.out;
    F.WinT = (h16*)(ws + WS_WIN); F.WaT = (h16*)(ws + WS_WA); F.WoT = (h16*)(ws + WS_WO); F.WbT = (h16*)(ws + WS_WB); F.WrT = (h16*)(ws + WS_WR);
    F.W1t = (h16*)(ws + WS_W1T); F.W2t = (h16*)(ws + WS_W2T); F.x16 = (h16*)(ws + WS_X16); F.x1 = (h16*)(ws + WS_X1); F.yb = (h16*)(ws + WS_YB); F.z = (h16*)(ws + WS_Z);
    F.merged = (h16*)(ws + WS_MERGED); F.h = (h16*)(ws + WS_H); F.hid = (h16*)(ws + WS_HID); F.y = (unsigned char*)(ws + WS_Y);
    F.logit = (float*)(ws + WS_LOGIT); F.gate = (float*)(ws + WS_GATE); F.lse = (float*)(ws + WS_LSE); F.ao = (h16*)(ws + WS_AO); F.Wc = (h16*)(ws + WS_WC);
    F.asg_e = (int*)(ws + WS_ASGE); F.asg_pos = (int*)(ws + WS_ASGP); F.row_tok = (int*)(ws + WS_ROWTOK); F.row_dst = (int*)(ws + WS_ROWDST); F.tile_e = (int*)(ws + WS_TILEE);

    volatile LAS unsigned* MISC = (volatile LAS unsigned*)((LAS unsigned char*)lds + (LDS_BYTES - 64));
    if (F.tid < 16) MISC[F.tid] = 0u;
    __syncthreads();
    XcdBarrier bar; bar.bar = F.ctl + CW_BAR; bar.x = 0; bar.st = nullptr;
    const int lo = args.ph_lo, hi = args.ph_hi;
    if (hi - lo > 1) bar = xcd_barrier_post(F.ctl + CW_BAR, MISC + 8);
#define IN(k) (lo <= (k) && (k) < hi)
#define REP(k) for (int rep_ = 0; rep_ < ((((DUP_MASK) >> (k)) & 1) ? 2 : 1); ++rep_)
#define SEAM(k) do { if (IN(k) && IN((k) + 1)) xcd_barrier(bar); } while (0)

    if (IN(PH_PRO)) REP(PH_PRO) { ph_prologue(F); } SEAM(PH_PRO);
    if (IN(PH_INPROJ)) REP(PH_INPROJ) { ProbDense P{F.x16, F.WinT, T, NIN, 1024, F.G, F.bid}; EpiInProj E{F.h, F.in_b, rep_ ? PROBE_MODE : 0}; GEMM(P, E); } SEAM(PH_INPROJ);
    if (IN(PH_ATTN)) REP(PH_ATTN) { ATTN_PHASE; } SEAM(PH_ATTN);
    if (IN(PH_GMLP)) REP(PH_GMLP) { GMLP_PHASE; } SEAM(PH_GMLP);
    if (IN(PH_YB)) REP(PH_YB) { ProbDense P{F.yb, F.WbT, T, DM, 256, F.G, F.bid}; EpiYb E{F.merged, F.h}; GEMM(P, E); }
    if (IN(PH_YA)) REP(PH_YA) { ProbDense P{F.z, F.WaT, T, DM, 1024, F.G, F.bid}; EpiYa E{F.merged, F.h}; GEMM(P, E); } SEAM(PH_YA);
    if (IN(PH_OUTW)) {
        PanelStats st{(unsigned long long*)(ws + WS_XBUF), F.ctl + CW_PANEL, LN_EPS}; EpiLn1 E{F.x1, F.x, F.ln1_g, F.ln1_b, st};
        const int nround = (512 + F.G - 1) / F.G;
        for (int ri = 0; ri < nround; ++ri) { ProbDenseR P; P.A = F.merged; P.Bt = F.WoT; P.M = T; P.N = DM; P.K = 1024; P.G = F.G; P.c = F.bid; P.ri = ri; GEMM(P, E); __syncthreads(); }
    } SEAM(PH_OUTW);
    if (IN(PH_ROUTER)) REP(PH_ROUTER) { ProbDense P{F.x1, F.WrT, T, NEXP, 1024, F.G, F.bid}; EpiLogit E{F.logit}; GEMM(P, E); } SEAM(PH_ROUTER);
    if (IN(PH_ROUTE1)) REP(PH_ROUTE1) { ph_route1(F); } SEAM(PH_ROUTE1);
    if (IN(PH_ROUTE2)) REP(PH_ROUTE2) { ph_route2(F); } SEAM(PH_ROUTE2);
    if (IN(PH_MOE1)) REP(PH_MOE1) { const int NT = (int)__hip_atomic_load(F.ctl + CW_NT, __ATOMIC_RELAXED, __HIP_MEMORY_SCOPE_AGENT);
        ProbMoe1 P{F.x1, F.W1t, F.row_tok, F.tile_e, NT, 1024, F.G, F.bid}; EpiMoe1 E{F.hid}; GEMM(P, E); } SEAM(PH_MOE1);
    if (IN(PH_MOE2)) REP(PH_MOE2) { const int NT = (int)__hip_atomic_load(F.ctl + CW_NT, __ATOMIC_RELAXED, __HIP_MEMORY_SCOPE_AGENT);
        ProbMoe2 P{F.hid, F.W2t, F.tile_e, NT, 256, F.G, F.bid}; EpiMoe2 E{F.y, F.row_dst, rep_ ? PROBE_MODE : 0}; GEMM(P, E); } SEAM(PH_MOE2);
    if (IN(PH_COMBINE)) REP(PH_COMBINE) { ph_combine(F, (LAS unsigned char*)lds); }
#undef IN
#undef SEAM
}

extern "C" void kernel_launch(void* const* d_in, const int* in_sizes, int n_in, void* d_out, int out_size, void* d_ws, size_t ws_size, hipStream_t stream) {
    static int grid = 0;
    if (grid == 0) {
        if (n_in != 22 || in_sizes[0] != T * DM || out_size != T * DM || ws_size < WS_END) {
            fprintf(stderr, "kernel_launch: unexpected problem: n_in %d in0 %d out %d ws %zu (need %zu); nothing launched\n", n_in, n_in > 0 ? in_sizes[0] : -1, out_size, ws_size, (size_t)WS_END);
            grid = -1; return; }
        int dev = 0, cus = 0;
        if (hipGetDevice(&dev) != hipSuccess || hipDeviceGetAttribute(&cus, hipDeviceAttributeMultiprocessorCount, dev) != hipSuccess) { grid = -1; return; }
        if (hipFuncSetAttribute((const void*)mk_fwd, hipFuncAttributeMaxDynamicSharedMemorySize, LDS_BYTES) != hipSuccess) { fprintf(stderr, "kernel_launch: hipFuncSetAttribute failed\n"); grid = -1; return; }
        int per_cu = 0;
        if (hipOccupancyMaxActiveBlocksPerMultiprocessor(&per_cu, (const void*)mk_fwd, NTHREADS, LDS_BYTES) != hipSuccess || per_cu < 1) fprintf(stderr, "kernel_launch: occupancy query reports %d\n", per_cu);
        (void)hipGetLastError();
        grid = cus;
    }
    if (grid < 0) return;
    (void)hipMemsetAsync((char*)d_ws + WS_CTL, 0, CTL_ZERO_BYTES, stream);
    Args a{};
    for (int i = 0; i < 22; ++i) a.in[i] = (const float*)d_in[i];
    a.out = (float*)d_out; a.ws = (unsigned char*)d_ws;
    constexpr int NL = MK_N_LAUNCHES;
    for (int li = 0; li < NL; ++li) {
        a.ph_lo = (NL == 1) ? 0 : li; a.ph_hi = (NL == 1) ? (int)N_PHASES : li + 1;
        hipLaunchKernelGGL(mk_fwd, dim3(grid), dim3(NTHREADS), LDS_BYTES, stream, a);
    }
}
```

```cpp
#include <hip/hip_runtime.h>
#include <cstdio>
#include <cstdint>
#include <cmath>

#ifndef USE_FAST_ATTN
#define USE_FAST_ATTN 1
#endif
#ifndef CONV_IN_ATTN
#define CONV_IN_ATTN 1
#endif
#ifndef ATTN_WAVES
#define ATTN_WAVES 5
#endif
#ifndef MK_N_LAUNCHES
#define MK_N_LAUNCHES 1
#endif

#ifndef USE_BF16
#define USE_BF16 1
#endif
#if USE_BF16
typedef __bf16 h16;
typedef __bf16 f16x8 __attribute__((ext_vector_type(8)));
typedef __bf16 f16x4 __attribute__((ext_vector_type(4)));
typedef __bf16 f16x2 __attribute__((ext_vector_type(2)));
#define MFMA16(a, b, c) __builtin_amdgcn_mfma_f32_16x16x32_bf16(a, b, c, 0, 0, 0)
#define MFMA32(a, b, c) __builtin_amdgcn_mfma_f32_32x32x16_bf16(a, b, c, 0, 0, 0)
#else
typedef _Float16 h16;
typedef _Float16 f16x8 __attribute__((ext_vector_type(8)));
typedef _Float16 f16x4 __attribute__((ext_vector_type(4)));
typedef _Float16 f16x2 __attribute__((ext_vector_type(2)));
#define MFMA16(a, b, c) MFMA16(a, b, c)
#define MFMA32(a, b, c) MFMA32(a, b, c)
#endif
typedef float f32x4 __attribute__((ext_vector_type(4)));
typedef float f32x2 __attribute__((ext_vector_type(2)));
typedef unsigned u32x4 __attribute__((ext_vector_type(4)));
typedef unsigned u32x2 __attribute__((ext_vector_type(2)));
typedef int i32x4 __attribute__((ext_vector_type(4)));
typedef int i32x8 __attribute__((ext_vector_type(8)));
typedef long i64x2 __attribute__((ext_vector_type(2)));
#define MFMA16_F8(a0, a1, b0, b1, c) __builtin_amdgcn_mfma_scale_f32_16x16x128_f8f6f4( \
    __builtin_shufflevector(__builtin_bit_cast(i32x4, a0), __builtin_bit_cast(i32x4, a1), 0, 1, 2, 3, 4, 5, 6, 7), \
    __builtin_shufflevector(__builtin_bit_cast(i32x4, b0), __builtin_bit_cast(i32x4, b1), 0, 1, 2, 3, 4, 5, 6, 7), c, 0, 0, 0, 0x7F7F7F7F, 0, 0x7F7F7F7F)
#define LAS __attribute__((address_space(3)))

constexpr int T = 32768, DM = 1024, NIN = 6400, SEQ = 4096;
constexpr int NEXP = 256, TOPK = 8, EDIM = 256, NASG = T * TOPK;
constexpr int MAXTILES = 1408, MAXROWS = MAXTILES * 256;
constexpr int C_U = 0, C_V = 1024, C_Q = 2048, C_K = 2816, C_VV = 3584, C_GA = 4352, C_GB = 5376;
constexpr float ALPHA = 1.189207115002721f;
constexpr float LN_EPS = 1e-5f;
constexpr float ROUTED_SCALE = 2.5f;
constexpr int NWAVES = 8, NTHREADS = 512;
constexpr float SC_X1 = 16.0f, SC_W = 512.0f, SC_HID = 8.0f, F8_MAX = 448.0f;
constexpr int LDS_BYTES = 147456;

constexpr size_t MiB = 1u << 20;
constexpr size_t WS_CTL = 0, CTL_ZERO_BYTES = 1 * MiB;
constexpr size_t WS_WIN = 1 * MiB;
constexpr size_t WS_WA = 14 * MiB;
constexpr size_t WS_WO = 16 * MiB;
constexpr size_t WS_WB = 18 * MiB;
constexpr size_t WS_WR = 19 * MiB;
constexpr size_t WS_WC = 19 * MiB + 512 * 1024;
constexpr size_t WS_ASGE = 20 * MiB;
constexpr size_t WS_ASGP = 21 * MiB;
constexpr size_t WS_GATE = 22 * MiB;
constexpr size_t WS_ROWTOK = 23 * MiB;
constexpr size_t WS_ROWDST = 24 * MiB + 512 * 1024;
constexpr size_t WS_TILEE = 26 * MiB;
constexpr size_t WS_W2T = 27 * MiB;
constexpr size_t WS_X1F8 = 92 * MiB;
constexpr size_t WS_X16 = 156 * MiB;
constexpr size_t WS_X1 = WS_X16;
constexpr size_t WS_YB = 220 * MiB;
constexpr size_t WS_Z = 236 * MiB;
constexpr size_t WS_LOGIT = 236 * MiB;
constexpr size_t WS_MERGED = 300 * MiB;
constexpr size_t WS_W1T = 364 * MiB;
constexpr size_t WS_H = 621 * MiB;
constexpr size_t WS_HID = 848 * MiB;
constexpr size_t WS_Y = 220 * MiB;
constexpr size_t WS_AO = 300 * MiB;
constexpr size_t WS_LSE = 1021 * MiB;
constexpr size_t WS_XBUF = 621 * MiB;
constexpr size_t WS_END = 1024 * MiB;
static_assert(WS_H + (size_t)T * NIN * 2 <= WS_END && WS_HID + (size_t)MAXROWS * 256 * 2 <= WS_END && WS_Y + (size_t)(NASG + T) * 1024 * 2 <= WS_HID, "ws map");
static_assert(WS_W1T + (size_t)257 * 512 * 1024 <= WS_H && WS_W2T + (size_t)257 * 1024 * 256 <= WS_X1F8 && WS_X1F8 + (size_t)T * 1024 <= WS_X16, "ws map 2");
constexpr int CW_NT = 8;
constexpr int CW_CNT = 64;
constexpr int CW_BAR = 4096;
constexpr int CW_CONVQ = 1024;
constexpr int CW_PANEL = 16384;

__device__ __forceinline__ f16x8 pack8(f32x4 a, f32x4 b) {
    f16x8 r;
    r[0] = (h16)a[0]; r[1] = (h16)a[1]; r[2] = (h16)a[2]; r[3] = (h16)a[3];
    r[4] = (h16)b[0]; r[5] = (h16)b[1]; r[6] = (h16)b[2]; r[7] = (h16)b[3];
    return r;
}
__device__ __forceinline__ float sigmoidf_(float x) { return __builtin_amdgcn_rcpf(1.0f + __builtin_amdgcn_exp2f(x * -1.4426950408889634f)); }
__device__ __forceinline__ float gelu_erf(float x) { return 0.5f * x * (1.0f + erff(x * 0.7071067811865476f)); }
__device__ __forceinline__ f32x2 gelu_pk(f32x2 v) {
    const f32x2 av = __builtin_elementwise_abs(v), d = av * 0.2316418882f + 1.0f;
    f32x2 t; t.x = __builtin_amdgcn_rcpf(d.x); t.y = __builtin_amdgcn_rcpf(d.y);
    f32x2 q = t * 0.5307027145f + (-0.7265760135f); q = q * t + 0.7107068705f; q = q * t + (-0.142248368f); q = q * t + 0.127414796f; q = q * t;
    const f32x2 s = (v * v) * (-0.72134752044f);
    f32x2 e; e.x = __builtin_amdgcn_exp2f(s.x); e.y = __builtin_amdgcn_exp2f(s.y);
    const f32x2 m = v * (q * e), r = v - m;
    f32x2 o; o.x = v.x < 0.f ? m.x : r.x; o.y = v.y < 0.f ? m.y : r.y; return o;
}
__device__ __forceinline__ float wave_sum(float v) {
#pragma unroll
    for (int o = 1; o < 64; o <<= 1) v += __shfl_xor(v, o);
    return v;
}
__device__ __forceinline__ float wave_max(float v) {
#pragma unroll
    for (int o = 1; o < 64; o <<= 1) v = fmaxf(v, __shfl_xor(v, o));
    return v;
}

#define XB_TMO      128
#define XB_XCNT(j)  (256  + 64 * (j))
#define XB_XSUB(j)  (1280 + 64 * (j))
#define XB_XGEN(j)  (2304 + 64 * (j))
#define XB_TOP      3328
#define XB_TOPGEN   3392
#define XCD_BAR_WORDS 3456
#define XB_SPIN_CAP (1u << 22)
__device__ __forceinline__ unsigned xb_ld(unsigned* p)              { return __hip_atomic_load(p, __ATOMIC_RELAXED, __HIP_MEMORY_SCOPE_AGENT); }
__device__ __forceinline__ unsigned xb_add(unsigned* p, unsigned v) { return __hip_atomic_fetch_add(p, v, __ATOMIC_RELAXED, __HIP_MEMORY_SCOPE_AGENT); }
__device__ __forceinline__ unsigned xb_xcc_id() { return (unsigned)__builtin_amdgcn_s_getreg((3 << 11) | 20) & 0xFu; }
#define XB_SPIN(cond, bar) do { unsigned _sp = 0; while (cond) { __builtin_amdgcn_s_sleep(1); \
    if ((++_sp & 255u) == 0u) { if (xb_ld(&(bar)[XB_TMO])) break; if (_sp > XB_SPIN_CAP) { atomicAdd(&(bar)[XB_TMO], 1u); break; } } } } while (0)
struct XcdBarrier { unsigned* bar; unsigned x; volatile LAS unsigned* st; };
__device__ __forceinline__ XcdBarrier xcd_barrier_post(unsigned* bar, volatile LAS unsigned* st) {
    XcdBarrier b; b.bar = bar; b.x = xb_xcc_id(); b.st = st;
    if (threadIdx.x == 0) (void)xb_add(&bar[XB_XCNT(b.x)], 1u);
    return b;
}
__device__ __forceinline__ void xcd_barrier_complete(unsigned* bar, unsigned x, unsigned& nloc, unsigned& nx) {
    const unsigned G = gridDim.x * gridDim.y * gridDim.z;
    unsigned sum, cnt, mine, sp = 0u;
    for (;;) {
        sum = 0u; cnt = 0u; mine = 0u;
#pragma unroll
        for (unsigned j = 0; j < 16; ++j) { const unsigned c = xb_ld(&bar[XB_XCNT(j)]); sum += c; cnt += (c > 0u) ? 1u : 0u; mine = (j == x) ? c : mine; }
        if (sum == G) break;
        __builtin_amdgcn_s_sleep(1);
        if ((++sp & 255u) == 0u) { if (xb_ld(&bar[XB_TMO])) break; if (sp > XB_SPIN_CAP) { atomicAdd(&bar[XB_TMO], 1u); break; } }
    }
    nloc = mine > 0u ? mine : 1u; nx = cnt > 0u ? cnt : 1u;
}
__device__ __forceinline__ void xcd_barrier(const XcdBarrier& b) {
    asm volatile("s_waitcnt vmcnt(0)" ::: "memory");
    __syncthreads();
    if (threadIdx.x == 0) {
        unsigned* bar = b.bar;
        __builtin_amdgcn_s_waitcnt(0);
        unsigned nloc = b.st[0], nx = b.st[1];
        if (nloc == 0u) { xcd_barrier_complete(bar, b.x, nloc, nx); b.st[0] = nloc; b.st[1] = nx; }
        const unsigned old = xb_add(&bar[XB_XSUB(b.x)], 1u);
        const unsigned gen = old / nloc;
        if (old + 1u == (gen + 1u) * nloc) {
            __builtin_amdgcn_fence(__ATOMIC_RELEASE, "agent");
            asm volatile("s_waitcnt vmcnt(0)" ::: "memory");
            const unsigned og = xb_add(&bar[XB_TOP], 1u);
            const unsigned tg = og / nx;
            if (og + 1u == (tg + 1u) * nx) xb_add(&bar[XB_TOPGEN], 1u);
            else XB_SPIN(xb_ld(&bar[XB_TOPGEN]) == tg, bar);
            __builtin_amdgcn_fence(__ATOMIC_ACQUIRE, "agent");
            xb_add(&bar[XB_XGEN(b.x)], 1u);
            asm volatile("s_waitcnt vmcnt(0)" ::: "memory");
        } else {
            XB_SPIN(xb_ld(&bar[XB_XGEN(b.x)]) == gen, bar);
            __builtin_amdgcn_fence(__ATOMIC_ACQUIRE, "agent");
            asm volatile("s_waitcnt vmcnt(0)" ::: "memory");
        }
    }
    __syncthreads();
}

struct Args { const float* in[22]; float* out; unsigned char* ws; int ph_lo, ph_hi; };
struct Frame {
    unsigned char* lds;
    unsigned* ctl;
    int tid, lane, wave, G, bid;
    const float *x, *in_w, *in_b, *gn_g, *gn_b, *sp_w, *sp_b, *pa_w, *pb_w, *out_w, *ln1_g, *ln1_b, *r_w, *r_b, *e_wg, *e_wu, *e_wd, *s_wg, *s_wu, *s_wd, *ln2_g, *ln2_b;
    float* out;
    h16 *WinT, *WaT, *WoT, *WbT, *WrT, *x16, *x1, *yb, *z, *merged, *h;
    unsigned char *W1t, *W2t, *x1f8, *hid;
    unsigned char* y;
    float *logit, *gate, *lse;
    h16* ao; h16* Wc;
    int *asg_e, *asg_pos, *row_tok, *row_dst, *tile_e;
};

struct Unit { int pm, pn; };
template <class Prob, class Epi>
__device__ __forceinline__ void gemm_simple(const Prob& P, const Epi& E) {
    const int tid = threadIdx.x, wid = tid >> 6, lane = tid & 63, wr = wid >> 2, wc = wid & 3, fr = lane & 15, fq = lane >> 4;
    const int K = P.K;
    Unit u;
    for (int i = 0; P.next(i, u); ++i) {
        f32x4 acc[2][2][4][2];
#pragma unroll
        for (int a = 0; a < 2; ++a)
#pragma unroll
            for (int b = 0; b < 2; ++b)
#pragma unroll
                for (int m = 0; m < 4; ++m)
#pragma unroll
                    for (int n = 0; n < 2; ++n) acc[a][b][m][n] = (f32x4){0.f, 0.f, 0.f, 0.f};
        int ao[2][4];
#pragma unroll
        for (int ai = 0; ai < 2; ++ai)
#pragma unroll
            for (int m = 0; m < 4; ++m) ao[ai][m] = P.aoff(u, 128 * ai + 64 * wr + 16 * m + fr) + 8 * fq;
        const h16* ab = P.abase();
        const h16* bt = P.bt(u) + (size_t)(Epi::ADJ ? (64 * wc + 16 * (fr >> 2) + (fr & 3)) : (32 * wc + 8 * (fr >> 2) + (fr & 3))) * K + 8 * fq;
        for (int k0 = 0; k0 < K; k0 += 32) {
            f16x8 af[2][4], wf[2][2];
#pragma unroll
            for (int ai = 0; ai < 2; ++ai)
#pragma unroll
                for (int m = 0; m < 4; ++m) af[ai][m] = *(const f16x8*)(ab + ao[ai][m] + k0);
#pragma unroll
            for (int bj = 0; bj < 2; ++bj)
#pragma unroll
                for (int n = 0; n < 2; ++n) wf[bj][n] = *(const f16x8*)(bt + (size_t)((Epi::ADJ ? 8 : 128) * bj + 4 * n) * K + k0);
#pragma unroll
            for (int ai = 0; ai < 2; ++ai)
#pragma unroll
                for (int bj = 0; bj < 2; ++bj)
#pragma unroll
                    for (int m = 0; m < 4; ++m)
#pragma unroll
                        for (int n = 0; n < 2; ++n)
                            acc[ai][bj][m][n] = MFMA16(wf[bj][n], af[ai][m], acc[ai][bj][m][n]);
        }
        if constexpr (!Epi::AFTER_DRAIN) E(acc, u, wr, wc, fr, fq);
    }
}

namespace fg {
constexpr int BK = 64, HALF = 128, HTB = HALF * BK * 2, STAGE_BYTES = 8 * HTB;
__device__ __forceinline__ int lds_byte(int r, int c) { const int st = (r >> 4) * 2 + (c >> 5), rr = r & 15, cc = c & 31, ob = rr * 64 + cc * 2; return st * 1024 + (ob ^ (((ob >> 9) & 1) << 5)); }
__device__ __forceinline__ void stage_rc(int b, int& R, int& C) { const int st = b / 1024, sb = b % 1024, swz = sb ^ (((sb >> 9) & 1) << 5); R = (st >> 1) * 16 + swz / 64; C = (st & 1) * 32 + (swz % 64) / 2; }
__device__ __forceinline__ int perm32(int rho) { const int n = rho >> 4, i = rho & 15; return 8 * (i >> 2) + 4 * n + (i & 3); }

template <class Prob, class Epi>
__device__ __forceinline__ void gemm_fast(LAS unsigned char* lds, const Prob& P, const Epi& E) {
    const int tid = threadIdx.x, wid = __builtin_amdgcn_readfirstlane(tid >> 6), lane = tid & 63, wr = wid >> 2, wc = wid & 3, fr = lane & 15, fq = lane >> 4;
    const int K = P.K, nt = K / BK;
    unsigned voffB[2];
#pragma unroll
    for (int i = 0; i < 2; ++i) { int R, C; stage_rc(tid * 16 + i * 8192, R, C);
        const int Rb = Epi::ADJ ? (64 * (R >> 5) + 16 * ((R & 15) >> 2) + 4 * ((R >> 4) & 1) + (R & 3)) : ((R & ~31) + perm32(R & 31));
        voffB[i] = (unsigned)(Rb * K + C) * 2u; }
    const size_t kstep = (size_t)(BK * 2);
    const size_t hstep = (size_t)(Epi::ADJ ? 8 : HALF) * K * 2;
    const unsigned ldsw = (unsigned)wid * 1024u;
    const int aoff = lds_byte(wr * 64 + fr, fq * 8), boff = lds_byte(wc * 32 + fr, fq * 8);
#define FG_SA(b, h) (((b) * 2 + (h)) * HTB)
#define FG_SB(b, h) ((4 + (b) * 2 + (h)) * HTB)
#define FG_STAGEB(bufoff, gbase) do { _Pragma("unroll") for (int _i = 0; _i < 2; ++_i) \
        __builtin_amdgcn_global_load_lds((const unsigned*)((const char*)(gbase) + voffB[_i]), (LAS unsigned*)(lds + (bufoff) + ldsw + _i * 8192), 16, 0, 0); } while (0)
#define FG_STAGEA(bufoff, gbase, vo, h) do { _Pragma("unroll") for (int _i = 0; _i < 2; ++_i) \
        __builtin_amdgcn_global_load_lds((const unsigned*)((const char*)(gbase) + (vo)[h][_i]), (LAS unsigned*)(lds + (bufoff) + ldsw + _i * 8192), 16, 0, 0); } while (0)
#define FG_LDA(dst, b, h) do { _Pragma("unroll") for (int m = 0; m < 4; ++m) _Pragma("unroll") for (int k = 0; k < 2; ++k) dst[m][k] = *(const LAS f16x8*)(lds + FG_SA(b, h) + aoff + m * 2048 + k * 1024); } while (0)
#define FG_LDB(dst, b, h) do { _Pragma("unroll") for (int n = 0; n < 2; ++n) _Pragma("unroll") for (int k = 0; k < 2; ++k) dst[n][k] = *(const LAS f16x8*)(lds + FG_SB(b, h) + boff + n * 2048 + k * 1024); } while (0)
#define FG_MMA(ai, bj, At, Bt) do { __builtin_amdgcn_s_setprio(1); _Pragma("unroll") for (int m = 0; m < 4; ++m) _Pragma("unroll") for (int n = 0; n < 2; ++n) _Pragma("unroll") for (int k = 0; k < 2; ++k) \
        acc[ai][bj][m][n] = MFMA16(Bt[n][k], At[m][k], acc[ai][bj][m][n]); __builtin_amdgcn_s_setprio(0); } while (0)
#define FG_MMA8(ai, bj, At, Bt) do { __builtin_amdgcn_s_setprio(1); _Pragma("unroll") for (int m = 0; m < 4; ++m) _Pragma("unroll") for (int n = 0; n < 2; ++n) _Pragma("unroll") for (int k = 0; k < 2; ++k) { \
        const i64x2 b_ = __builtin_bit_cast(i64x2, Bt[n][k]), a_ = __builtin_bit_cast(i64x2, At[m][k]); \
        acc[ai][bj][m][n] = __builtin_amdgcn_mfma_f32_16x16x32_fp8_fp8(b_[0], a_[0], acc[ai][bj][m][n], 0, 0, 0); acc[ai][bj][m][n] = __builtin_amdgcn_mfma_f32_16x16x32_fp8_fp8(b_[1], a_[1], acc[ai][bj][m][n], 0, 0, 0); } __builtin_amdgcn_s_setprio(0); } while (0)
#define FG_MM(ai, bj, At, Bt) do { if constexpr (Prob::F8) FG_MMA8(ai, bj, At, Bt); else FG_MMA(ai, bj, At, Bt); } while (0)
#define FG_WAIT_V(n) asm volatile("s_waitcnt vmcnt(" #n ")" ::: "memory")
#define FG_WAIT_L(n) asm volatile("s_waitcnt lgkmcnt(" #n ")" ::: "memory")
#define FG_BAR __builtin_amdgcn_s_barrier()
#define FG_SCHED __builtin_amdgcn_sched_barrier(0)
#define FG_VOFF(dst, u) do { _Pragma("unroll") for (int _i = 0; _i < 2; ++_i) { int _R, _C; stage_rc(tid * 16 + _i * 8192, _R, _C); _Pragma("unroll") for (int _h = 0; _h < 2; ++_h) dst[_h][_i] = (unsigned)(P.aoff(u, 128 * _h + _R) + _C) * 2u; } } while (0)
    Unit cur, nxt; int ui = 0;
    if (!P.next(0, cur)) return;
    f32x4 acc[2][2][4][2];
#pragma unroll
    for (int a = 0; a < 2; ++a)
#pragma unroll
        for (int b = 0; b < 2; ++b)
#pragma unroll
            for (int m = 0; m < 4; ++m)
#pragma unroll
                for (int n = 0; n < 2; ++n) acc[a][b][m][n] = (f32x4){0.f, 0.f, 0.f, 0.f};
    f16x8 At[4][2], B0[2][2], B1[2][2];
    unsigned vc[2][2], vn[2][2], vs[2][2];
    FG_VOFF(vc, cur);
    const char* Ab = (const char*)P.abase();
    const char* cB = (const char*)P.bt(cur);
    FG_STAGEB(FG_SB(0, 0), cB); FG_STAGEB(FG_SB(0, 1), cB + hstep); FG_STAGEA(FG_SA(0, 0), Ab, vc, 0); FG_STAGEA(FG_SA(0, 1), Ab, vc, 1);
    if (wr == 1) FG_BAR;
    FG_WAIT_V(2); FG_BAR;
    FG_STAGEB(FG_SB(1, 0), cB + kstep); FG_STAGEA(FG_SA(1, 0), Ab + kstep, vc, 0); FG_STAGEB(FG_SB(1, 1), cB + hstep + kstep);
    FG_WAIT_V(6); FG_BAR;
    for (;;) {
        const bool has_next = P.next(ui + 1, nxt);
        const char* nB = cB;
        if (has_next) { FG_VOFF(vn, nxt); nB = (const char*)P.bt(nxt); }
        else {
#pragma unroll
            for (int _h = 0; _h < 2; ++_h)
#pragma unroll
                for (int _i = 0; _i < 2; ++_i) vn[_h][_i] = vc[_h][_i];
        }
        for (int t = 0; t < nt; t += 2) {
            const bool last = (t == nt - 2);
            const char* a1 = Ab + (size_t)(t + 1) * kstep;
            const char* a2 = last ? Ab : Ab + (size_t)(t + 2) * kstep; const char* b2 = last ? nB : cB + (size_t)(t + 2) * kstep;
            const char* a3 = a2 + kstep; const char* b3 = b2 + kstep;
#pragma unroll
            for (int _h = 0; _h < 2; ++_h)
#pragma unroll
                for (int _i = 0; _i < 2; ++_i) vs[_h][_i] = last ? vn[_h][_i] : vc[_h][_i];
            FG_LDB(B0, 0, 0); FG_LDB(B1, 0, 1); FG_SCHED; FG_LDA(At, 0, 0); FG_STAGEA(FG_SA(1, 1), a1, vc, 1);
            FG_WAIT_V(8); FG_WAIT_L(0); FG_BAR; FG_MM(0, 0, At, B0); FG_MM(0, 1, At, B1); FG_BAR; FG_SCHED;
            FG_LDA(At, 0, 1); FG_STAGEB(FG_SB(0, 0), b2); FG_STAGEB(FG_SB(0, 1), b2 + hstep); FG_STAGEA(FG_SA(0, 0), a2, vs, 0);
            FG_WAIT_V(8); FG_WAIT_L(0); FG_BAR; FG_MM(1, 0, At, B0); FG_MM(1, 1, At, B1); FG_BAR; FG_SCHED;
            FG_LDB(B0, 1, 0); FG_LDB(B1, 1, 1); FG_SCHED; FG_LDA(At, 1, 0); FG_STAGEA(FG_SA(0, 1), a2, vs, 1);
            FG_WAIT_V(8); FG_WAIT_L(0); FG_BAR; FG_MM(0, 0, At, B0); FG_MM(0, 1, At, B1); FG_BAR; FG_SCHED;
            FG_LDA(At, 1, 1); FG_STAGEB(FG_SB(1, 0), b3); FG_STAGEB(FG_SB(1, 1), b3 + hstep); FG_STAGEA(FG_SA(1, 0), a3, vs, 0);
            FG_WAIT_V(8); FG_WAIT_L(0); FG_BAR; FG_MM(1, 0, At, B0); FG_MM(1, 1, At, B1); FG_BAR; FG_SCHED;
        }
        if (wr == 0) FG_BAR;
        if constexpr (!Epi::AFTER_DRAIN) E(acc, cur, wr, wc, fr, fq);
        if (!has_next) break;
#pragma unroll
        for (int a = 0; a < 2; ++a)
#pragma unroll
            for (int b = 0; b < 2; ++b)
#pragma unroll
                for (int m = 0; m < 4; ++m)
#pragma unroll
                    for (int n = 0; n < 2; ++n) acc[a][b][m][n] = (f32x4){0.f, 0.f, 0.f, 0.f};
        cur = nxt; cB = nB; ++ui;
#pragma unroll
        for (int _h = 0; _h < 2; ++_h)
#pragma unroll
            for (int _i = 0; _i < 2; ++_i) vc[_h][_i] = vn[_h][_i];
        if (wr == 1) FG_BAR;
    }
    FG_WAIT_V(0);
    FG_BAR;
    if constexpr (Epi::AFTER_DRAIN) E.fused(acc, cur, wr, wc, fr, fq, lds, wid, lane);
#undef FG_SA
#undef FG_SB
#undef FG_STAGEA
#undef FG_STAGEB
#undef FG_LDA
#undef FG_LDB
#undef FG_MMA
#undef FG_MMA8
#undef FG_MM
#undef FG_WAIT_V
#undef FG_WAIT_L
#undef FG_BAR
#undef FG_SCHED
#undef FG_VOFF
}
}

__device__ __forceinline__ int xcd_remap(long L, int nwg) {
    const int q = nwg >> 3, r = nwg & 7, xcd = (int)(L & 7), off = (int)(L >> 3);
    return (xcd < r ? xcd * (q + 1) : r * (q + 1) + (xcd - r) * q) + off;
}
struct ProbDense {
    static constexpr bool F8 = false;
    const h16* A; const h16* Bt; int M, N, K; int G, c;
    __device__ __forceinline__ bool next(int i, Unit& u) const {
        const int nM = M / 256, nN = N / 256, nwg = nM * nN; const long L = (long)i * G + c; if (L >= (long)nwg) return false;
        const int w = (G & 7) ? (int)L : xcd_remap(L, nwg);
        const int nig = 8 * nN, gid = w / nig, fm = gid * 8, gsz = (nM - fm) < 8 ? (nM - fm) : 8, wi = w - gid * nig;
        u.pm = fm + wi % gsz; u.pn = wi / gsz; return true;
    }
    __device__ __forceinline__ const h16* abase() const { return A; }
    __device__ __forceinline__ int aoff(const Unit& u, int r) const { return (256 * u.pm + r) * K; }
    __device__ __forceinline__ const h16* bt(const Unit& u) const { return Bt + (size_t)(256 * u.pn) * K; }
};
struct ProbDenseR : ProbDense { int ri; __device__ __forceinline__ bool next(int i, Unit& u) const { return i == 0 ? ProbDense::next(ri, u) : false; } };
struct ProbMoe1 {
    static constexpr bool F8 = true;
    const h16* X1; const h16* W1t; const int* row_tok; const int* tile_e; int NT; int K; int G, c;
    __device__ __forceinline__ bool next(int i, Unit& u) const {
        const int nwg = NT * 2; const long L = (long)i * G + c; if (L >= (long)nwg) return false;
        const int w = (G & 7) ? (int)L : xcd_remap(L, nwg);
        u.pm = w >> 1; u.pn = w & 1; return true;
    }
    __device__ __forceinline__ const h16* abase() const { return X1; }
    __device__ __forceinline__ int aoff(const Unit& u, int r) const { return row_tok[256 * u.pm + r] * 512; }
    __device__ __forceinline__ const h16* bt(const Unit& u) const { return W1t + (size_t)tile_e[u.pm] * (512 * 512) + (size_t)u.pn * (256 * 512); }
};
struct ProbMoe2 {
    static constexpr bool F8 = true;
    const h16* HID; const h16* W2t; const int* tile_e; int NT; int K; int G, c;
    __device__ __forceinline__ bool next(int i, Unit& u) const {
        const int nwg = NT * 4; const long L = (long)i * G + c; if (L >= (long)nwg) return false;
        const int w = (G & 7) ? (int)L : xcd_remap(L, nwg);
        u.pm = w >> 2; u.pn = w & 3; return true;
    }
    __device__ __forceinline__ const h16* abase() const { return HID; }
    __device__ __forceinline__ int aoff(const Unit& u, int r) const { return (256 * u.pm + r) * 128; }
    __device__ __forceinline__ const h16* bt(const Unit& u) const { return W2t + (size_t)tile_e[u.pm] * (1024 * 128) + (size_t)u.pn * (256 * 128); }
};

__device__ __forceinline__ unsigned pk4_fp8s(f32x4 v, float sc) {
    v = v * sc;
#pragma unroll
    for (int j = 0; j < 4; ++j) v[j] = __builtin_amdgcn_fmed3f(v[j], -F8_MAX, F8_MAX);
    int w = 0; w = __builtin_amdgcn_cvt_pk_fp8_f32(v[0], v[1], w, false); w = __builtin_amdgcn_cvt_pk_fp8_f32(v[2], v[3], w, true); return (unsigned)w; }
#define EPI_LOOP_BEGIN \
    _Pragma("unroll") for (int ai = 0; ai < 2; ++ai) _Pragma("unroll") for (int m = 0; m < 4; ++m) { const int row = 256 * u.pm + 128 * ai + 64 * wr + 16 * m + fr; \
    _Pragma("unroll") for (int bj = 0; bj < 2; ++bj) { const int col = 256 * u.pn + 128 * bj + 32 * wc + 8 * fq; f32x4 v0 = acc[ai][bj][m][0], v1 = acc[ai][bj][m][1];
#define EPI_LOOP_END } }

#define EPI_FENCE asm volatile("" ::: "memory")
struct EpiInProj {
    static constexpr bool AFTER_DRAIN = false; static constexpr bool ADJ = false;
    h16* H; const float* bias; int mode;
    __device__ __forceinline__ void operator()(const f32x4 (&acc)[2][2][4][2], const Unit& u, int wr, int wc, int fr, int fq) const {
        if (mode == 2) { asm volatile("" :: "v"(acc[0][0][0][0]), "v"(acc[1][1][3][1])); return; }
        f32x4 bv[2][2];
#pragma unroll
        for (int bj = 0; bj < 2; ++bj) { const int col = 256 * u.pn + 128 * bj + 32 * wc + 8 * fq; bv[bj][0] = *(const f32x4*)(bias + col); bv[bj][1] = *(const f32x4*)(bias + col + 4); }
        EPI_FENCE;
        EPI_LOOP_BEGIN
            v0 += bv[bj][0]; v1 += bv[bj][1];
            if (u.pn < 8) {
                const f32x2 a_ = gelu_pk((f32x2){v0[0], v0[1]}), b_ = gelu_pk((f32x2){v0[2], v0[3]}), c_ = gelu_pk((f32x2){v1[0], v1[1]}), d_ = gelu_pk((f32x2){v1[2], v1[3]});
                v0 = (f32x4){a_.x, a_.y, b_.x, b_.y}; v1 = (f32x4){c_.x, c_.y, d_.x, d_.y};
            }
            *(f16x8*)(H + (size_t)row * NIN + col) = pack8(v0, v1);
        EPI_LOOP_END
    }
};
struct EpiYb {
    static constexpr bool AFTER_DRAIN = false; static constexpr bool ADJ = false;
    h16* MG; const h16* H;
    __device__ __forceinline__ void operator()(const f32x4 (&acc)[2][2][4][2], const Unit& u, int wr, int wc, int fr, int fq) const {
        f16x8 g[2][4][2];
#pragma unroll
        for (int ai = 0; ai < 2; ++ai)
#pragma unroll
            for (int m = 0; m < 4; ++m)
#pragma unroll
                for (int bj = 0; bj < 2; ++bj) g[ai][m][bj] = *(const f16x8*)(H + (size_t)(256 * u.pm + 128 * ai + 64 * wr + 16 * m + fr) * NIN + C_GB + 256 * u.pn + 128 * bj + 32 * wc + 8 * fq);
        EPI_FENCE;
        EPI_LOOP_BEGIN
#pragma unroll
            for (int j = 0; j < 4; ++j) { v0[j] *= sigmoidf_((float)g[ai][m][bj][j]); v1[j] *= sigmoidf_((float)g[ai][m][bj][4 + j]); }
            *(f16x8*)(MG + (size_t)row * DM + col) = pack8(v0, v1);
        EPI_LOOP_END
    }
};
struct EpiYa {
    static constexpr bool AFTER_DRAIN = false; static constexpr bool ADJ = false;
    h16* MG; const h16* H;
    __device__ __forceinline__ void operator()(const f32x4 (&acc)[2][2][4][2], const Unit& u, int wr, int wc, int fr, int fq) const {
#pragma unroll
        for (int ai = 0; ai < 2; ++ai) {
            f16x8 g[4][2], t[4][2];
#pragma unroll
            for (int m = 0; m < 4; ++m)
#pragma unroll
                for (int bj = 0; bj < 2; ++bj) { const int row = 256 * u.pm + 128 * ai + 64 * wr + 16 * m + fr, col = 256 * u.pn + 128 * bj + 32 * wc + 8 * fq;
                    g[m][bj] = *(const f16x8*)(H + (size_t)row * NIN + C_GA + col); t[m][bj] = *(const f16x8*)(MG + (size_t)row * DM + col); }
            EPI_FENCE;
#pragma unroll
            for (int m = 0; m < 4; ++m)
#pragma unroll
                for (int bj = 0; bj < 2; ++bj) { const int row = 256 * u.pm + 128 * ai + 64 * wr + 16 * m + fr, col = 256 * u.pn + 128 * bj + 32 * wc + 8 * fq;
                    f32x4 v0 = acc[ai][bj][m][0], v1 = acc[ai][bj][m][1];
#pragma unroll
                    for (int j = 0; j < 4; ++j) { v0[j] = v0[j] * sigmoidf_((float)g[m][bj][j]) + (float)t[m][bj][j]; v1[j] = v1[j] * sigmoidf_((float)g[m][bj][4 + j]) + (float)t[m][bj][4 + j]; }
                    *(f16x8*)(MG + (size_t)row * DM + col) = pack8(v0, v1); }
            EPI_FENCE;
        }
    }
};
struct EpiOutW {
    static constexpr bool AFTER_DRAIN = false; static constexpr bool ADJ = false;
    float* R; const float* X;
    __device__ __forceinline__ void operator()(const f32x4 (&acc)[2][2][4][2], const Unit& u, int wr, int wc, int fr, int fq) const {
#pragma unroll
        for (int ai = 0; ai < 2; ++ai)
#pragma unroll
            for (int mh = 0; mh < 2; ++mh) {
                f32x4 xv[2][2][2];
#pragma unroll
                for (int mm = 0; mm < 2; ++mm)
#pragma unroll
                    for (int bj = 0; bj < 2; ++bj) { const int m = 2 * mh + mm; const int row = 256 * u.pm + 128 * ai + 64 * wr + 16 * m + fr, col = 256 * u.pn + 128 * bj + 32 * wc + 8 * fq;
                        xv[mm][bj][0] = *(const f32x4*)(X + (size_t)row * DM + col); xv[mm][bj][1] = *(const f32x4*)(X + (size_t)row * DM + col + 4); }
                EPI_FENCE;
#pragma unroll
                for (int mm = 0; mm < 2; ++mm)
#pragma unroll
                    for (int bj = 0; bj < 2; ++bj) { const int m = 2 * mh + mm; const int row = 256 * u.pm + 128 * ai + 64 * wr + 16 * m + fr, col = 256 * u.pn + 128 * bj + 32 * wc + 8 * fq;
                        *(f32x4*)(R + (size_t)row * DM + col) = xv[mm][bj][0] * ALPHA + acc[ai][bj][m][0]; *(f32x4*)(R + (size_t)row * DM + col + 4) = xv[mm][bj][1] * ALPHA + acc[ai][bj][m][1]; }
                EPI_FENCE;
            }
    }
};
struct PanelStats {
    unsigned long long* xbuf;
    unsigned* cnt;
    float eps;
    __device__ __forceinline__ void run(const f32x4 (&v)[2][2][4][2], const Unit& u, int wr, int wc, int fr, int fq, LAS unsigned char* lds, int wid, int lane) const {
        LAS f32x2* P = (LAS f32x2*)lds;
        LAS f32x2* S = (LAS f32x2*)(lds + 8192);
#pragma unroll
        for (int ai = 0; ai < 2; ++ai)
#pragma unroll
            for (int m = 0; m < 4; ++m) {
                float s = 0.f;
#pragma unroll
                for (int bj = 0; bj < 2; ++bj)
#pragma unroll
                    for (int n = 0; n < 2; ++n) { const f32x4 x = v[ai][bj][m][n]; s += (x[0] + x[1]) + (x[2] + x[3]); }
                s += __shfl_xor(s, 16); s += __shfl_xor(s, 32);
                const float mw = s * (1.0f / 64.0f); float q = 0.f;
#pragma unroll
                for (int bj = 0; bj < 2; ++bj)
#pragma unroll
                    for (int n = 0; n < 2; ++n) { const f32x4 d = v[ai][bj][m][n] - mw; q += (d[0] * d[0] + d[1] * d[1]) + (d[2] * d[2] + d[3] * d[3]); }
                q += __shfl_xor(q, 16); q += __shfl_xor(q, 32);
                if (fq == 0) P[(ai * 128 + wr * 64 + m * 16 + fr) * 4 + wc] = (f32x2){mw, q};
            }
        asm volatile("s_waitcnt lgkmcnt(0)" ::: "memory"); __builtin_amdgcn_s_barrier(); asm volatile("" ::: "memory");
        const int row = wid * 32 + (lane & 31);
        if (lane < 32) {
            const f32x2 a = P[row * 4 + 0], b = P[row * 4 + 1], c = P[row * 4 + 2], d = P[row * 4 + 3];
            const float mt = (a.x + b.x + c.x + d.x) * 0.25f;
            const float da = a.x - mt, db = b.x - mt, dc = c.x - mt, dd = d.x - mt;
            const float m2 = (a.y + b.y) + (c.y + d.y) + 64.0f * ((da * da + db * db) + (dc * dc + dd * dd));
            unsigned long long* slot = xbuf + ((size_t)(u.pm * 256 + row) * 4 + u.pn);
            __hip_atomic_store(slot, ((unsigned long long)__float_as_uint(m2) << 32) | __float_as_uint(mt), __ATOMIC_RELAXED, __HIP_MEMORY_SCOPE_AGENT);
        }
        asm volatile("s_waitcnt vmcnt(0)" ::: "memory");
        if (lane == 0) __hip_atomic_fetch_add(cnt + 64 * u.pm, 1u, __ATOMIC_RELAXED, __HIP_MEMORY_SCOPE_AGENT);
        if (wid == 0) {
            unsigned sp = 0;
            while ((unsigned)__builtin_amdgcn_readfirstlane(__hip_atomic_load(cnt + 64 * u.pm, __ATOMIC_RELAXED, __HIP_MEMORY_SCOPE_AGENT)) < 32u) { __builtin_amdgcn_s_sleep(2); if (++sp > (1u << 22)) break; }
            __builtin_amdgcn_fence(__ATOMIC_ACQUIRE, "agent");
        }
        asm volatile("s_waitcnt vmcnt(0) lgkmcnt(0)" ::: "memory"); __builtin_amdgcn_s_barrier(); asm volatile("" ::: "memory");
        if (lane < 32) {
            const unsigned long long* slot = xbuf + (size_t)(u.pm * 256 + row) * 4; float mt[4], m2[4]; float ms = 0.f;
#pragma unroll
            for (int t = 0; t < 4; ++t) { const unsigned long long w = __hip_atomic_load(slot + t, __ATOMIC_RELAXED, __HIP_MEMORY_SCOPE_AGENT); mt[t] = __uint_as_float((unsigned)w); m2[t] = __uint_as_float((unsigned)(w >> 32)); ms += mt[t]; }
            const float mean = ms * 0.25f; float q = 0.f;
#pragma unroll
            for (int t = 0; t < 4; ++t) { const float dm = mt[t] - mean; q += m2[t] + 256.0f * dm * dm; }
            S[row] = (f32x2){mean, 1.0f / sqrtf(q * (1.0f / 1024.0f) + eps)};
        }
        asm volatile("s_waitcnt lgkmcnt(0)" ::: "memory"); __builtin_amdgcn_s_barrier(); asm volatile("" ::: "memory");
    }
};
struct EpiLn1 {
    static constexpr bool AFTER_DRAIN = true; static constexpr bool ADJ = false;
    h16* X1; unsigned char* X1F8; const float* X; const float* g; const float* b; PanelStats st;
    __device__ __forceinline__ void operator()(const f32x4 (&)[2][2][4][2], const Unit&, int, int, int, int) const {}
    __device__ __forceinline__ void fused(f32x4 (&acc)[2][2][4][2], const Unit& u, int wr, int wc, int fr, int fq, LAS unsigned char* lds, int wid, int lane) const {
#pragma unroll
        for (int ai = 0; ai < 2; ++ai)
#pragma unroll
            for (int mh = 0; mh < 2; ++mh) {
                f32x4 xv[2][2][2];
#pragma unroll
                for (int mm = 0; mm < 2; ++mm)
#pragma unroll
                    for (int bj = 0; bj < 2; ++bj) { const int m = 2 * mh + mm; const int row = 256 * u.pm + 128 * ai + 64 * wr + 16 * m + fr, col = 256 * u.pn + 128 * bj + 32 * wc + 8 * fq;
                        xv[mm][bj][0] = *(const f32x4*)(X + (size_t)row * DM + col); xv[mm][bj][1] = *(const f32x4*)(X + (size_t)row * DM + col + 4); }
#pragma unroll
                for (int mm = 0; mm < 2; ++mm)
#pragma unroll
                    for (int bj = 0; bj < 2; ++bj) { const int m = 2 * mh + mm; acc[ai][bj][m][0] += xv[mm][bj][0] * ALPHA; acc[ai][bj][m][1] += xv[mm][bj][1] * ALPHA; }
                asm volatile("" : "+v"(acc[ai][0][2 * mh][0]), "+v"(acc[ai][0][2 * mh + 1][0]), "+v"(acc[ai][1][2 * mh][0]), "+v"(acc[ai][1][2 * mh + 1][0]));
            }
        st.run(acc, u, wr, wc, fr, fq, lds, wid, lane);
        const LAS f32x2* S = (const LAS f32x2*)(lds + 8192);
        f32x4 gv[2][2], bv[2][2];
#pragma unroll
        for (int bj = 0; bj < 2; ++bj) { const int col = 256 * u.pn + 128 * bj + 32 * wc + 8 * fq; gv[bj][0] = *(const f32x4*)(g + col); gv[bj][1] = *(const f32x4*)(g + col + 4); bv[bj][0] = *(const f32x4*)(b + col); bv[bj][1] = *(const f32x4*)(b + col + 4); }
        EPI_FENCE;
#pragma unroll
        for (int ai = 0; ai < 2; ++ai)
#pragma unroll
            for (int m = 0; m < 4; ++m) { const int rl = 128 * ai + 64 * wr + 16 * m + fr; const f32x2 sr = S[rl]; const int row = 256 * u.pm + rl;
#pragma unroll
                for (int bj = 0; bj < 2; ++bj) { const int col = 256 * u.pn + 128 * bj + 32 * wc + 8 * fq;
                    const f32x4 o0 = (acc[ai][bj][m][0] - sr.x) * sr.y * gv[bj][0] + bv[bj][0], o1 = (acc[ai][bj][m][1] - sr.x) * sr.y * gv[bj][1] + bv[bj][1];
                    *(f16x8*)(X1 + (size_t)row * DM + col) = pack8(o0, o1);
                    *(u32x2*)(X1F8 + (size_t)row * DM + col) = (u32x2){pk4_fp8s(o0, SC_X1), pk4_fp8s(o1, SC_X1)}; } }
    }
};
struct EpiLogit {
    static constexpr bool AFTER_DRAIN = false; static constexpr bool ADJ = false;
    float* L;
    __device__ __forceinline__ void operator()(const f32x4 (&acc)[2][2][4][2], const Unit& u, int wr, int wc, int fr, int fq) const {
        EPI_LOOP_BEGIN
            *(f32x4*)(L + (size_t)row * NEXP + col) = v0; *(f32x4*)(L + (size_t)row * NEXP + col + 4) = v1;
        EPI_LOOP_END
    }
};
struct EpiMoe1 {
    static constexpr bool AFTER_DRAIN = false; static constexpr bool ADJ = false;
    unsigned char* HID;
    __device__ __forceinline__ void operator()(const f32x4 (&acc)[2][2][4][2], const Unit& u, int wr, int wc, int fr, int fq) const {
        constexpr float IS = 1.0f / (SC_X1 * SC_W);
#pragma unroll
        for (int ai = 0; ai < 2; ++ai)
#pragma unroll
            for (int m = 0; m < 4; ++m) {
                const int row = 256 * u.pm + 128 * ai + 64 * wr + 16 * m + fr; const int col = 128 * u.pn + 32 * wc + 8 * fq;
                f32x4 g0 = acc[ai][0][m][0], g1 = acc[ai][0][m][1], u0 = acc[ai][1][m][0], u1 = acc[ai][1][m][1];
#pragma unroll
                for (int j = 0; j < 4; ++j) { const float a0 = g0[j] * IS, a1 = g1[j] * IS; g0[j] = a0 * sigmoidf_(a0) * u0[j]; g1[j] = a1 * sigmoidf_(a1) * u1[j]; }
                *(u32x2*)(HID + (size_t)row * EDIM + col) = (u32x2){pk4_fp8s(g0, IS * SC_HID), pk4_fp8s(g1, IS * SC_HID)};
            }
    }
};
constexpr float Y_SCALE = 64.0f, Y_INV = 1.0f / 64.0f;
__device__ __forceinline__ unsigned pk4_fp8(f32x4 v) { return pk4_fp8s(v, Y_SCALE / (SC_HID * SC_W)); }
struct EpiMoe2 {
    static constexpr bool AFTER_DRAIN = false; static constexpr bool ADJ = true;
    unsigned char* Y; const int* row_dst; int mode;
    __device__ __forceinline__ void operator()(const f32x4 (&acc)[2][2][4][2], const Unit& u, int wr, int wc, int fr, int fq) const {
        if (mode == 2) { asm volatile("" :: "v"(acc[0][0][0][0]), "v"(acc[1][1][3][1])); return; }
        int dsts[2][4];
#pragma unroll
        for (int ai = 0; ai < 2; ++ai)
#pragma unroll
            for (int m = 0; m < 4; ++m) dsts[ai][m] = row_dst[256 * u.pm + 128 * ai + 64 * wr + 16 * m + fr];
        EPI_FENCE;
        const int col = 256 * u.pn + 64 * wc + 16 * fq;
#pragma unroll
        for (int ai = 0; ai < 2; ++ai)
#pragma unroll
            for (int m = 0; m < 4; ++m) {
                const int dst = dsts[ai][m];
                if (dst >= 0) {
                    u32x4 w; w[0] = pk4_fp8(acc[ai][0][m][0]); w[1] = pk4_fp8(acc[ai][0][m][1]); w[2] = pk4_fp8(acc[ai][1][m][0]); w[3] = pk4_fp8(acc[ai][1][m][1]);
                    if (mode == 0) *(u32x4*)(Y + (size_t)dst * DM + col) = w; else asm volatile("" :: "v"(w));
                }
            }
    }
};

__device__ __forceinline__ void tr_item(const float* W, int K, int N, int k0, int n0, h16* dst, float* scr, int lane) {
    (void)scr;
    const int lk = lane & 7, ln = lane >> 3;
    const float* src = W + (size_t)(k0 + 8 * lk) * N + n0 + 4 * ln;
    f32x4 v[8];
#pragma unroll
    for (int i = 0; i < 8; ++i) v[i] = __builtin_nontemporal_load((const f32x4*)(src + (size_t)i * N));
#pragma unroll
    for (int j = 0; j < 4; ++j) { f16x8 o;
#pragma unroll
        for (int i = 0; i < 8; ++i) o[i] = (h16)v[i][j];
        *(f16x8*)(dst + (size_t)(4 * ln + j) * K + k0 + 8 * lk) = o; }
}
constexpr int CONV_PER_E = 192, CONV_NIT = 257 * CONV_PER_E, CONV_NF = 2;
__device__ __forceinline__ void conv_item_addr(const Frame& F, int it, const float*& src, int& K, int& N, int& k0, int& n0, unsigned char*& dst) {
    const int e = it / CONV_PER_E; int r = it - e * CONV_PER_E;
    const float* wg = e < 256 ? F.e_wg + (size_t)e * 1024 * 256 : F.s_wg;
    const float* wu = e < 256 ? F.e_wu + (size_t)e * 1024 * 256 : F.s_wu;
    const float* wd = e < 256 ? F.e_wd + (size_t)e * 256 * 1024 : F.s_wd;
    unsigned char* w1 = F.W1t + (size_t)e * 512 * 1024; unsigned char* w2 = F.W2t + (size_t)e * 1024 * 256;
    if (r < 64) { const int kb = r >> 3, nb = r & 7; n0 = 32 * nb; k0 = 128 * kb; src = wg; K = 1024; N = 256; dst = w1 + (size_t)((n0 >> 7) * 256 + (n0 & 127)) * 1024; return; } r -= 64;
    if (r < 64) { const int kb = r >> 3, nb = r & 7; n0 = 32 * nb; k0 = 128 * kb; src = wu; K = 1024; N = 256; dst = w1 + (size_t)((n0 >> 7) * 256 + 128 + (n0 & 127)) * 1024; return; } r -= 64;
    { const int kb = r >> 5, nb = r & 31; n0 = 32 * nb; k0 = 128 * kb; src = wd; K = 256; N = 1024; dst = w2 + (size_t)n0 * 256; }
}
#define CONV_LOAD(u, itv) { const float* sp; int N0, n0; conv_item_addr(F, itv, sp, Kd[u], N0, kd[u], n0, d[u]); \
        const float* p = sp + (size_t)(kd[u] + 16 * lk) * N0 + n0 + 4 * ln; \
        _Pragma("unroll") for (int i = 0; i < 16; ++i) v[u][i] = __builtin_nontemporal_load((const f32x4*)(p + (size_t)i * N0)); }
#define CONV_STORE(u) { _Pragma("unroll") for (int j = 0; j < 4; ++j) { u32x4 o; \
        _Pragma("unroll") for (int i4 = 0; i4 < 4; ++i4) { int w = 0; \
            w = __builtin_amdgcn_cvt_pk_fp8_f32(v[u][4 * i4][j] * SC_W, v[u][4 * i4 + 1][j] * SC_W, w, false); w = __builtin_amdgcn_cvt_pk_fp8_f32(v[u][4 * i4 + 2][j] * SC_W, v[u][4 * i4 + 3][j] * SC_W, w, true); o[i4] = (unsigned)w; } \
        __builtin_nontemporal_store(o, (u32x4*)(d[u] + (size_t)(4 * ln + j) * Kd[u] + kd[u] + 16 * lk)); } }
__device__ __forceinline__ void conv_experts(Frame& F, int gw, int NGW) {
    const int lane = F.lane, lk = lane & 7, ln = lane >> 3;
    constexpr int NIT = CONV_NIT, NF = CONV_NF;
    for (int it = gw; it < NIT; it += NF * NGW) {
        f32x4 v[NF][16]; unsigned char* d[NF]; int Kd[NF], kd[NF]; bool ok[NF];
#pragma unroll
        for (int u = 0; u < NF; ++u) { const int itu = it + u * NGW; ok[u] = itu < NIT; CONV_LOAD(u, ok[u] ? itu : it) }
#pragma unroll
        for (int u = 0; u < NF; ++u) { if (ok[u]) CONV_STORE(u) }
    }
}
__device__ __forceinline__ void conv_experts_dyn(Frame& F) {
    const int lane = F.lane, lk = lane & 7, ln = lane >> 3;
    constexpr int NIT = CONV_NIT, NF = CONV_NF, CH = 12, PER = NIT / 8;
    const int x = F.bid & 7; unsigned* ctr = F.ctl + CW_CONVQ + 64 * x;
    const int lo = x * PER, hi = (x == 7) ? NIT : lo + PER;
    for (;;) {
        unsigned b0 = 0;
        if (lane == 0) b0 = __hip_atomic_fetch_add(ctr, (unsigned)CH, __ATOMIC_RELAXED, __HIP_MEMORY_SCOPE_AGENT);
        const int base = lo + (int)__builtin_amdgcn_readfirstlane(b0);
        if (base >= hi) break;
        const int end = base + CH < hi ? base + CH : hi;
        for (int it = base; it < end; it += NF) {
            f32x4 v[NF][16]; unsigned char* d[NF]; int Kd[NF], kd[NF]; bool ok[NF];
#pragma unroll
            for (int u = 0; u < NF; ++u) { const int itu = it + u; ok[u] = itu < end; CONV_LOAD(u, ok[u] ? itu : it) }
#pragma unroll
            for (int u = 0; u < NF; ++u) { if (ok[u]) CONV_STORE(u) }
        }
    }
}
__device__ __forceinline__ void ph_prologue(Frame& F) {
    float* scr = (float*)(F.lds + F.wave * 16384);
    const int gw = F.bid * NWAVES + F.wave, NGW = F.G * NWAVES;
    constexpr int I_IN = 16 * 200, I_A = 16 * 32, I_B = 4 * 32, I_O = 16 * 32, I_R = 16 * 8, I_SMALL = I_IN + I_A + I_B + I_O + I_R;
    for (int it = gw; it < I_SMALL; it += NGW) {
        int r = it;
        if (r < I_IN) { const int kb = r / 200, nb = r % 200; tr_item(F.in_w, 1024, NIN, 64 * kb, 32 * nb, F.WinT + (size_t)(32 * nb) * 1024, scr, F.lane); continue; } r -= I_IN;
        if (r < I_A) { const int kb = r / 32, nb = r % 32; tr_item(F.pa_w, 1024, 1024, 64 * kb, 32 * nb, F.WaT + (size_t)(32 * nb) * 1024, scr, F.lane); continue; } r -= I_A;
        if (r < I_B) { const int kb = r / 32, nb = r % 32; tr_item(F.pb_w, 256, 1024, 64 * kb, 32 * nb, F.WbT + (size_t)(32 * nb) * 256, scr, F.lane); continue; } r -= I_B;
        if (r < I_O) { const int kb = r / 32, nb = r % 32; tr_item(F.out_w, 1024, 1024, 64 * kb, 32 * nb, F.WoT + (size_t)(32 * nb) * 1024, scr, F.lane); continue; } r -= I_O;
        { const int kb = r / 8, nb = r % 8; tr_item(F.r_w, 1024, 256, 64 * kb, 32 * nb, F.WrT + (size_t)(32 * nb) * 1024, scr, F.lane); }
    }
#if !CONV_IN_ATTN
    conv_experts(F, F.bid * NWAVES + F.wave, F.G * NWAVES);
#endif
    for (int i = F.bid * NTHREADS + F.tid; i < 8 * 128 * 128; i += F.G * NTHREADS) { const int tt = (i >> 7) & 127, ss = i & 127; F.Wc[i] = (ss <= tt) ? (h16)F.sp_w[i] : (h16)0.f; }
    const size_t nth = (size_t)F.G * NTHREADS; const size_t n8 = (size_t)T * DM / 8;
    for (size_t i = (size_t)F.bid * NTHREADS + F.tid; i < n8; i += 4 * nth) {
        f32x4 a[4], b[4];
#pragma unroll
        for (int u = 0; u < 4; ++u) { const size_t j = i + u * nth; if (j < n8) { a[u] = __builtin_nontemporal_load((const f32x4*)(F.x + j * 8)); b[u] = __builtin_nontemporal_load((const f32x4*)(F.x + j * 8 + 4)); } }
#pragma unroll
        for (int u = 0; u < 4; ++u) { const size_t j = i + u * nth; if (j < n8) *(f16x8*)(F.x16 + j * 8) = pack8(a[u], b[u]); }
    }
}

__device__ __forceinline__ void ph_attn_simple(Frame& F) {
    float* pl = (float*)(F.lds) + F.wave * 512;
    const int gw = F.bid * NWAVES + F.wave, NGW = F.G * NWAVES;
    const int lane = F.lane;
    for (int it = gw; it < T * 4; it += NGW) {
        const int t = it >> 2, hg = it & 3; const int s = t & (SEQ - 1);
        float sc[3][3];
        float mx = -INFINITY;
#pragma unroll
        for (int g = 0; g < 3; ++g) {
            const int hh = 4 * g + hg; const int dil = (g == 0) ? 1 : (g == 1 ? 4 : 16);
            const float slope = exp2f(hh < 8 ? -0.5f * (float)(hh + 1) : -(float)(hh - 3));
            const h16* qp = F.h + (size_t)t * NIN + C_Q + hh * 64;
            f16x8 q[8];
#pragma unroll
            for (int j = 0; j < 8; ++j) q[j] = *(const f16x8*)(qp + 8 * j);
#pragma unroll
            for (int r = 0; r < 3; ++r) {
                const int delta = lane + 64 * r; const bool valid = (r < 2 || lane == 0) && (s - delta * dil >= 0);
                float v = -INFINITY;
                if (valid) {
                    const h16* kp = F.h + (size_t)(t - delta * dil) * NIN + C_K + hh * 64;
                    float d = 0.f;
#pragma unroll
                    for (int j = 0; j < 8; ++j) { const f16x8 kk = *(const f16x8*)(kp + 8 * j);
#pragma unroll
                        for (int e = 0; e < 8; ++e) d += (float)q[j][e] * (float)kk[e]; }
                    v = d * 0.125f - slope * (float)(delta * dil);
                }
                sc[g][r] = v; mx = fmaxf(mx, v);
            }
        }
        mx = wave_max(mx);
        float lsum = 0.f;
#pragma unroll
        for (int g = 0; g < 3; ++g)
#pragma unroll
            for (int r = 0; r < 3; ++r) {
                const float p = (sc[g][r] == -INFINITY) ? 0.f : __expf(sc[g][r] - mx);
                lsum += p;
                if (r < 2 || lane == 0) pl[g * 129 + lane + 64 * r] = p;
            }
        lsum = wave_sum(lsum);
        __builtin_amdgcn_s_waitcnt(0xc07f); asm volatile("" ::: "memory");
        float o = 0.f;
#pragma unroll
        for (int g = 0; g < 3; ++g) {
            const int hh = 4 * g + hg; const int dil = (g == 0) ? 1 : (g == 1 ? 4 : 16);
            int nk = s / dil + 1; if (nk > 129) nk = 129;
            const h16* vp = F.h + (size_t)t * NIN + C_VV + hh * 64 + lane;
            for (int delta = 0; delta < nk; ++delta) o += pl[g * 129 + delta] * (float)vp[-(long)delta * dil * NIN];
        }
        F.yb[(size_t)t * 256 + hg * 64 + lane] = (h16)(o / lsum);
        asm volatile("" ::: "memory");
    }
}

typedef float f32x16 __attribute__((ext_vector_type(16)));
typedef short v4i16_t __attribute__((ext_vector_type(4)));
__device__ __forceinline__ int crow(int r, int hi) { return (r & 3) + 8 * (r >> 2) + 4 * hi; }
__device__ __forceinline__ void ph_attn_fast(Frame& F, LAS unsigned char* ldsb) {
    const int lane = F.lane, q = lane & 31, hi = lane >> 5;
    LAS unsigned char* vl = ldsb + F.wave * 8448;
    const int vcu = (F.G % 8 == 0) ? (F.bid % 8) * (F.G / 8) + F.bid / 8 : F.bid;
    constexpr int NTASK = 8 * 12 * 32 * 4;
#if CONV_IN_ATTN
    constexpr int NA = ATTN_WAVES;
    if (F.wave >= NA) { conv_experts_dyn(F); return; }
#else
    constexpr int NA = NWAVES;
#endif
    const int R = (NTASK + F.G * NA - 1) / (F.G * NA);
    const int li = lane & 15;
    const int tr_base = (4 * hi + (li >> 2)) * 64 + (16 * ((lane >> 4) & 1) + 4 * (li & 3)) * 2;
    const int vw_kv = lane >> 3, vw_c = lane & 7;
    const int vw_off = (vw_c >> 2) * 2112 + vw_kv * 64 + (vw_c & 3) * 16;
    for (int it = 0; it < R; ++it) {
        const int task = (vcu * R + it) * NA + F.wave;
        if (task >= NTASK) break;
        const int unit = task >> 2, a = task & 3, bh = unit >> 5, blk = unit & 31;
        const int b = bh / 12, hh = bh - b * 12, g = hh >> 2, dsh = 2 * g, dil = 1 << dsh;
        const int n = blk >> dsh, r = blk & (dil - 1);
        const int Iq0 = n * 128 + 32 * a, Ik0 = Iq0 - 128;
        const int nskip = Ik0 < 0 ? ((-Ik0) >> 5) : 0;
        const float slope = exp2f(hh < 8 ? -0.5f * (float)(hh + 1) : -(float)(hh - 3));
        const float c1 = 0.125f * 1.4426950408889634f, c2 = slope * (float)dil * 1.4426950408889634f;
        const h16* hb = F.h + (size_t)b * SEQ * NIN + (size_t)r * NIN + hh * 64;
        const size_t rs = (size_t)dil * NIN;
        f16x8 qf[4];
        { const h16* qp = hb + (size_t)(Iq0 + q) * rs + C_Q + 8 * hi;
#pragma unroll
          for (int s4 = 0; s4 < 4; ++s4) qf[s4] = *(const f16x8*)(qp + 16 * s4); }
        f32x16 S[5];
        {
            f16x8 kf[3][4];
#pragma unroll
            for (int kb = 0; kb < 3; ++kb) {
                const int kbc = kb;
                const h16* kp = hb + (size_t)(Ik0 + 32 * kbc + q) * rs + C_K + 8 * hi;
#pragma unroll
                for (int s4 = 0; s4 < 4; ++s4) kf[kb][s4] = *(const f16x8*)(kp + 16 * s4);
            }
#pragma unroll
            for (int kb = 0; kb < 3; ++kb) {
#pragma unroll
                for (int e = 0; e < 16; ++e) S[kb][e] = 0.f;
#pragma unroll
                for (int s4 = 0; s4 < 4; ++s4) S[kb] = MFMA32(kf[kb][s4], qf[s4], S[kb]);
            }
        }
        {
            f16x8 kf[2][4];
#pragma unroll
            for (int kb = 3; kb < 5; ++kb) {
                const int kbc = kb;
                const h16* kp = hb + (size_t)(Ik0 + 32 * kbc + q) * rs + C_K + 8 * hi;
#pragma unroll
                for (int s4 = 0; s4 < 4; ++s4) kf[kb - 3][s4] = *(const f16x8*)(kp + 16 * s4);
            }
#pragma unroll
            for (int kb = 3; kb < 5; ++kb) {
#pragma unroll
                for (int e = 0; e < 16; ++e) S[kb][e] = 0.f;
#pragma unroll
                for (int s4 = 0; s4 < 4; ++s4) S[kb] = MFMA32(kf[kb - 3][s4], qf[s4], S[kb]);
            }
        }
        f16x8 vgA[3][4], vgB[2][4];
#pragma unroll
        for (int kb = 0; kb < 3; ++kb) {
            const int kbc = kb;
#pragma unroll
            for (int i = 0; i < 4; ++i) vgA[kb][i] = *(const f16x8*)(hb + (size_t)(Ik0 + 32 * kbc + 8 * i + vw_kv) * rs + C_VV + 8 * vw_c);
        }
        int qq = q; asm volatile("" : "+v"(qq));
        const float nb = -c2 * (float)(qq + 128 - 4 * hi);
        const int qrel = qq - 4 * hi;
        float m = -INFINITY;
#pragma unroll
        for (int kb = 0; kb < 5; ++kb)
#pragma unroll
            for (int e = 0; e < 16; ++e) {
                const int ec = (e & 3) + 8 * (e >> 2);
                float v = __builtin_fmaf(S[kb][e], c1, __builtin_fmaf(c2, (float)(32 * kb + ec), nb));
                bool ok = kb >= nskip;
                if (kb == 0) ok = ok && (ec >= qrel);
                if (kb == 4) ok = ok && (ec <= qrel);
                v = ok ? v : -INFINITY;
                S[kb][e] = v; m = fmaxf(m, v);
            }
        m = fmaxf(m, __shfl_xor(m, 32));
        float l = 0.f;
        f16x8 pf[5][2];
#pragma unroll
        for (int kb = 0; kb < 5; ++kb)
#pragma unroll
            for (int e = 0; e < 16; ++e) { const float p = __builtin_amdgcn_exp2f(S[kb][e] - m); l += p; pf[kb][e >> 3][e & 7] = (h16)p; }
        l += __shfl_xor(l, 32);
#pragma unroll
        for (int kb = 3; kb < 5; ++kb) {
            const int kbc = kb;
#pragma unroll
            for (int i = 0; i < 4; ++i) vgB[kb - 3][i] = *(const f16x8*)(hb + (size_t)(Ik0 + 32 * kbc + 8 * i + vw_kv) * rs + C_VV + 8 * vw_c);
        }
        f32x16 O[2];
#pragma unroll
        for (int e = 0; e < 16; ++e) { O[0][e] = 0.f; O[1][e] = 0.f; }
#pragma unroll
        for (int kb = 0; kb < 5; ++kb) {
            LAS unsigned char* vb = vl + (kb & 1) * 4224;
#pragma unroll
            for (int i = 0; i < 4; ++i) *(LAS f16x8*)(vb + vw_off + i * 512) = (kb < 3) ? vgA[kb < 3 ? kb : 0][i] : vgB[kb >= 3 ? kb - 3 : 0][i];
#pragma unroll
            for (int s2 = 0; s2 < 2; ++s2) {
#pragma unroll
                for (int db = 0; db < 2; ++db) {
                    const v4i16_t lo = __builtin_amdgcn_ds_read_tr16_b64_v4i16((LAS v4i16_t*)(vb + tr_base + db * 2112 + s2 * 1024));
                    const v4i16_t hi4 = __builtin_amdgcn_ds_read_tr16_b64_v4i16((LAS v4i16_t*)(vb + tr_base + db * 2112 + s2 * 1024 + 512));
                    typedef short s16x8 __attribute__((ext_vector_type(8)));
                    const s16x8 vv = (s16x8){lo[0], lo[1], lo[2], lo[3], hi4[0], hi4[1], hi4[2], hi4[3]};
                    O[db] = MFMA32(__builtin_bit_cast(f16x8, vv), pf[kb][s2], O[db]);
                }
            }
        }
        const float rl = 1.0f / l;
        const size_t tq = (size_t)b * SEQ + (size_t)(Iq0 + q) * dil + r;
        {
            LAS unsigned char* ot = vl;
#pragma unroll
            for (int db = 0; db < 2; ++db)
#pragma unroll
                for (int r4 = 0; r4 < 4; ++r4) { f16x4 w;
#pragma unroll
                    for (int e = 0; e < 4; ++e) w[e] = (h16)(O[db][4 * r4 + e] * rl);
                    const int d0 = 32 * db + 8 * r4 + 4 * hi;
                    *(LAS f16x4*)(ot + q * 128 + ((((d0 >> 3) ^ (q & 7)) << 4) | ((d0 & 7) * 2))) = w; }
#pragma unroll
            for (int j = 0; j < 4; ++j) { const int row = 8 * j + (lane >> 3), ch = lane & 7;
                const f16x8 v = *(const LAS f16x8*)(ot + row * 128 + ((ch ^ (row & 7)) << 4));
                const size_t tr = (size_t)b * SEQ + (size_t)(Iq0 + row) * dil + r;
                *(f16x8*)(F.ao + tr * 768 + hh * 64 + 8 * ch) = v; }
        }
        if (hi == 0) F.lse[tq * 12 + hh] = (m + __builtin_amdgcn_logf(l)) * 0.6931471805599453f;
    }
#if CONV_IN_ATTN
    conv_experts_dyn(F);
#endif
}
__device__ __forceinline__ void attn_merge_chunk(Frame& F, int t0) {
    for (int idx = F.tid; idx < 4096; idx += NTHREADS) {
        const int c = idx & 7, hg = (idx >> 3) & 3, t = t0 + (idx >> 5);
        const float l0 = F.lse[(size_t)t * 12 + hg], l1 = F.lse[(size_t)t * 12 + 4 + hg], l2 = F.lse[(size_t)t * 12 + 8 + hg];
        const float mx = fmaxf(l0, fmaxf(l1, l2)); float w0 = __expf(l0 - mx), w1 = __expf(l1 - mx), w2 = __expf(l2 - mx); const float inv = 1.0f / (w0 + w1 + w2);
        w0 *= inv; w1 *= inv; w2 *= inv;
        const h16* ap = F.ao + (size_t)t * 768 + hg * 64 + 8 * c;
        const f16x8 a0 = *(const f16x8*)ap, a1 = *(const f16x8*)(ap + 256), a2 = *(const f16x8*)(ap + 512);
        f16x8 o;
#pragma unroll
        for (int e = 0; e < 8; ++e) o[e] = (h16)(w0 * (float)a0[e] + w1 * (float)a1[e] + w2 * (float)a2[e]);
        *(f16x8*)(F.yb + (size_t)t * 256 + hg * 64 + 8 * c) = o;
    }
}

__device__ __forceinline__ void ph_gmlp_simple(Frame& F) {
    float* Vl = (float*)F.lds;
    float* Wl = Vl + 128 * 128;
    float* st = Wl + 128 * 129;
    const int tid = F.tid, lane = F.lane, wave = F.wave;
    for (int ch = F.bid; ch < T / 128; ch += F.G) {
        const int t0 = ch * 128;
#if USE_FAST_ATTN
        attn_merge_chunk(F, t0);
#endif
        for (int i = 0; i < 16; ++i) {
            const int tl = wave * 16 + i; const h16* vp = F.h + (size_t)(t0 + tl) * NIN + C_V;
            const f16x8 a = *(const f16x8*)(vp + 8 * lane), b = *(const f16x8*)(vp + 512 + 8 * lane);
            float s = 0.f;
#pragma unroll
            for (int j = 0; j < 8; ++j) s += (float)a[j] + (float)b[j];
            const float mean = wave_sum(s) * (1.f / 1024.f);
            float q = 0.f;
#pragma unroll
            for (int j = 0; j < 8; ++j) { const float da = (float)a[j] - mean, db = (float)b[j] - mean; q += da * da + db * db; }
            const float rstd = 1.f / sqrtf(wave_sum(q) * (1.f / 1024.f) + LN_EPS);
            if (lane == 0) { st[tl * 2] = mean; st[tl * 2 + 1] = rstd; }
        }
        __syncthreads();
        for (int g = 0; g < 8; ++g) {
            {
                const int sr = tid >> 2, c0 = (tid & 3) * 32; const float mean = st[sr * 2], rstd = st[sr * 2 + 1];
                const h16* vp = F.h + (size_t)(t0 + sr) * NIN + C_V + g * 128 + c0;
#pragma unroll
                for (int j = 0; j < 4; ++j) { const f16x8 a = *(const f16x8*)(vp + 8 * j);
#pragma unroll
                    for (int e = 0; e < 8; ++e) { const int c = c0 + 8 * j + e; Vl[sr * 128 + c] = ((float)a[e] - mean) * rstd * F.gn_g[g * 128 + c] + F.gn_b[g * 128 + c]; } }
            }
            for (int idx = tid; idx < 128 * 128; idx += NTHREADS) { const int tt = idx >> 7, ss = idx & 127; Wl[tt * 129 + ss] = (ss <= tt) ? F.sp_w[(size_t)g * 16384 + idx] : 0.f; }
            __syncthreads();
            {
                const int tt = tid >> 2, c0 = (tid & 3) * 32; float acc[32];
#pragma unroll
                for (int j = 0; j < 32; ++j) acc[j] = 0.f;
                for (int ss = 0; ss < 128; ++ss) { const float w = Wl[tt * 129 + ss];
#pragma unroll
                    for (int j = 0; j < 32; ++j) acc[j] += w * Vl[ss * 128 + c0 + j]; }
                const float sb = F.sp_b[g * 128 + tt];
                const h16* up = F.h + (size_t)(t0 + tt) * NIN + C_U + g * 128 + c0; h16* zp = F.z + (size_t)(t0 + tt) * DM + g * 128 + c0;
#pragma unroll
                for (int j = 0; j < 4; ++j) { const f16x8 uu = *(const f16x8*)(up + 8 * j); f16x8 o;
#pragma unroll
                    for (int e = 0; e < 8; ++e) o[e] = (h16)((float)uu[e] * (acc[8 * j + e] + sb));
                    *(f16x8*)(zp + 8 * j) = o; }
            }
            __syncthreads();
        }
    }
}

constexpr int GM_CB = 8256, GM_IMG = 4 * GM_CB;
__device__ __forceinline__ void gmlp_stage(Frame& F, LAS unsigned char* img, const LAS float* st, int t0, int g) {
#pragma unroll
    for (int i = 0; i < 4; ++i) {
        const int idx = F.tid + i * NTHREADS; const int sr = idx >> 4, cc = idx & 15;
        const f16x8 v = *(const f16x8*)(F.h + (size_t)(t0 + sr) * NIN + C_V + g * 128 + 8 * cc);
        const float mean = st[sr * 2], rstd = st[sr * 2 + 1];
        const f32x4 g0 = *(const f32x4*)(F.gn_g + g * 128 + 8 * cc), g1 = *(const f32x4*)(F.gn_g + g * 128 + 8 * cc + 4);
        const f32x4 b0 = *(const f32x4*)(F.gn_b + g * 128 + 8 * cc), b1 = *(const f32x4*)(F.gn_b + g * 128 + 8 * cc + 4);
        f16x8 o;
#pragma unroll
        for (int e = 0; e < 4; ++e) { o[e] = (h16)(((float)v[e] - mean) * rstd * g0[e] + b0[e]); o[4 + e] = (h16)(((float)v[4 + e] - mean) * rstd * g1[e] + b1[e]); }
        *(LAS f16x8*)(img + (cc >> 2) * GM_CB + sr * 64 + (cc & 3) * 16) = o;
    }
}
__device__ __forceinline__ void ph_gmlp_fast(Frame& F, LAS unsigned char* ldsb) {
    LAS float* st = (LAS float*)ldsb;
    LAS unsigned char* img0 = ldsb + 1024;
    const int tid = F.tid, lane = F.lane, wave = F.wave, hi = lane >> 5, li = lane & 15;
    const int cb = wave & 3, half = wave >> 2;
    const int tbA = half ? 1 : 0, tbB = half ? 2 : 3;
    const int nA = 2 * (tbA + 1), nB = 2 * (tbB + 1);
    const int tr_base = cb * GM_CB + (8 * hi + (li >> 2)) * 64 + (16 * ((lane >> 4) & 1) + 4 * (li & 3)) * 2;
    for (int ch = F.bid; ch < T / 128; ch += F.G) {
        const int t0 = ch * 128;
        attn_merge_chunk(F, t0);
        for (int i0 = 0; i0 < 16; i0 += 8) {
            f16x8 a[8], b[8];
#pragma unroll
            for (int i = 0; i < 8; ++i) { const h16* vp = F.h + (size_t)(t0 + wave * 16 + i0 + i) * NIN + C_V; a[i] = *(const f16x8*)(vp + 8 * lane); b[i] = *(const f16x8*)(vp + 512 + 8 * lane); }
#pragma unroll
            for (int i = 0; i < 8; ++i) {
                const int tl = wave * 16 + i0 + i;
                float s_ = 0.f;
#pragma unroll
                for (int j = 0; j < 8; ++j) s_ += (float)a[i][j] + (float)b[i][j];
                const float mean = wave_sum(s_) * (1.f / 1024.f);
                float qv = 0.f;
#pragma unroll
                for (int j = 0; j < 8; ++j) { const float da = (float)a[i][j] - mean, db = (float)b[i][j] - mean; qv += da * da + db * db; }
                const float rstd = 1.f / sqrtf(wave_sum(qv) * (1.f / 1024.f) + LN_EPS);
                if (lane == 0) { st[tl * 2] = mean; st[tl * 2 + 1] = rstd; }
            }
        }
        __syncthreads();
        gmlp_stage(F, img0, st, t0, 0);
        __syncthreads();
        for (int g = 0; g < 8; ++g) {
            LAS unsigned char* img = img0 + (g & 1) * GM_IMG;
            LAS unsigned char* outb = img0 + 2 * GM_IMG + (g & 1) * 32768;
            if (g < 7) gmlp_stage(F, img0 + ((g + 1) & 1) * GM_IMG, st, t0, g + 1);
            f32x16 DA, DB;
#pragma unroll
            for (int e = 0; e < 16; ++e) { DA[e] = 0.f; DB[e] = 0.f; }
            const h16* wa = F.Wc + (size_t)g * 16384 + (size_t)(32 * tbA + (lane & 31)) * 128 + 8 * hi;
            const h16* wb = F.Wc + (size_t)g * 16384 + (size_t)(32 * tbB + (lane & 31)) * 128 + 8 * hi;
#pragma unroll
            for (int ks = 0; ks < 8; ++ks) {
                if (ks < nB) {
                    const v4i16_t lo = __builtin_amdgcn_ds_read_tr16_b64_v4i16((LAS v4i16_t*)(img + tr_base + ks * 1024));
                    const v4i16_t hi4 = __builtin_amdgcn_ds_read_tr16_b64_v4i16((LAS v4i16_t*)(img + tr_base + ks * 1024 + 256));
                    typedef short s16x8 __attribute__((ext_vector_type(8)));
                    const s16x8 vv = (s16x8){lo[0], lo[1], lo[2], lo[3], hi4[0], hi4[1], hi4[2], hi4[3]};
                    const f16x8 af = __builtin_bit_cast(f16x8, vv);
                    const f16x8 bfB = *(const f16x8*)(wb + 16 * ks);
                    DB = MFMA32(af, bfB, DB);
                    if (ks < nA) { const f16x8 bfA = *(const f16x8*)(wa + 16 * ks); DA = MFMA32(af, bfA, DA); }
                }
            }
#pragma unroll
            for (int w2 = 0; w2 < 2; ++w2) {
                const int tb = w2 ? tbB : tbA; const int tt = 32 * tb + (lane & 31);
                const float sb = F.sp_b[g * 128 + tt];
#pragma unroll
                for (int r4 = 0; r4 < 4; ++r4) { f16x4 o;
#pragma unroll
                    for (int e = 0; e < 4; ++e) o[e] = (h16)((w2 ? DB[4 * r4 + e] : DA[4 * r4 + e]) + sb);
                    *(LAS f16x4*)(outb + tt * 256 + (((4 * cb + r4) ^ (tt & 15)) << 4) + 8 * hi) = o; }
            }
            __syncthreads();
#pragma unroll
            for (int i = 0; i < 4; ++i) {
                const int idx = tid + i * NTHREADS; const int tt = idx >> 4, cc = idx & 15;
                const f16x8 vm = *(const LAS f16x8*)(outb + tt * 256 + ((cc ^ (tt & 15)) << 4));
                const f16x8 uu = *(const f16x8*)(F.h + (size_t)(t0 + tt) * NIN + C_U + g * 128 + 8 * cc);
                f16x8 o;
#pragma unroll
                for (int e = 0; e < 8; ++e) o[e] = (h16)((float)uu[e] * (float)vm[e]);
                *(f16x8*)(F.z + (size_t)(t0 + tt) * DM + g * 128 + 8 * cc) = o;
            }
        }
        __syncthreads();
    }
}

__device__ __forceinline__ void ph_ln1(Frame& F) {
    const int gw = F.bid * NWAVES + F.wave, NGW = F.G * NWAVES, lane = F.lane;
    for (int m = gw; m < T; m += NGW) {
        const f32x4* rp = (const f32x4*)(F.out + (size_t)m * DM) + lane;
        f32x4 v[4]; float s = 0.f;
#pragma unroll
        for (int j = 0; j < 4; ++j) { v[j] = rp[64 * j]; s += (v[j][0] + v[j][1]) + (v[j][2] + v[j][3]); }
        const float mean = wave_sum(s) * (1.f / DM); float q = 0.f;
#pragma unroll
        for (int j = 0; j < 4; ++j) { v[j] = v[j] - mean; q += (v[j][0] * v[j][0] + v[j][1] * v[j][1]) + (v[j][2] * v[j][2] + v[j][3] * v[j][3]); }
        const float rstd = 1.f / sqrtf(wave_sum(q) * (1.f / DM) + LN_EPS);
#pragma unroll
        for (int j = 0; j < 4; ++j) { const int c = 4 * lane + 256 * j; const f32x4 g = *(const f32x4*)(F.ln1_g + c), b = *(const f32x4*)(F.ln1_b + c);
            const f32x4 o = v[j] * rstd * g + b; f16x4 w; w[0] = (h16)o[0]; w[1] = (h16)o[1]; w[2] = (h16)o[2]; w[3] = (h16)o[3];
            *(f16x4*)(F.x1 + (size_t)m * DM + c) = w; }
    }
}

template <int CTRL> __device__ __forceinline__ float dppf(float v) { const int b_ = __builtin_bit_cast(int, v); return __builtin_bit_cast(float, __builtin_amdgcn_update_dpp(b_, b_, CTRL, 0xF, 0xF, false)); }
__device__ __forceinline__ void ph_route1(Frame& F) {
    int* cnt = (int*)F.lds; int* base = cnt + 256; int* ebuf = base + 256; int* pbuf = ebuf + 1024;
    const int tid = F.tid, lane = F.lane, wave = F.wave;
    for (int ch = F.bid; ch < T / 128; ch += F.G) {
        if (tid < 256) cnt[tid] = 0;
        __syncthreads();
        for (int i = 0; i < 16; ++i) {
            const int tl = wave * 16 + i, t = ch * 128 + tl;
            const f32x4 lg = *(const f32x4*)(F.logit + (size_t)t * NEXP + 4 * lane);
            const f32x4 rb = *(const f32x4*)(F.r_b + 4 * lane);
            float sc[4], mv[4];
#pragma unroll
            for (int j = 0; j < 4; ++j) { sc[j] = sigmoidf_(lg[j]); mv[j] = sc[j] + rb[j]; }
            float m1 = fmaxf(mv[0], mv[1]), m2 = fminf(mv[0], mv[1]);
#pragma unroll
            for (int j = 2; j < 4; ++j) { const float v = mv[j]; m2 = fmaxf(m2, fminf(m1, v)); m1 = fmaxf(m1, v); }
            { float o1 = dppf<0xB1>(m1), o2 = dppf<0xB1>(m2); m2 = fmaxf(fminf(m1, o1), fmaxf(m2, o2)); m1 = fmaxf(m1, o1); }
            { float o1 = dppf<0x4E>(m1), o2 = dppf<0x4E>(m2); m2 = fmaxf(fminf(m1, o1), fmaxf(m2, o2)); m1 = fmaxf(m1, o1); }
            { float o1 = dppf<0x141>(m1), o2 = dppf<0x141>(m2); m2 = fmaxf(fminf(m1, o1), fmaxf(m2, o2)); m1 = fmaxf(m1, o1); }
            const float gs = m1 + m2; const int grp = lane >> 3;
            int rank = 0;
#pragma unroll
            for (int g = 0; g < 8; ++g) { const float og = __builtin_bit_cast(float, __builtin_amdgcn_readlane(__builtin_bit_cast(int, gs), g * 8)); rank += (og > gs || (og == gs && g < grp)) ? 1 : 0; }
            const bool gsel = rank < 4;
#pragma unroll
            for (int j = 0; j < 4; ++j) mv[j] = gsel ? mv[j] : -INFINITY;
            int my_e = 0; float my_s = 0.f, ssum = 0.f;
            for (int k = 0; k < TOPK; ++k) {
                float bv = mv[0], bsc = sc[0]; int bi = 0;
#pragma unroll
                for (int j = 1; j < 4; ++j) if (mv[j] > bv) { bv = mv[j]; bi = j; bsc = sc[j]; }
                float r = bv;
                r = fmaxf(r, dppf<0xB1>(r)); r = fmaxf(r, dppf<0x4E>(r)); r = fmaxf(r, dppf<0x141>(r)); r = fmaxf(r, dppf<0x140>(r));
                const float r0 = __builtin_bit_cast(float, __builtin_amdgcn_readlane(__builtin_bit_cast(int, r), 0)), r1 = __builtin_bit_cast(float, __builtin_amdgcn_readlane(__builtin_bit_cast(int, r), 16));
                const float r2 = __builtin_bit_cast(float, __builtin_amdgcn_readlane(__builtin_bit_cast(int, r), 32)), r3 = __builtin_bit_cast(float, __builtin_amdgcn_readlane(__builtin_bit_cast(int, r), 48));
                const float M = fmaxf(fmaxf(r0, r1), fmaxf(r2, r3));
                const int L = __builtin_ctzll(__ballot(bv == M));
                const int be = 4 * L + __builtin_amdgcn_readlane(bi, L);
                const float sv = __builtin_bit_cast(float, __builtin_amdgcn_readlane(__builtin_bit_cast(int, bsc), L));
                if (lane == L) {
#pragma unroll
                    for (int j = 0; j < 4; ++j) if (bi == j) mv[j] = -INFINITY;
                }
                ssum += sv;
                if (lane == k) { my_e = be; my_s = sv; }
            }
            if (lane < TOPK) {
                const int lp = atomicAdd(&cnt[my_e], 1);
                ebuf[tl * 8 + lane] = my_e; pbuf[tl * 8 + lane] = lp;
                F.asg_e[t * 8 + lane] = my_e; F.gate[t * 8 + lane] = my_s / ssum * ROUTED_SCALE;
            }
        }
        __syncthreads();
        if (tid < 256) { const int c = cnt[tid]; base[tid] = c ? (int)__hip_atomic_fetch_add(F.ctl + CW_CNT + tid, (unsigned)c, __ATOMIC_RELAXED, __HIP_MEMORY_SCOPE_AGENT) : 0; }
        __syncthreads();
        for (int idx = tid; idx < 1024; idx += NTHREADS) F.asg_pos[ch * 1024 + idx] = base[ebuf[idx]] + pbuf[idx];
        __syncthreads();
    }
}
__device__ __forceinline__ void ph_route2(Frame& F) {
    int* pstart = (int*)F.lds; int* cn = pstart + 257;
    const int tid = F.tid;
    if (tid < 256) cn[tid] = (int)__hip_atomic_load(F.ctl + CW_CNT + tid, __ATOMIC_RELAXED, __HIP_MEMORY_SCOPE_AGENT);
    __syncthreads();
    if (tid == 0) { int run = T; for (int e = 0; e < 256; ++e) { pstart[e] = run; run += (cn[e] + 255) & ~255; } pstart[256] = run; }
    __syncthreads();
    for (int ch = F.bid; ch < T / 128; ch += F.G) {
        for (int idx = tid; idx < 1024; idx += NTHREADS) { const int a = ch * 1024 + idx; const int e = F.asg_e[a], row = pstart[e] + F.asg_pos[a]; F.row_tok[row] = a >> 3; F.row_dst[row] = a; }
        if (tid < 128) { const int r = ch * 128 + tid; F.row_tok[r] = r; F.row_dst[r] = NASG + r; }
    }
    for (int e = F.bid; e < 256; e += F.G) {
        const int p0 = pstart[e], c = cn[e], p1 = pstart[e + 1];
        for (int row = p0 + c + tid; row < p1; row += NTHREADS) { F.row_tok[row] = 0; F.row_dst[row] = -1; }
        for (int tl = (p0 >> 8) + tid; tl < (p1 >> 8); tl += NTHREADS) F.tile_e[tl] = e;
    }
    if (F.bid == 0) {
        if (tid < 128) F.tile_e[tid] = 256;
        if (tid == 0) F.ctl[CW_NT] = (unsigned)(pstart[256] >> 8);
    }
}

__device__ __forceinline__ void ph_combine(Frame& F, LAS unsigned char* ldsb) {
    const int gw = F.bid * NWAVES + F.wave, NGW = F.G * NWAVES, lane = F.lane;
    for (int tb = gw * 2; tb < T; tb += NGW * 2) {
        f16x8 xr[2][2]; u32x4 yr[2][9]; float gt[2][8];
#pragma unroll
        for (int u = 0; u < 2; ++u) {
            const int t = tb + u;
            const h16* xp = F.x1 + (size_t)t * DM + 16 * lane; const unsigned char* yp = F.y + (size_t)t * 8 * DM + 16 * lane; const unsigned char* sp = F.y + (size_t)(NASG + t) * DM + 16 * lane;
            xr[u][0] = *(const f16x8*)xp; xr[u][1] = *(const f16x8*)(xp + 8);
#pragma unroll
            for (int k = 0; k < 8; ++k) yr[u][k] = __builtin_nontemporal_load((const u32x4*)(yp + (size_t)k * DM));
            yr[u][8] = __builtin_nontemporal_load((const u32x4*)sp);
#pragma unroll
            for (int k = 0; k < 8; ++k) gt[u][k] = F.gate[t * 8 + k] * Y_INV;
        }
#pragma unroll
        for (int u = 0; u < 2; ++u) {
            const int t = tb + u;
            float acc[16];
            __builtin_amdgcn_sched_barrier(0);
#pragma unroll
            for (int d = 0; d < 4; ++d) {
                const f32x2 s0 = __builtin_amdgcn_cvt_pk_f32_fp8((int)yr[u][8][d], false), s1 = __builtin_amdgcn_cvt_pk_f32_fp8((int)yr[u][8][d], true);
                float a0 = s0.x * Y_INV, a1 = s0.y * Y_INV, a2 = s1.x * Y_INV, a3 = s1.y * Y_INV;
#pragma unroll
                for (int k = 0; k < 8; ++k) { const f32x2 p0 = __builtin_amdgcn_cvt_pk_f32_fp8((int)yr[u][k][d], false), p1 = __builtin_amdgcn_cvt_pk_f32_fp8((int)yr[u][k][d], true);
                    a0 += gt[u][k] * p0.x; a1 += gt[u][k] * p0.y; a2 += gt[u][k] * p1.x; a3 += gt[u][k] * p1.y; }
                acc[4 * d] = a0; acc[4 * d + 1] = a1; acc[4 * d + 2] = a2; acc[4 * d + 3] = a3;
            }
#pragma unroll
            for (int e = 0; e < 8; ++e) { acc[e] += ALPHA * (float)xr[u][0][e]; acc[8 + e] += ALPHA * (float)xr[u][1][e]; }
            float s = 0.f;
#pragma unroll
            for (int j = 0; j < 16; ++j) s += acc[j];
            const float mean = wave_sum(s) * (1.f / DM); float q = 0.f;
#pragma unroll
            for (int j = 0; j < 16; ++j) { acc[j] -= mean; q += acc[j] * acc[j]; }
            const float rstd = 1.f / sqrtf(wave_sum(q) * (1.f / DM) + LN_EPS);
            LAS float* stg = (LAS float*)ldsb + F.wave * 1024;
#pragma unroll
            for (int qd = 0; qd < 4; ++qd) { f32x4 o;
#pragma unroll
                for (int e = 0; e < 4; ++e) o[e] = acc[4 * qd + e] * rstd;
                *(LAS f32x4*)(stg + 16 * lane + 4 * qd) = o; }
#pragma unroll
            for (int j = 0; j < 4; ++j) { const int c = 4 * lane + 256 * j; const f32x4 v = *(const LAS f32x4*)(stg + c);
                const f32x4 g = *(const f32x4*)(F.ln2_g + c), b = *(const f32x4*)(F.ln2_b + c);
                *(f32x4*)(F.out + (size_t)t * DM + c) = v * g + b; }
        }
    }
}

#if USE_FAST_ATTN
#define ATTN_PHASE ph_attn_fast(F, (LAS unsigned char*)lds)
#else
#define ATTN_PHASE ph_attn_simple(F)
#endif
#ifndef USE_FAST_GMLP
#define USE_FAST_GMLP 1
#endif
#if USE_FAST_GMLP
#define GMLP_PHASE ph_gmlp_fast(F, (LAS unsigned char*)lds)
#else
#define GMLP_PHASE ph_gmlp_simple(F)
#endif
#ifndef PROBE_MODE
#define PROBE_MODE 0
#endif
#ifndef DUP_MASK
#define DUP_MASK 0
#endif
#ifndef USE_FAST_GEMM
#define USE_FAST_GEMM 1
#endif
#if USE_FAST_GEMM
#define GEMM(P, E) fg::gemm_fast((LAS unsigned char*)lds, P, E)
#else
#define GEMM(P, E) gemm_simple(P, E)
#endif
enum { PH_PRO = 0, PH_INPROJ, PH_ATTN, PH_GMLP, PH_YB, PH_YA, PH_OUTW, PH_LN1, PH_ROUTER, PH_ROUTE1, PH_ROUTE2, PH_MOE1, PH_MOE2, PH_COMBINE, N_PHASES };

__global__ void __launch_bounds__(NTHREADS, 2) mk_fwd(Args args) {
    extern __shared__ __attribute__((aligned(16))) unsigned char lds[];
    Frame F;
    F.lds = lds; F.tid = threadIdx.x; F.lane = F.tid & 63; F.wave = __builtin_amdgcn_readfirstlane(F.tid >> 6); F.G = gridDim.x; F.bid = blockIdx.x;
    unsigned char* ws = args.ws;
    F.ctl = (unsigned*)(ws + WS_CTL);
    F.x = args.in[0]; F.in_w = args.in[1]; F.in_b = args.in[2]; F.gn_g = args.in[3]; F.gn_b = args.in[4]; F.sp_w = args.in[5]; F.sp_b = args.in[6]; F.pa_w = args.in[7];
    F.pb_w = args.in[8]; F.out_w = args.in[9]; F.ln1_g = args.in[10]; F.ln1_b = args.in[11]; F.r_w = args.in[12]; F.r_b = args.in[13]; F.e_wg = args.in[14]; F.e_wu = args.in[15];
    F.e_wd = args.in[16]; F.s_wg = args.in[17]; F.s_wu = args.in[18]; F.s_wd = args.in[19]; F.ln2_g = args.in[20]; F.ln2_b = args.in[21];
    F.out = args.out;
    F.WinT = (h16*)(ws + WS_WIN); F.WaT = (h16*)(ws + WS_WA); F.WoT = (h16*)(ws + WS_WO); F.WbT = (h16*)(ws + WS_WB); F.WrT = (h16*)(ws + WS_WR);
    F.W1t = ws + WS_W1T; F.W2t = ws + WS_W2T; F.x1f8 = ws + WS_X1F8; F.x16 = (h16*)(ws + WS_X16); F.x1 = (h16*)(ws + WS_X1); F.yb = (h16*)(ws + WS_YB); F.z = (h16*)(ws + WS_Z);
    F.merged = (h16*)(ws + WS_MERGED); F.h = (h16*)(ws + WS_H); F.hid = ws + WS_HID; F.y = (unsigned char*)(ws + WS_Y);
    F.logit = (float*)(ws + WS_LOGIT); F.gate = (float*)(ws + WS_GATE); F.lse = (float*)(ws + WS_LSE); F.ao = (h16*)(ws + WS_AO); F.Wc = (h16*)(ws + WS_WC);
    F.asg_e = (int*)(ws + WS_ASGE); F.asg_pos = (int*)(ws + WS_ASGP); F.row_tok = (int*)(ws + WS_ROWTOK); F.row_dst = (int*)(ws + WS_ROWDST); F.tile_e = (int*)(ws + WS_TILEE);

    volatile LAS unsigned* MISC = (volatile LAS unsigned*)((LAS unsigned char*)lds + (LDS_BYTES - 64));
    if (F.tid < 16) MISC[F.tid] = 0u;
    __syncthreads();
    XcdBarrier bar; bar.bar = F.ctl + CW_BAR; bar.x = 0; bar.st = nullptr;
    const int lo = args.ph_lo, hi = args.ph_hi;
    if (hi - lo > 1) bar = xcd_barrier_post(F.ctl + CW_BAR, MISC + 8);
#define IN(k) (lo <= (k) && (k) < hi)
#define REP(k) for (int rep_ = 0; rep_ < ((((DUP_MASK) >> (k)) & 1) ? 2 : 1); ++rep_)
#define SEAM(k) do { if (IN(k) && IN((k) + 1)) xcd_barrier(bar); } while (0)

    if (IN(PH_PRO)) REP(PH_PRO) { ph_prologue(F); } SEAM(PH_PRO);
    if (IN(PH_INPROJ)) REP(PH_INPROJ) { ProbDense P{F.x16, F.WinT, T, NIN, 1024, F.G, F.bid}; EpiInProj E{F.h, F.in_b, rep_ ? PROBE_MODE : 0}; GEMM(P, E); } SEAM(PH_INPROJ);
    if (IN(PH_ATTN)) REP(PH_ATTN) { ATTN_PHASE; } SEAM(PH_ATTN);
    if (IN(PH_GMLP)) REP(PH_GMLP) { GMLP_PHASE; } SEAM(PH_GMLP);
    if (IN(PH_YB)) REP(PH_YB) { ProbDense P{F.yb, F.WbT, T, DM, 256, F.G, F.bid}; EpiYb E{F.merged, F.h}; GEMM(P, E); }
    if (IN(PH_YA)) REP(PH_YA) { ProbDense P{F.z, F.WaT, T, DM, 1024, F.G, F.bid}; EpiYa E{F.merged, F.h}; GEMM(P, E); } SEAM(PH_YA);
    if (IN(PH_OUTW)) {
        PanelStats st{(unsigned long long*)(ws + WS_XBUF), F.ctl + CW_PANEL, LN_EPS}; EpiLn1 E{F.x1, F.x1f8, F.x, F.ln1_g, F.ln1_b, st};
        const int nround = (512 + F.G - 1) / F.G;
        for (int ri = 0; ri < nround; ++ri) { ProbDenseR P; P.A = F.merged; P.Bt = F.WoT; P.M = T; P.N = DM; P.K = 1024; P.G = F.G; P.c = F.bid; P.ri = ri; GEMM(P, E); __syncthreads(); }
    } SEAM(PH_OUTW);
    if (IN(PH_ROUTER)) REP(PH_ROUTER) { ProbDense P{F.x1, F.WrT, T, NEXP, 1024, F.G, F.bid}; EpiLogit E{F.logit}; GEMM(P, E); } SEAM(PH_ROUTER);
    if (IN(PH_ROUTE1)) REP(PH_ROUTE1) { ph_route1(F); } SEAM(PH_ROUTE1);
    if (IN(PH_ROUTE2)) REP(PH_ROUTE2) { ph_route2(F); } SEAM(PH_ROUTE2);
    if (IN(PH_MOE1)) REP(PH_MOE1) { const int NT = (int)__hip_atomic_load(F.ctl + CW_NT, __ATOMIC_RELAXED, __HIP_MEMORY_SCOPE_AGENT);
        ProbMoe1 P{(const h16*)F.x1f8, (const h16*)F.W1t, F.row_tok, F.tile_e, NT, 512, F.G, F.bid}; EpiMoe1 E{F.hid}; GEMM(P, E); } SEAM(PH_MOE1);
    if (IN(PH_MOE2)) REP(PH_MOE2) { const int NT = (int)__hip_atomic_load(F.ctl + CW_NT, __ATOMIC_RELAXED, __HIP_MEMORY_SCOPE_AGENT);
        ProbMoe2 P{(const h16*)F.hid, (const h16*)F.W2t, F.tile_e, NT, 128, F.G, F.bid}; EpiMoe2 E{F.y, F.row_dst, rep_ ? PROBE_MODE : 0}; GEMM(P, E); } SEAM(PH_MOE2);
    if (IN(PH_COMBINE)) REP(PH_COMBINE) { ph_combine(F, (LAS unsigned char*)lds); }
#undef IN
#undef SEAM
}

extern "C" void kernel_launch(void* const* d_in, const int* in_sizes, int n_in, void* d_out, int out_size, void* d_ws, size_t ws_size, hipStream_t stream) {
    static int grid = 0;
    if (grid == 0) {
        if (n_in != 22 || in_sizes[0] != T * DM || out_size != T * DM || ws_size < WS_END) {
            fprintf(stderr, "kernel_launch: unexpected problem: n_in %d in0 %d out %d ws %zu (need %zu); nothing launched\n", n_in, n_in > 0 ? in_sizes[0] : -1, out_size, ws_size, (size_t)WS_END);
            grid = -1; return; }
        int dev = 0, cus = 0;
        if (hipGetDevice(&dev) != hipSuccess || hipDeviceGetAttribute(&cus, hipDeviceAttributeMultiprocessorCount, dev) != hipSuccess) { grid = -1; return; }
        if (hipFuncSetAttribute((const void*)mk_fwd, hipFuncAttributeMaxDynamicSharedMemorySize, LDS_BYTES) != hipSuccess) { fprintf(stderr, "kernel_launch: hipFuncSetAttribute failed\n"); grid = -1; return; }
        int per_cu = 0;
        if (hipOccupancyMaxActiveBlocksPerMultiprocessor(&per_cu, (const void*)mk_fwd, NTHREADS, LDS_BYTES) != hipSuccess || per_cu < 1) fprintf(stderr, "kernel_launch: occupancy query reports %d\n", per_cu);
        (void)hipGetLastError();
        grid = cus;
    }
    if (grid < 0) return;
    (void)hipMemsetAsync((char*)d_ws + WS_CTL, 0, CTL_ZERO_BYTES, stream);
    Args a{};
    for (int i = 0; i < 22; ++i) a.in[i] = (const float*)d_in[i];
    a.out = (float*)d_out; a.ws = (unsigned char*)d_ws;
    constexpr int NL = MK_N_LAUNCHES;
    for (int li = 0; li < NL; ++li) {
        a.ph_lo = (NL == 1) ? 0 : li; a.ph_hi = (NL == 1) ? (int)N_PHASES : li + 1;
        hipLaunchKernelGGL(mk_fwd, dim3(grid), dim3(NTHREADS), LDS_BYTES, stream, a);
    }
}
```

```cpp
#include <hip/hip_runtime.h>
#include <cstdio>
#include <cstdint>
#include <cmath>

#ifndef USE_FAST_ATTN
#define USE_FAST_ATTN 1
#endif
#ifndef CONV_IN_ATTN
#define CONV_IN_ATTN 1
#endif
#ifndef ATTN_WAVES
#define ATTN_WAVES 5
#endif
#ifndef MK_N_LAUNCHES
#define MK_N_LAUNCHES 1
#endif

#ifndef USE_BF16
#define USE_BF16 1
#endif
#if USE_BF16
typedef __bf16 h16;
typedef __bf16 f16x8 __attribute__((ext_vector_type(8)));
typedef __bf16 f16x4 __attribute__((ext_vector_type(4)));
typedef __bf16 f16x2 __attribute__((ext_vector_type(2)));
#define MFMA16(a, b, c) __builtin_amdgcn_mfma_f32_16x16x32_bf16(a, b, c, 0, 0, 0)
#define MFMA32(a, b, c) __builtin_amdgcn_mfma_f32_32x32x16_bf16(a, b, c, 0, 0, 0)
#else
typedef _Float16 h16;
typedef _Float16 f16x8 __attribute__((ext_vector_type(8)));
typedef _Float16 f16x4 __attribute__((ext_vector_type(4)));
typedef _Float16 f16x2 __attribute__((ext_vector_type(2)));
#define MFMA16(a, b, c) MFMA16(a, b, c)
#define MFMA32(a, b, c) MFMA32(a, b, c)
#endif
typedef float f32x4 __attribute__((ext_vector_type(4)));
typedef float f32x2 __attribute__((ext_vector_type(2)));
typedef unsigned u32x4 __attribute__((ext_vector_type(4)));
typedef unsigned u32x2 __attribute__((ext_vector_type(2)));
typedef int i32x4 __attribute__((ext_vector_type(4)));
typedef int i32x8 __attribute__((ext_vector_type(8)));
typedef long i64x2 __attribute__((ext_vector_type(2)));
#define MFMA16_F8(a0, a1, b0, b1, c) __builtin_amdgcn_mfma_scale_f32_16x16x128_f8f6f4( \
    __builtin_shufflevector(__builtin_bit_cast(i32x4, a0), __builtin_bit_cast(i32x4, a1), 0, 1, 2, 3, 4, 5, 6, 7), \
    __builtin_shufflevector(__builtin_bit_cast(i32x4, b0), __builtin_bit_cast(i32x4, b1), 0, 1, 2, 3, 4, 5, 6, 7), c, 0, 0, 0, 0x7F7F7F7F, 0, 0x7F7F7F7F)
#define LAS __attribute__((address_space(3)))

constexpr int T = 32768, DM = 1024, NIN = 6400, SEQ = 4096;
constexpr int NEXP = 256, TOPK = 8, EDIM = 256, NASG = T * TOPK;
constexpr int MAXTILES = 1408, MAXROWS = MAXTILES * 256;
constexpr int C_U = 0, C_V = 1024, C_Q = 2048, C_K = 2816, C_VV = 3584, C_GA = 4352, C_GB = 5376;
constexpr float ALPHA = 1.189207115002721f;
constexpr float LN_EPS = 1e-5f;
constexpr float ROUTED_SCALE = 2.5f;
constexpr int NWAVES = 8, NTHREADS = 512;
constexpr float SC_X1 = 16.0f, SC_W = 512.0f, SC_HID = 8.0f, F8_MAX = 448.0f;
constexpr int LDS_BYTES = 147456 + 1024;

constexpr size_t MiB = 1u << 20;
constexpr size_t WS_CTL = 0, CTL_ZERO_BYTES = 1 * MiB;
constexpr size_t WS_WIN = 1 * MiB;
constexpr size_t WS_WA = 14 * MiB;
constexpr size_t WS_WO = 16 * MiB;
constexpr size_t WS_WB = 18 * MiB;
constexpr size_t WS_WR = 19 * MiB;
constexpr size_t WS_WC = 19 * MiB + 512 * 1024;
constexpr size_t WS_ASGE = 20 * MiB;
constexpr size_t WS_ASGP = 21 * MiB;
constexpr size_t WS_GATE = 22 * MiB;
constexpr size_t WS_ROWTOK = 23 * MiB;
constexpr size_t WS_ROWDST = 24 * MiB + 512 * 1024;
constexpr size_t WS_TILEE = 26 * MiB;
constexpr size_t WS_W2T = 27 * MiB;
constexpr size_t WS_X1F8 = 92 * MiB;
constexpr size_t WS_X16 = 156 * MiB;
constexpr size_t WS_X1 = WS_X16;
constexpr size_t WS_YB = 220 * MiB;
constexpr size_t WS_Z = 236 * MiB;
constexpr size_t WS_LOGIT = 236 * MiB;
constexpr size_t WS_MERGED = 300 * MiB;
constexpr size_t WS_W1T = 364 * MiB;
constexpr size_t WS_H = 621 * MiB;
constexpr size_t WS_HID = 848 * MiB;
constexpr size_t WS_Y = 220 * MiB;
constexpr size_t WS_AO = 300 * MiB;
constexpr size_t WS_LSE = 1021 * MiB;
constexpr size_t WS_XBUF = 621 * MiB;
constexpr size_t WS_END = 1024 * MiB;
static_assert(WS_H + (size_t)T * NIN * 2 <= WS_END && WS_HID + (size_t)MAXROWS * 256 * 2 <= WS_END && WS_Y + (size_t)(NASG + T) * 1024 * 2 <= WS_HID, "ws map");
static_assert(WS_W1T + (size_t)257 * 512 * 1024 <= WS_H && WS_W2T + (size_t)257 * 1024 * 256 <= WS_X1F8 && WS_X1F8 + (size_t)T * 1024 <= WS_X16, "ws map 2");
constexpr int CW_NT = 8;
constexpr int CW_CNT = 64;
constexpr int CW_BAR = 4096;
constexpr int CW_CONVQ = 1024;
constexpr int CW_PANEL = 16384;

__device__ __forceinline__ f16x8 pack8(f32x4 a, f32x4 b) {
    f16x8 r;
    r[0] = (h16)a[0]; r[1] = (h16)a[1]; r[2] = (h16)a[2]; r[3] = (h16)a[3];
    r[4] = (h16)b[0]; r[5] = (h16)b[1]; r[6] = (h16)b[2]; r[7] = (h16)b[3];
    return r;
}
__device__ __forceinline__ float sigmoidf_(float x) { return __builtin_amdgcn_rcpf(1.0f + __builtin_amdgcn_exp2f(x * -1.4426950408889634f)); }
__device__ __forceinline__ float gelu_erf(float x) { return 0.5f * x * (1.0f + erff(x * 0.7071067811865476f)); }
__device__ __forceinline__ f32x2 gelu_pk(f32x2 v) {
    const f32x2 av = __builtin_elementwise_abs(v), d = av * 0.2316418882f + 1.0f;
    f32x2 t; t.x = __builtin_amdgcn_rcpf(d.x); t.y = __builtin_amdgcn_rcpf(d.y);
    f32x2 q = t * 0.5307027145f + (-0.7265760135f); q = q * t + 0.7107068705f; q = q * t + (-0.142248368f); q = q * t + 0.127414796f; q = q * t;
    const f32x2 s = (v * v) * (-0.72134752044f);
    f32x2 e; e.x = __builtin_amdgcn_exp2f(s.x); e.y = __builtin_amdgcn_exp2f(s.y);
    const f32x2 m = v * (q * e), r = v - m;
    f32x2 o; o.x = v.x < 0.f ? m.x : r.x; o.y = v.y < 0.f ? m.y : r.y; return o;
}
__device__ __forceinline__ float wave_sum(float v) {
#pragma unroll
    for (int o = 1; o < 64; o <<= 1) v += __shfl_xor(v, o);
    return v;
}
__device__ __forceinline__ float wave_max(float v) {
#pragma unroll
    for (int o = 1; o < 64; o <<= 1) v = fmaxf(v, __shfl_xor(v, o));
    return v;
}

#define XB_TMO      128
#define XB_XCNT(j)  (256  + 64 * (j))
#define XB_XSUB(j)  (1280 + 64 * (j))
#define XB_XGEN(j)  (2304 + 64 * (j))
#define XB_TOP      3328
#define XB_TOPGEN   3392
#define XCD_BAR_WORDS 3456
#define XB_SPIN_CAP (1u << 22)
__device__ __forceinline__ unsigned xb_ld(unsigned* p)              { return __hip_atomic_load(p, __ATOMIC_RELAXED, __HIP_MEMORY_SCOPE_AGENT); }
__device__ __forceinline__ unsigned xb_add(unsigned* p, unsigned v) { return __hip_atomic_fetch_add(p, v, __ATOMIC_RELAXED, __HIP_MEMORY_SCOPE_AGENT); }
__device__ __forceinline__ unsigned xb_xcc_id() { return (unsigned)__builtin_amdgcn_s_getreg((3 << 11) | 20) & 0xFu; }
#define XB_SPIN(cond, bar) do { unsigned _sp = 0; while (cond) { __builtin_amdgcn_s_sleep(1); \
    if ((++_sp & 255u) == 0u) { if (xb_ld(&(bar)[XB_TMO])) break; if (_sp > XB_SPIN_CAP) { atomicAdd(&(bar)[XB_TMO], 1u); break; } } } } while (0)
struct XcdBarrier { unsigned* bar; unsigned x; volatile LAS unsigned* st; };
__device__ __forceinline__ XcdBarrier xcd_barrier_post(unsigned* bar, volatile LAS unsigned* st) {
    XcdBarrier b; b.bar = bar; b.x = xb_xcc_id(); b.st = st;
    if (threadIdx.x == 0) (void)xb_add(&bar[XB_XCNT(b.x)], 1u);
    return b;
}
__device__ __forceinline__ void xcd_barrier_complete(unsigned* bar, unsigned x, unsigned& nloc, unsigned& nx) {
    const unsigned G = gridDim.x * gridDim.y * gridDim.z;
    unsigned sum, cnt, mine, sp = 0u;
    for (;;) {
        sum = 0u; cnt = 0u; mine = 0u;
#pragma unroll
        for (unsigned j = 0; j < 16; ++j) { const unsigned c = xb_ld(&bar[XB_XCNT(j)]); sum += c; cnt += (c > 0u) ? 1u : 0u; mine = (j == x) ? c : mine; }
        if (sum == G) break;
        __builtin_amdgcn_s_sleep(1);
        if ((++sp & 255u) == 0u) { if (xb_ld(&bar[XB_TMO])) break; if (sp > XB_SPIN_CAP) { atomicAdd(&bar[XB_TMO], 1u); break; } }
    }
    nloc = mine > 0u ? mine : 1u; nx = cnt > 0u ? cnt : 1u;
}
__device__ __forceinline__ void xcd_barrier(const XcdBarrier& b) {
    asm volatile("s_waitcnt vmcnt(0)" ::: "memory");
    __syncthreads();
    if (threadIdx.x == 0) {
        unsigned* bar = b.bar;
        __builtin_amdgcn_s_waitcnt(0);
        unsigned nloc = b.st[0], nx = b.st[1];
        if (nloc == 0u) { xcd_barrier_complete(bar, b.x, nloc, nx); b.st[0] = nloc; b.st[1] = nx; }
        const unsigned old = xb_add(&bar[XB_XSUB(b.x)], 1u);
        const unsigned gen = old / nloc;
        if (old + 1u == (gen + 1u) * nloc) {
            __builtin_amdgcn_fence(__ATOMIC_RELEASE, "agent");
            asm volatile("s_waitcnt vmcnt(0)" ::: "memory");
            const unsigned og = xb_add(&bar[XB_TOP], 1u);
            const unsigned tg = og / nx;
            if (og + 1u == (tg + 1u) * nx) xb_add(&bar[XB_TOPGEN], 1u);
            else XB_SPIN(xb_ld(&bar[XB_TOPGEN]) == tg, bar);
            __builtin_amdgcn_fence(__ATOMIC_ACQUIRE, "agent");
            xb_add(&bar[XB_XGEN(b.x)], 1u);
            asm volatile("s_waitcnt vmcnt(0)" ::: "memory");
        } else {
            XB_SPIN(xb_ld(&bar[XB_XGEN(b.x)]) == gen, bar);
            __builtin_amdgcn_fence(__ATOMIC_ACQUIRE, "agent");
            asm volatile("s_waitcnt vmcnt(0)" ::: "memory");
        }
    }
    __syncthreads();
}

struct Args { const float* in[22]; float* out; unsigned char* ws; int ph_lo, ph_hi; };
struct Frame {
    unsigned char* lds;
    unsigned* ctl;
    int tid, lane, wave, G, bid;
    const float *x, *in_w, *in_b, *gn_g, *gn_b, *sp_w, *sp_b, *pa_w, *pb_w, *out_w, *ln1_g, *ln1_b, *r_w, *r_b, *e_wg, *e_wu, *e_wd, *s_wg, *s_wu, *s_wd, *ln2_g, *ln2_b;
    float* out;
    h16 *WinT, *WaT, *WoT, *WbT, *WrT, *x16, *x1, *yb, *z, *merged, *h;
    unsigned char *W1t, *W2t, *x1f8, *hid;
    unsigned char* y;
    float *logit, *gate, *lse;
    h16* ao; h16* Wc;
    int *asg_e, *asg_pos, *row_tok, *row_dst, *tile_e;
};

struct Unit { int pm, pn; };
template <class Prob, class Epi>
__device__ __forceinline__ void gemm_simple(const Prob& P, const Epi& E) {
    const int tid = threadIdx.x, wid = tid >> 6, lane = tid & 63, wr = wid >> 2, wc = wid & 3, fr = lane & 15, fq = lane >> 4;
    const int K = P.K;
    Unit u;
    for (int i = 0; P.next(i, u); ++i) {
        f32x4 acc[2][2][4][2];
#pragma unroll
        for (int a = 0; a < 2; ++a)
#pragma unroll
            for (int b = 0; b < 2; ++b)
#pragma unroll
                for (int m = 0; m < 4; ++m)
#pragma unroll
                    for (int n = 0; n < 2; ++n) acc[a][b][m][n] = (f32x4){0.f, 0.f, 0.f, 0.f};
        int ao[2][4];
#pragma unroll
        for (int ai = 0; ai < 2; ++ai)
#pragma unroll
            for (int m = 0; m < 4; ++m) ao[ai][m] = P.aoff(u, 128 * ai + 64 * wr + 16 * m + fr) + 8 * fq;
        const h16* ab = P.abase();
        const h16* bt = P.bt(u) + (size_t)(Epi::ADJ ? (64 * wc + 16 * (fr >> 2) + (fr & 3)) : (32 * wc + 8 * (fr >> 2) + (fr & 3))) * K + 8 * fq;
        for (int k0 = 0; k0 < K; k0 += 32) {
            f16x8 af[2][4], wf[2][2];
#pragma unroll
            for (int ai = 0; ai < 2; ++ai)
#pragma unroll
                for (int m = 0; m < 4; ++m) af[ai][m] = *(const f16x8*)(ab + ao[ai][m] + k0);
#pragma unroll
            for (int bj = 0; bj < 2; ++bj)
#pragma unroll
                for (int n = 0; n < 2; ++n) wf[bj][n] = *(const f16x8*)(bt + (size_t)((Epi::ADJ ? 8 : 128) * bj + 4 * n) * K + k0);
#pragma unroll
            for (int ai = 0; ai < 2; ++ai)
#pragma unroll
                for (int bj = 0; bj < 2; ++bj)
#pragma unroll
                    for (int m = 0; m < 4; ++m)
#pragma unroll
                        for (int n = 0; n < 2; ++n)
                            acc[ai][bj][m][n] = MFMA16(wf[bj][n], af[ai][m], acc[ai][bj][m][n]);
        }
        if constexpr (!Epi::AFTER_DRAIN) E(acc, u, wr, wc, fr, fq);
    }
}

namespace fg {
constexpr int BK = 64, HALF = 128, HTB = HALF * BK * 2, STAGE_BYTES = 8 * HTB;
__device__ __forceinline__ int lds_byte(int r, int c) { const int st = (r >> 4) * 2 + (c >> 5), rr = r & 15, cc = c & 31, ob = rr * 64 + cc * 2; return st * 1024 + (ob ^ (((ob >> 9) & 1) << 5)); }
__device__ __forceinline__ void stage_rc(int b, int& R, int& C) { const int st = b / 1024, sb = b % 1024, swz = sb ^ (((sb >> 9) & 1) << 5); R = (st >> 1) * 16 + swz / 64; C = (st & 1) * 32 + (swz % 64) / 2; }
__device__ __forceinline__ int perm32(int rho) { const int n = rho >> 4, i = rho & 15; return 8 * (i >> 2) + 4 * n + (i & 3); }

template <class Prob, class Epi>
__device__ __forceinline__ void gemm_fast(LAS unsigned char* lds, const Prob& P, const Epi& E) {
    const int tid = threadIdx.x, wid = __builtin_amdgcn_readfirstlane(tid >> 6), lane = tid & 63, wr = wid >> 2, wc = wid & 3, fr = lane & 15, fq = lane >> 4;
    const int K = P.K, nt = K / BK;
    unsigned voffB[2];
#pragma unroll
    for (int i = 0; i < 2; ++i) { int R, C; stage_rc(tid * 16 + i * 8192, R, C);
        const int Rb = Epi::ADJ ? (64 * (R >> 5) + 16 * ((R & 15) >> 2) + 4 * ((R >> 4) & 1) + (R & 3)) : ((R & ~31) + perm32(R & 31));
        voffB[i] = (unsigned)(Rb * K + C) * 2u; }
    const size_t kstep = (size_t)(BK * 2);
    const size_t hstep = (size_t)(Epi::ADJ ? 8 : HALF) * K * 2;
    const unsigned ldsw = (unsigned)wid * 1024u;
    const int aoff = lds_byte(wr * 64 + fr, fq * 8), boff = lds_byte(wc * 32 + fr, fq * 8);
#define FG_SA(b, h) (((b) * 2 + (h)) * HTB)
#define FG_SB(b, h) ((4 + (b) * 2 + (h)) * HTB)
#define FG_STAGEB(bufoff, gbase) do { _Pragma("unroll") for (int _i = 0; _i < 2; ++_i) { unsigned _vb = voffB[_i]; if constexpr (Prob::F8) asm volatile("" : "+v"(_vb));   \
        __builtin_amdgcn_global_load_lds((const unsigned*)((const char*)(gbase) + _vb), (LAS unsigned*)(lds + (bufoff) + ldsw + _i * 8192), 16, 0, 0); } } while (0)
#define FG_STAGEA(bufoff, gbase, vo, h) do { _Pragma("unroll") for (int _i = 0; _i < 2; ++_i) \
        __builtin_amdgcn_global_load_lds((const unsigned*)((const char*)(gbase) + (vo)[h][_i]), (LAS unsigned*)(lds + (bufoff) + ldsw + _i * 8192), 16, 0, 0); } while (0)
#define FG_LDA(dst, b, h) do { _Pragma("unroll") for (int m = 0; m < 4; ++m) _Pragma("unroll") for (int k = 0; k < 2; ++k) dst[m][k] = *(const LAS f16x8*)(lds + FG_SA(b, h) + aoff + m * 2048 + k * 1024); } while (0)
#define FG_LDB(dst, b, h) do { _Pragma("unroll") for (int n = 0; n < 2; ++n) _Pragma("unroll") for (int k = 0; k < 2; ++k) dst[n][k] = *(const LAS f16x8*)(lds + FG_SB(b, h) + boff + n * 2048 + k * 1024); } while (0)
#define FG_MMA(ai, bj, At, Bt) do { __builtin_amdgcn_s_setprio(1); _Pragma("unroll") for (int m = 0; m < 4; ++m) _Pragma("unroll") for (int n = 0; n < 2; ++n) _Pragma("unroll") for (int k = 0; k < 2; ++k) \
        acc[ai][bj][m][n] = MFMA16(Bt[n][k], At[m][k], acc[ai][bj][m][n]); __builtin_amdgcn_s_setprio(0); } while (0)
#define FG_MMA8(ai, bj, At, Bt) do { __builtin_amdgcn_s_setprio(1); _Pragma("unroll") for (int m = 0; m < 4; ++m) _Pragma("unroll") for (int n = 0; n < 2; ++n) \
        acc[ai][bj][m][n] = MFMA16_F8(Bt[n][0], Bt[n][1], At[m][0], At[m][1], acc[ai][bj][m][n]); __builtin_amdgcn_s_setprio(0); } while (0)
#define FG_MM(ai, bj, At, Bt) do { if constexpr (Prob::F8) FG_MMA8(ai, bj, At, Bt); else FG_MMA(ai, bj, At, Bt); } while (0)
#define FG_WAIT_V(n) asm volatile("s_waitcnt vmcnt(" #n ")" ::: "memory")
#define FG_WAIT_L(n) asm volatile("s_waitcnt lgkmcnt(" #n ")" ::: "memory")
#define FG_BAR __builtin_amdgcn_s_barrier()
#define FG_SCHED __builtin_amdgcn_sched_barrier(0)
#define FG_OFFW(par, u) do { int _t = tid; asm volatile("" : "+v"(_t)); _Pragma("unroll") for (int _h = 0; _h < 2; ++_h) { u32x2 _o; _Pragma("unroll") for (int _i = 0; _i < 2; ++_i) { int _R, _C; stage_rc(_t * 16 + _i * 8192, _R, _C); \
        _o[_i] = (unsigned)(P.aoff(u, 128 * _h + _R) + _C) * 2u; } *(LAS u32x2*)(lds + STAGE_BYTES + _t * 8 + (par) * 8192 + _h * 4096) = _o; } } while (0)
#define FG_STA(bufoff, gbase, vo, par, h) do { if constexpr (Prob::F8) { const u32x2 _o = *(const LAS u32x2*)(offs + (par) * 8192 + (h) * 4096); _Pragma("unroll") for (int _i = 0; _i < 2; ++_i) \
        __builtin_amdgcn_global_load_lds((const unsigned*)((const char*)(gbase) + _o[_i]), (LAS unsigned*)(lds + (bufoff) + ldsw + _i * 8192), 16, 0, 0); } else FG_STAGEA(bufoff, gbase, vo, h); } while (0)
#define FG_VOFF(dst, u) do { _Pragma("unroll") for (int _i = 0; _i < 2; ++_i) { int _R, _C; stage_rc(tid * 16 + _i * 8192, _R, _C); _Pragma("unroll") for (int _h = 0; _h < 2; ++_h) dst[_h][_i] = (unsigned)(P.aoff(u, 128 * _h + _R) + _C) * 2u; } } while (0)
    Unit cur, nxt; int ui = 0;
    if (!P.next(0, cur)) return;
    f32x4 acc[2][2][4][2];
#pragma unroll
    for (int a = 0; a < 2; ++a)
#pragma unroll
        for (int b = 0; b < 2; ++b)
#pragma unroll
            for (int m = 0; m < 4; ++m)
#pragma unroll
                for (int n = 0; n < 2; ++n) acc[a][b][m][n] = (f32x4){0.f, 0.f, 0.f, 0.f};
    f16x8 At[4][2], B0[2][2], B1[2][2];
    unsigned vc[2][2], vn[2][2], vs[2][2];
    LAS unsigned char* offs = lds + STAGE_BYTES + tid * 8;
    if constexpr (Prob::F8) FG_OFFW(0, cur); else FG_VOFF(vc, cur);
    const char* Ab = (const char*)P.abase();
    const char* cB = (const char*)P.bt(cur);
    FG_STAGEB(FG_SB(0, 0), cB); FG_STAGEB(FG_SB(0, 1), cB + hstep); FG_STA(FG_SA(0, 0), Ab, vc, 0, 0); FG_STA(FG_SA(0, 1), Ab, vc, 0, 1);
    if (wr == 1) FG_BAR;
    FG_WAIT_V(2); FG_BAR;
    FG_STAGEB(FG_SB(1, 0), cB + kstep); FG_STA(FG_SA(1, 0), Ab + kstep, vc, 0, 0); FG_STAGEB(FG_SB(1, 1), cB + hstep + kstep);
    FG_WAIT_V(6); FG_BAR;
    for (;;) {
        const bool has_next = P.next(ui + 1, nxt);
        const char* nB = cB;
        const int pc = ui & 1;
        if (has_next) { if constexpr (Prob::F8) FG_OFFW(pc ^ 1, nxt); else FG_VOFF(vn, nxt); nB = (const char*)P.bt(nxt); }
        else {
#pragma unroll
            for (int _h = 0; _h < 2; ++_h)
#pragma unroll
                for (int _i = 0; _i < 2; ++_i) vn[_h][_i] = vc[_h][_i];
        }
#pragma nounroll
        for (int t = 0; t < nt; t += 2) {
            const bool last = (t == nt - 2); const int ps = (last && has_next) ? (pc ^ 1) : pc;
            const char* a1 = Ab + (size_t)(t + 1) * kstep;
            const char* a2 = last ? Ab : Ab + (size_t)(t + 2) * kstep; const char* b2 = last ? nB : cB + (size_t)(t + 2) * kstep;
            const char* a3 = a2 + kstep; const char* b3 = b2 + kstep;
#pragma unroll
            for (int _h = 0; _h < 2; ++_h)
#pragma unroll
                for (int _i = 0; _i < 2; ++_i) vs[_h][_i] = last ? vn[_h][_i] : vc[_h][_i];
            FG_LDB(B0, 0, 0); FG_LDB(B1, 0, 1); FG_SCHED; FG_LDA(At, 0, 0); FG_STA(FG_SA(1, 1), a1, vc, pc, 1);
            FG_WAIT_V(8); FG_WAIT_L(0); FG_BAR; FG_MM(0, 0, At, B0); FG_MM(0, 1, At, B1); FG_BAR; FG_SCHED;
            FG_LDA(At, 0, 1); FG_STAGEB(FG_SB(0, 0), b2); FG_STAGEB(FG_SB(0, 1), b2 + hstep); FG_STA(FG_SA(0, 0), a2, vs, ps, 0);
            FG_WAIT_V(8); FG_WAIT_L(0); FG_BAR; FG_MM(1, 0, At, B0); FG_MM(1, 1, At, B1); FG_BAR; FG_SCHED;
            FG_LDB(B0, 1, 0); FG_LDB(B1, 1, 1); FG_SCHED; FG_LDA(At, 1, 0); FG_STA(FG_SA(0, 1), a2, vs, ps, 1);
            FG_WAIT_V(8); FG_WAIT_L(0); FG_BAR; FG_MM(0, 0, At, B0); FG_MM(0, 1, At, B1); FG_BAR; FG_SCHED;
            FG_LDA(At, 1, 1); FG_STAGEB(FG_SB(1, 0), b3); FG_STAGEB(FG_SB(1, 1), b3 + hstep); FG_STA(FG_SA(1, 0), a3, vs, ps, 0);
            FG_WAIT_V(8); FG_WAIT_L(0); FG_BAR; FG_MM(1, 0, At, B0); FG_MM(1, 1, At, B1); FG_BAR; FG_SCHED;
        }
        if (wr == 0) FG_BAR;
        if constexpr (!Epi::AFTER_DRAIN) E(acc, cur, wr, wc, fr, fq);
        if (!has_next) break;
#pragma unroll
        for (int a = 0; a < 2; ++a)
#pragma unroll
            for (int b = 0; b < 2; ++b)
#pragma unroll
                for (int m = 0; m < 4; ++m)
#pragma unroll
                    for (int n = 0; n < 2; ++n) acc[a][b][m][n] = (f32x4){0.f, 0.f, 0.f, 0.f};
        cur = nxt; cB = nB; ++ui;
#pragma unroll
        for (int _h = 0; _h < 2; ++_h)
#pragma unroll
            for (int _i = 0; _i < 2; ++_i) vc[_h][_i] = vn[_h][_i];
        if (wr == 1) FG_BAR;
    }
    FG_WAIT_V(0);
    FG_BAR;
    if constexpr (Epi::AFTER_DRAIN) E.fused(acc, cur, wr, wc, fr, fq, lds, wid, lane);
#undef FG_SA
#undef FG_SB
#undef FG_STAGEA
#undef FG_STAGEB
#undef FG_LDA
#undef FG_LDB
#undef FG_MMA
#undef FG_MMA8
#undef FG_MM
#undef FG_WAIT_V
#undef FG_WAIT_L
#undef FG_BAR
#undef FG_SCHED
#undef FG_VOFF
#undef FG_OFFW
#undef FG_STA
}
}

__device__ __forceinline__ int xcd_remap(long L, int nwg) {
    const int q = nwg >> 3, r = nwg & 7, xcd = (int)(L & 7), off = (int)(L >> 3);
    return (xcd < r ? xcd * (q + 1) : r * (q + 1) + (xcd - r) * q) + off;
}
struct ProbDense {
    static constexpr bool F8 = false;
    const h16* A; const h16* Bt; int M, N, K; int G, c;
    __device__ __forceinline__ bool next(int i, Unit& u) const {
        const int nM = M / 256, nN = N / 256, nwg = nM * nN; const long L = (long)i * G + c; if (L >= (long)nwg) return false;
        const int w = (G & 7) ? (int)L : xcd_remap(L, nwg);
        const int nig = 8 * nN, gid = w / nig, fm = gid * 8, gsz = (nM - fm) < 8 ? (nM - fm) : 8, wi = w - gid * nig;
        u.pm = fm + wi % gsz; u.pn = wi / gsz; return true;
    }
    __device__ __forceinline__ const h16* abase() const { return A; }
    __device__ __forceinline__ int aoff(const Unit& u, int r) const { return (256 * u.pm + r) * K; }
    __device__ __forceinline__ const h16* bt(const Unit& u) const { return Bt + (size_t)(256 * u.pn) * K; }
};
struct ProbDenseR : ProbDense { int ri; __device__ __forceinline__ bool next(int i, Unit& u) const { return i == 0 ? ProbDense::next(ri, u) : false; } };
struct ProbMoe1 {
    static constexpr bool F8 = true;
    const h16* X1; const h16* W1t; const int* row_tok; const int* tile_e; int NT; int K; int G, c;
    __device__ __forceinline__ bool next(int i, Unit& u) const {
        const int nwg = NT * 2; const int L = i * G + c; if (L >= nwg) return false;
        const int w = (G & 7) ? (int)L : xcd_remap(L, nwg);
        u.pm = w >> 1; u.pn = w & 1; return true;
    }
    __device__ __forceinline__ const h16* abase() const { return X1; }
    __device__ __forceinline__ int aoff(const Unit& u, int r) const { return row_tok[256 * u.pm + r] * 512; }
    __device__ __forceinline__ const h16* bt(const Unit& u) const { return W1t + (size_t)tile_e[u.pm] * (512 * 512) + (size_t)u.pn * (256 * 512); }
};
struct ProbMoe2 {
    static constexpr bool F8 = true;
    const h16* HID; const h16* W2t; const int* tile_e; int NT; int K; int G, c;
    __device__ __forceinline__ bool next(int i, Unit& u) const {
        const int nwg = NT * 4; const int L = i * G + c; if (L >= nwg) return false;
        const int w = (G & 7) ? (int)L : xcd_remap(L, nwg);
        u.pm = w >> 2; u.pn = w & 3; return true;
    }
    __device__ __forceinline__ const h16* abase() const { return HID; }
    __device__ __forceinline__ int aoff(const Unit& u, int r) const { return (256 * u.pm + r) * 128; }
    __device__ __forceinline__ const h16* bt(const Unit& u) const { return W2t + (size_t)tile_e[u.pm] * (1024 * 128) + (size_t)u.pn * (256 * 128); }
};

__device__ __forceinline__ unsigned pk4_fp8s(f32x4 v, float sc) {
    v = v * sc;
#pragma unroll
    for (int j = 0; j < 4; ++j) v[j] = __builtin_amdgcn_fmed3f(v[j], -F8_MAX, F8_MAX);
    int w = 0; w = __builtin_amdgcn_cvt_pk_fp8_f32(v[0], v[1], w, false); w = __builtin_amdgcn_cvt_pk_fp8_f32(v[2], v[3], w, true); return (unsigned)w; }
#define EPI_LOOP_BEGIN \
    _Pragma("unroll") for (int ai = 0; ai < 2; ++ai) _Pragma("unroll") for (int m = 0; m < 4; ++m) { const int row = 256 * u.pm + 128 * ai + 64 * wr + 16 * m + fr; \
    _Pragma("unroll") for (int bj = 0; bj < 2; ++bj) { const int col = 256 * u.pn + 128 * bj + 32 * wc + 8 * fq; f32x4 v0 = acc[ai][bj][m][0], v1 = acc[ai][bj][m][1];
#define EPI_LOOP_END } }

#define EPI_FENCE asm volatile("" ::: "memory")
struct EpiInProj {
    static constexpr bool AFTER_DRAIN = false; static constexpr bool ADJ = false;
    h16* H; const float* bias; int mode;
    __device__ __forceinline__ void operator()(const f32x4 (&acc)[2][2][4][2], const Unit& u, int wr, int wc, int fr, int fq) const {
        if (mode == 2) { asm volatile("" :: "v"(acc[0][0][0][0]), "v"(acc[1][1][3][1])); return; }
        f32x4 bv[2][2];
#pragma unroll
        for (int bj = 0; bj < 2; ++bj) { const int col = 256 * u.pn + 128 * bj + 32 * wc + 8 * fq; bv[bj][0] = *(const f32x4*)(bias + col); bv[bj][1] = *(const f32x4*)(bias + col + 4); }
        EPI_FENCE;
        EPI_LOOP_BEGIN
            v0 += bv[bj][0]; v1 += bv[bj][1];
            if (u.pn < 8) {
                const f32x2 a_ = gelu_pk((f32x2){v0[0], v0[1]}), b_ = gelu_pk((f32x2){v0[2], v0[3]}), c_ = gelu_pk((f32x2){v1[0], v1[1]}), d_ = gelu_pk((f32x2){v1[2], v1[3]});
                v0 = (f32x4){a_.x, a_.y, b_.x, b_.y}; v1 = (f32x4){c_.x, c_.y, d_.x, d_.y};
            }
            *(f16x8*)(H + (size_t)row * NIN + col) = pack8(v0, v1);
        EPI_LOOP_END
    }
};
struct EpiYb {
    static constexpr bool AFTER_DRAIN = false; static constexpr bool ADJ = false;
    h16* MG; const h16* H;
    __device__ __forceinline__ void operator()(const f32x4 (&acc)[2][2][4][2], const Unit& u, int wr, int wc, int fr, int fq) const {
        f16x8 g[2][4][2];
#pragma unroll
        for (int ai = 0; ai < 2; ++ai)
#pragma unroll
            for (int m = 0; m < 4; ++m)
#pragma unroll
                for (int bj = 0; bj < 2; ++bj) g[ai][m][bj] = *(const f16x8*)(H + (size_t)(256 * u.pm + 128 * ai + 64 * wr + 16 * m + fr) * NIN + C_GB + 256 * u.pn + 128 * bj + 32 * wc + 8 * fq);
        EPI_FENCE;
        EPI_LOOP_BEGIN
#pragma unroll
            for (int j = 0; j < 4; ++j) { v0[j] *= sigmoidf_((float)g[ai][m][bj][j]); v1[j] *= sigmoidf_((float)g[ai][m][bj][4 + j]); }
            *(f16x8*)(MG + (size_t)row * DM + col) = pack8(v0, v1);
        EPI_LOOP_END
    }
};
struct EpiYa {
    static constexpr bool AFTER_DRAIN = false; static constexpr bool ADJ = false;
    h16* MG; const h16* H;
    __device__ __forceinline__ void operator()(const f32x4 (&acc)[2][2][4][2], const Unit& u, int wr, int wc, int fr, int fq) const {
#pragma unroll
        for (int ai = 0; ai < 2; ++ai) {
            f16x8 g[4][2], t[4][2];
#pragma unroll
            for (int m = 0; m < 4; ++m)
#pragma unroll
                for (int bj = 0; bj < 2; ++bj) { const int row = 256 * u.pm + 128 * ai + 64 * wr + 16 * m + fr, col = 256 * u.pn + 128 * bj + 32 * wc + 8 * fq;
                    g[m][bj] = *(const f16x8*)(H + (size_t)row * NIN + C_GA + col); t[m][bj] = *(const f16x8*)(MG + (size_t)row * DM + col); }
            EPI_FENCE;
#pragma unroll
            for (int m = 0; m < 4; ++m)
#pragma unroll
                for (int bj = 0; bj < 2; ++bj) { const int row = 256 * u.pm + 128 * ai + 64 * wr + 16 * m + fr, col = 256 * u.pn + 128 * bj + 32 * wc + 8 * fq;
                    f32x4 v0 = acc[ai][bj][m][0], v1 = acc[ai][bj][m][1];
#pragma unroll
                    for (int j = 0; j < 4; ++j) { v0[j] = v0[j] * sigmoidf_((float)g[m][bj][j]) + (float)t[m][bj][j]; v1[j] = v1[j] * sigmoidf_((float)g[m][bj][4 + j]) + (float)t[m][bj][4 + j]; }
                    *(f16x8*)(MG + (size_t)row * DM + col) = pack8(v0, v1); }
            EPI_FENCE;
        }
    }
};
struct EpiOutW {
    static constexpr bool AFTER_DRAIN = false; static constexpr bool ADJ = false;
    float* R; const float* X;
    __device__ __forceinline__ void operator()(const f32x4 (&acc)[2][2][4][2], const Unit& u, int wr, int wc, int fr, int fq) const {
#pragma unroll
        for (int ai = 0; ai < 2; ++ai)
#pragma unroll
            for (int mh = 0; mh < 2; ++mh) {
                f32x4 xv[2][2][2];
#pragma unroll
                for (int mm = 0; mm < 2; ++mm)
#pragma unroll
                    for (int bj = 0; bj < 2; ++bj) { const int m = 2 * mh + mm; const int row = 256 * u.pm + 128 * ai + 64 * wr + 16 * m + fr, col = 256 * u.pn + 128 * bj + 32 * wc + 8 * fq;
                        xv[mm][bj][0] = *(const f32x4*)(X + (size_t)row * DM + col); xv[mm][bj][1] = *(const f32x4*)(X + (size_t)row * DM + col + 4); }
                EPI_FENCE;
#pragma unroll
                for (int mm = 0; mm < 2; ++mm)
#pragma unroll
                    for (int bj = 0; bj < 2; ++bj) { const int m = 2 * mh + mm; const int row = 256 * u.pm + 128 * ai + 64 * wr + 16 * m + fr, col = 256 * u.pn + 128 * bj + 32 * wc + 8 * fq;
                        *(f32x4*)(R + (size_t)row * DM + col) = xv[mm][bj][0] * ALPHA + acc[ai][bj][m][0]; *(f32x4*)(R + (size_t)row * DM + col + 4) = xv[mm][bj][1] * ALPHA + acc[ai][bj][m][1]; }
                EPI_FENCE;
            }
    }
};
struct PanelStats {
    unsigned long long* xbuf;
    unsigned* cnt;
    float eps;
    __device__ __forceinline__ void run(const f32x4 (&v)[2][2][4][2], const Unit& u, int wr, int wc, int fr, int fq, LAS unsigned char* lds, int wid, int lane) const {
        LAS f32x2* P = (LAS f32x2*)lds;
        LAS f32x2* S = (LAS f32x2*)(lds + 8192);
#pragma unroll
        for (int ai = 0; ai < 2; ++ai)
#pragma unroll
            for (int m = 0; m < 4; ++m) {
                float s = 0.f;
#pragma unroll
                for (int bj = 0; bj < 2; ++bj)
#pragma unroll
                    for (int n = 0; n < 2; ++n) { const f32x4 x = v[ai][bj][m][n]; s += (x[0] + x[1]) + (x[2] + x[3]); }
                s += __shfl_xor(s, 16); s += __shfl_xor(s, 32);
                const float mw = s * (1.0f / 64.0f); float q = 0.f;
#pragma unroll
                for (int bj = 0; bj < 2; ++bj)
#pragma unroll
                    for (int n = 0; n < 2; ++n) { const f32x4 d = v[ai][bj][m][n] - mw; q += (d[0] * d[0] + d[1] * d[1]) + (d[2] * d[2] + d[3] * d[3]); }
                q += __shfl_xor(q, 16); q += __shfl_xor(q, 32);
                if (fq == 0) P[(ai * 128 + wr * 64 + m * 16 + fr) * 4 + wc] = (f32x2){mw, q};
            }
        asm volatile("s_waitcnt lgkmcnt(0)" ::: "memory"); __builtin_amdgcn_s_barrier(); asm volatile("" ::: "memory");
        const int row = wid * 32 + (lane & 31);
        if (lane < 32) {
            const f32x2 a = P[row * 4 + 0], b = P[row * 4 + 1], c = P[row * 4 + 2], d = P[row * 4 + 3];
            const float mt = (a.x + b.x + c.x + d.x) * 0.25f;
            const float da = a.x - mt, db = b.x - mt, dc = c.x - mt, dd = d.x - mt;
            const float m2 = (a.y + b.y) + (c.y + d.y) + 64.0f * ((da * da + db * db) + (dc * dc + dd * dd));
            unsigned long long* slot = xbuf + ((size_t)(u.pm * 256 + row) * 4 + u.pn);
            __hip_atomic_store(slot, ((unsigned long long)__float_as_uint(m2) << 32) | __float_as_uint(mt), __ATOMIC_RELAXED, __HIP_MEMORY_SCOPE_AGENT);
        }
        asm volatile("s_waitcnt vmcnt(0)" ::: "memory");
        if (lane == 0) __hip_atomic_fetch_add(cnt + 64 * u.pm, 1u, __ATOMIC_RELAXED, __HIP_MEMORY_SCOPE_AGENT);
        if (wid == 0) {
            unsigned sp = 0;
            while ((unsigned)__builtin_amdgcn_readfirstlane(__hip_atomic_load(cnt + 64 * u.pm, __ATOMIC_RELAXED, __HIP_MEMORY_SCOPE_AGENT)) < 32u) { __builtin_amdgcn_s_sleep(2); if (++sp > (1u << 22)) break; }
            __builtin_amdgcn_fence(__ATOMIC_ACQUIRE, "agent");
        }
        asm volatile("s_waitcnt vmcnt(0) lgkmcnt(0)" ::: "memory"); __builtin_amdgcn_s_barrier(); asm volatile("" ::: "memory");
        if (lane < 32) {
            const unsigned long long* slot = xbuf + (size_t)(u.pm * 256 + row) * 4; float mt[4], m2[4]; float ms = 0.f;
#pragma unroll
            for (int t = 0; t < 4; ++t) { const unsigned long long w = __hip_atomic_load(slot + t, __ATOMIC_RELAXED, __HIP_MEMORY_SCOPE_AGENT); mt[t] = __uint_as_float((unsigned)w); m2[t] = __uint_as_float((unsigned)(w >> 32)); ms += mt[t]; }
            const float mean = ms * 0.25f; float q = 0.f;
#pragma unroll
            for (int t = 0; t < 4; ++t) { const float dm = mt[t] - mean; q += m2[t] + 256.0f * dm * dm; }
            S[row] = (f32x2){mean, 1.0f / sqrtf(q * (1.0f / 1024.0f) + eps)};
        }
        asm volatile("s_waitcnt lgkmcnt(0)" ::: "memory"); __builtin_amdgcn_s_barrier(); asm volatile("" ::: "memory");
    }
};
struct EpiLn1 {
    static constexpr bool AFTER_DRAIN = true; static constexpr bool ADJ = false;
    h16* X1; unsigned char* X1F8; const float* X; const float* g; const float* b; PanelStats st;
    __device__ __forceinline__ void operator()(const f32x4 (&)[2][2][4][2], const Unit&, int, int, int, int) const {}
    __device__ __forceinline__ void fused(f32x4 (&acc)[2][2][4][2], const Unit& u, int wr, int wc, int fr, int fq, LAS unsigned char* lds, int wid, int lane) const {
#pragma unroll
        for (int ai = 0; ai < 2; ++ai)
#pragma unroll
            for (int mh = 0; mh < 2; ++mh) {
                f32x4 xv[2][2][2];
#pragma unroll
                for (int mm = 0; mm < 2; ++mm)
#pragma unroll
                    for (int bj = 0; bj < 2; ++bj) { const int m = 2 * mh + mm; const int row = 256 * u.pm + 128 * ai + 64 * wr + 16 * m + fr, col = 256 * u.pn + 128 * bj + 32 * wc + 8 * fq;
                        xv[mm][bj][0] = *(const f32x4*)(X + (size_t)row * DM + col); xv[mm][bj][1] = *(const f32x4*)(X + (size_t)row * DM + col + 4); }
#pragma unroll
                for (int mm = 0; mm < 2; ++mm)
#pragma unroll
                    for (int bj = 0; bj < 2; ++bj) { const int m = 2 * mh + mm; acc[ai][bj][m][0] += xv[mm][bj][0] * ALPHA; acc[ai][bj][m][1] += xv[mm][bj][1] * ALPHA; }
                asm volatile("" : "+v"(acc[ai][0][2 * mh][0]), "+v"(acc[ai][0][2 * mh + 1][0]), "+v"(acc[ai][1][2 * mh][0]), "+v"(acc[ai][1][2 * mh + 1][0]));
            }
        st.run(acc, u, wr, wc, fr, fq, lds, wid, lane);
        const LAS f32x2* S = (const LAS f32x2*)(lds + 8192);
        f32x4 gv[2][2], bv[2][2];
#pragma unroll
        for (int bj = 0; bj < 2; ++bj) { const int col = 256 * u.pn + 128 * bj + 32 * wc + 8 * fq; gv[bj][0] = *(const f32x4*)(g + col); gv[bj][1] = *(const f32x4*)(g + col + 4); bv[bj][0] = *(const f32x4*)(b + col); bv[bj][1] = *(const f32x4*)(b + col + 4); }
        EPI_FENCE;
#pragma unroll
        for (int ai = 0; ai < 2; ++ai)
#pragma unroll
            for (int m = 0; m < 4; ++m) { const int rl = 128 * ai + 64 * wr + 16 * m + fr; const f32x2 sr = S[rl]; const int row = 256 * u.pm + rl;
#pragma unroll
                for (int bj = 0; bj < 2; ++bj) { const int col = 256 * u.pn + 128 * bj + 32 * wc + 8 * fq;
                    const f32x4 o0 = (acc[ai][bj][m][0] - sr.x) * sr.y * gv[bj][0] + bv[bj][0], o1 = (acc[ai][bj][m][1] - sr.x) * sr.y * gv[bj][1] + bv[bj][1];
                    *(f16x8*)(X1 + (size_t)row * DM + col) = pack8(o0, o1);
                    *(u32x2*)(X1F8 + (size_t)row * DM + col) = (u32x2){pk4_fp8s(o0, SC_X1), pk4_fp8s(o1, SC_X1)}; } }
    }
};
struct EpiLogit {
    static constexpr bool AFTER_DRAIN = false; static constexpr bool ADJ = false;
    float* L;
    __device__ __forceinline__ void operator()(const f32x4 (&acc)[2][2][4][2], const Unit& u, int wr, int wc, int fr, int fq) const {
        EPI_LOOP_BEGIN
            *(f32x4*)(L + (size_t)row * NEXP + col) = v0; *(f32x4*)(L + (size_t)row * NEXP + col + 4) = v1;
        EPI_LOOP_END
    }
};
struct EpiMoe1 {
    static constexpr bool AFTER_DRAIN = false; static constexpr bool ADJ = false;
    unsigned char* HID;
    __device__ __forceinline__ void operator()(const f32x4 (&acc)[2][2][4][2], const Unit& u, int wr, int wc, int, int) const {
        constexpr float IS = 1.0f / (SC_X1 * SC_W);
        int t_ = threadIdx.x; asm volatile("" : "+v"(t_)); const int fr = t_ & 15, fq = (t_ >> 4) & 3;
#pragma unroll
        for (int ai = 0; ai < 2; ++ai)
#pragma unroll
            for (int m = 0; m < 4; ++m) {
                const int row = 256 * u.pm + 128 * ai + 64 * wr + 16 * m + fr; const int col = 128 * u.pn + 32 * wc + 8 * fq;
                f32x4 g0 = acc[ai][0][m][0], g1 = acc[ai][0][m][1], u0 = acc[ai][1][m][0], u1 = acc[ai][1][m][1];
#pragma unroll
                for (int j = 0; j < 4; ++j) { const float a0 = g0[j] * IS, a1 = g1[j] * IS; g0[j] = a0 * sigmoidf_(a0) * u0[j]; g1[j] = a1 * sigmoidf_(a1) * u1[j]; }
                *(u32x2*)(HID + (size_t)row * EDIM + col) = (u32x2){pk4_fp8s(g0, IS * SC_HID), pk4_fp8s(g1, IS * SC_HID)};
            }
    }
};
constexpr float Y_SCALE = 64.0f, Y_INV = 1.0f / 64.0f;
__device__ __forceinline__ unsigned pk4_fp8(f32x4 v) { return pk4_fp8s(v, Y_SCALE / (SC_HID * SC_W)); }
struct EpiMoe2 {
    static constexpr bool AFTER_DRAIN = false; static constexpr bool ADJ = true;
    unsigned char* Y; const int* row_dst; int mode;
    __device__ __forceinline__ void operator()(const f32x4 (&acc)[2][2][4][2], const Unit& u, int wr, int wc, int fr, int fq) const {
        if (mode == 2) { asm volatile("" :: "v"(acc[0][0][0][0]), "v"(acc[1][1][3][1])); return; }
        int dsts[2][4];
#pragma unroll
        for (int ai = 0; ai < 2; ++ai)
#pragma unroll
            for (int m = 0; m < 4; ++m) dsts[ai][m] = row_dst[256 * u.pm + 128 * ai + 64 * wr + 16 * m + fr];
        EPI_FENCE;
        const int col = 256 * u.pn + 64 * wc + 16 * fq;
#pragma unroll
        for (int ai = 0; ai < 2; ++ai)
#pragma unroll
            for (int m = 0; m < 4; ++m) {
                const int dst = dsts[ai][m];
                if (dst >= 0) {
                    u32x4 w; w[0] = pk4_fp8(acc[ai][0][m][0]); w[1] = pk4_fp8(acc[ai][0][m][1]); w[2] = pk4_fp8(acc[ai][1][m][0]); w[3] = pk4_fp8(acc[ai][1][m][1]);
                    if (mode == 0) *(u32x4*)(Y + (size_t)dst * DM + col) = w; else asm volatile("" :: "v"(w));
                }
            }
    }
};

__device__ __forceinline__ void tr_item(const float* W, int K, int N, int k0, int n0, h16* dst, float* scr, int lane) {
    (void)scr;
    const int lk = lane & 7, ln = lane >> 3;
    const float* src = W + (size_t)(k0 + 8 * lk) * N + n0 + 4 * ln;
    f32x4 v[8];
#pragma unroll
    for (int i = 0; i < 8; ++i) v[i] = __builtin_nontemporal_load((const f32x4*)(src + (size_t)i * N));
#pragma unroll
    for (int j = 0; j < 4; ++j) { f16x8 o;
#pragma unroll
        for (int i = 0; i < 8; ++i) o[i] = (h16)v[i][j];
        *(f16x8*)(dst + (size_t)(4 * ln + j) * K + k0 + 8 * lk) = o; }
}
constexpr int CONV_PER_E = 192, CONV_NIT = 257 * CONV_PER_E, CONV_NF = 2;
__device__ __forceinline__ void conv_item_addr(const Frame& F, int it, const float*& src, int& K, int& N, int& k0, int& n0, unsigned char*& dst) {
    const int e = it / CONV_PER_E; int r = it - e * CONV_PER_E;
    const float* wg = e < 256 ? F.e_wg + (size_t)e * 1024 * 256 : F.s_wg;
    const float* wu = e < 256 ? F.e_wu + (size_t)e * 1024 * 256 : F.s_wu;
    const float* wd = e < 256 ? F.e_wd + (size_t)e * 256 * 1024 : F.s_wd;
    unsigned char* w1 = F.W1t + (size_t)e * 512 * 1024; unsigned char* w2 = F.W2t + (size_t)e * 1024 * 256;
    if (r < 64) { const int kb = r >> 3, nb = r & 7; n0 = 32 * nb; k0 = 128 * kb; src = wg; K = 1024; N = 256; dst = w1 + (size_t)((n0 >> 7) * 256 + (n0 & 127)) * 1024; return; } r -= 64;
    if (r < 64) { const int kb = r >> 3, nb = r & 7; n0 = 32 * nb; k0 = 128 * kb; src = wu; K = 1024; N = 256; dst = w1 + (size_t)((n0 >> 7) * 256 + 128 + (n0 & 127)) * 1024; return; } r -= 64;
    { const int kb = r >> 5, nb = r & 31; n0 = 32 * nb; k0 = 128 * kb; src = wd; K = 256; N = 1024; dst = w2 + (size_t)n0 * 256; }
}
#define CONV_LOAD(u, itv) { const float* sp; int N0, n0; conv_item_addr(F, itv, sp, Kd[u], N0, kd[u], n0, d[u]); \
        const float* p = sp + (size_t)(kd[u] + 16 * lk) * N0 + n0 + 4 * ln; \
        _Pragma("unroll") for (int i = 0; i < 16; ++i) v[u][i] = __builtin_nontemporal_load((const f32x4*)(p + (size_t)i * N0)); }
#define CONV_STORE(u) { _Pragma("unroll") for (int j = 0; j < 4; ++j) { u32x4 o; \
        _Pragma("unroll") for (int i4 = 0; i4 < 4; ++i4) { int w = 0; \
            w = __builtin_amdgcn_cvt_pk_fp8_f32(v[u][4 * i4][j] * SC_W, v[u][4 * i4 + 1][j] * SC_W, w, false); w = __builtin_amdgcn_cvt_pk_fp8_f32(v[u][4 * i4 + 2][j] * SC_W, v[u][4 * i4 + 3][j] * SC_W, w, true); o[i4] = (unsigned)w; } \
        __builtin_nontemporal_store(o, (u32x4*)(d[u] + (size_t)(4 * ln + j) * Kd[u] + kd[u] + 16 * lk)); } }
__device__ __forceinline__ void conv_experts(Frame& F, int gw, int NGW) {
    const int lane = F.lane, lk = lane & 7, ln = lane >> 3;
    constexpr int NIT = CONV_NIT, NF = CONV_NF;
    for (int it = gw; it < NIT; it += NF * NGW) {
        f32x4 v[NF][16]; unsigned char* d[NF]; int Kd[NF], kd[NF]; bool ok[NF];
#pragma unroll
        for (int u = 0; u < NF; ++u) { const int itu = it + u * NGW; ok[u] = itu < NIT; CONV_LOAD(u, ok[u] ? itu : it) }
#pragma unroll
        for (int u = 0; u < NF; ++u) { if (ok[u]) CONV_STORE(u) }
    }
}
__device__ __forceinline__ void conv_experts_dyn(Frame& F) {
    const int lane = F.lane, lk = lane & 7, ln = lane >> 3;
    constexpr int NIT = CONV_NIT, NF = CONV_NF, CH = 12, PER = NIT / 8;
    const int x = F.bid & 7; unsigned* ctr = F.ctl + CW_CONVQ + 64 * x;
    const int lo = x * PER, hi = (x == 7) ? NIT : lo + PER;
    for (;;) {
        unsigned b0 = 0;
        if (lane == 0) b0 = __hip_atomic_fetch_add(ctr, (unsigned)CH, __ATOMIC_RELAXED, __HIP_MEMORY_SCOPE_AGENT);
        const int base = lo + (int)__builtin_amdgcn_readfirstlane(b0);
        if (base >= hi) break;
        const int end = base + CH < hi ? base + CH : hi;
        for (int it = base; it < end; it += NF) {
            f32x4 v[NF][16]; unsigned char* d[NF]; int Kd[NF], kd[NF]; bool ok[NF];
#pragma unroll
            for (int u = 0; u < NF; ++u) { const int itu = it + u; ok[u] = itu < end; CONV_LOAD(u, ok[u] ? itu : it) }
#pragma unroll
            for (int u = 0; u < NF; ++u) { if (ok[u]) CONV_STORE(u) }
        }
    }
}
__device__ __forceinline__ void ph_prologue(Frame& F) {
    float* scr = (float*)(F.lds + F.wave * 16384);
    const int gw = F.bid * NWAVES + F.wave, NGW = F.G * NWAVES;
    constexpr int I_IN = 16 * 200, I_A = 16 * 32, I_B = 4 * 32, I_O = 16 * 32, I_R = 16 * 8, I_SMALL = I_IN + I_A + I_B + I_O + I_R;
    for (int it = gw; it < I_SMALL; it += NGW) {
        int r = it;
        if (r < I_IN) { const int kb = r / 200, nb = r % 200; tr_item(F.in_w, 1024, NIN, 64 * kb, 32 * nb, F.WinT + (size_t)(32 * nb) * 1024, scr, F.lane); continue; } r -= I_IN;
        if (r < I_A) { const int kb = r / 32, nb = r % 32; tr_item(F.pa_w, 1024, 1024, 64 * kb, 32 * nb, F.WaT + (size_t)(32 * nb) * 1024, scr, F.lane); continue; } r -= I_A;
        if (r < I_B) { const int kb = r / 32, nb = r % 32; tr_item(F.pb_w, 256, 1024, 64 * kb, 32 * nb, F.WbT + (size_t)(32 * nb) * 256, scr, F.lane); continue; } r -= I_B;
        if (r < I_O) { const int kb = r / 32, nb = r % 32; tr_item(F.out_w, 1024, 1024, 64 * kb, 32 * nb, F.WoT + (size_t)(32 * nb) * 1024, scr, F.lane); continue; } r -= I_O;
        { const int kb = r / 8, nb = r % 8; tr_item(F.r_w, 1024, 256, 64 * kb, 32 * nb, F.WrT + (size_t)(32 * nb) * 1024, scr, F.lane); }
    }
#if !CONV_IN_ATTN
    conv_experts(F, F.bid * NWAVES + F.wave, F.G * NWAVES);
#endif
    for (int i = F.bid * NTHREADS + F.tid; i < 8 * 128 * 128; i += F.G * NTHREADS) { const int tt = (i >> 7) & 127, ss = i & 127; F.Wc[i] = (ss <= tt) ? (h16)F.sp_w[i] : (h16)0.f; }
    const size_t nth = (size_t)F.G * NTHREADS; const size_t n8 = (size_t)T * DM / 8;
    for (size_t i = (size_t)F.bid * NTHREADS + F.tid; i < n8; i += 4 * nth) {
        f32x4 a[4], b[4];
#pragma unroll
        for (int u = 0; u < 4; ++u) { const size_t j = i + u * nth; if (j < n8) { a[u] = __builtin_nontemporal_load((const f32x4*)(F.x + j * 8)); b[u] = __builtin_nontemporal_load((const f32x4*)(F.x + j * 8 + 4)); } }
#pragma unroll
        for (int u = 0; u < 4; ++u) { const size_t j = i + u * nth; if (j < n8) *(f16x8*)(F.x16 + j * 8) = pack8(a[u], b[u]); }
    }
}

__device__ __forceinline__ void ph_attn_simple(Frame& F) {
    float* pl = (float*)(F.lds) + F.wave * 512;
    const int gw = F.bid * NWAVES + F.wave, NGW = F.G * NWAVES;
    const int lane = F.lane;
    for (int it = gw; it < T * 4; it += NGW) {
        const int t = it >> 2, hg = it & 3; const int s = t & (SEQ - 1);
        float sc[3][3];
        float mx = -INFINITY;
#pragma unroll
        for (int g = 0; g < 3; ++g) {
            const int hh = 4 * g + hg; const int dil = (g == 0) ? 1 : (g == 1 ? 4 : 16);
            const float slope = exp2f(hh < 8 ? -0.5f * (float)(hh + 1) : -(float)(hh - 3));
            const h16* qp = F.h + (size_t)t * NIN + C_Q + hh * 64;
            f16x8 q[8];
#pragma unroll
            for (int j = 0; j < 8; ++j) q[j] = *(const f16x8*)(qp + 8 * j);
#pragma unroll
            for (int r = 0; r < 3; ++r) {
                const int delta = lane + 64 * r; const bool valid = (r < 2 || lane == 0) && (s - delta * dil >= 0);
                float v = -INFINITY;
                if (valid) {
                    const h16* kp = F.h + (size_t)(t - delta * dil) * NIN + C_K + hh * 64;
                    float d = 0.f;
#pragma unroll
                    for (int j = 0; j < 8; ++j) { const f16x8 kk = *(const f16x8*)(kp + 8 * j);
#pragma unroll
                        for (int e = 0; e < 8; ++e) d += (float)q[j][e] * (float)kk[e]; }
                    v = d * 0.125f - slope * (float)(delta * dil);
                }
                sc[g][r] = v; mx = fmaxf(mx, v);
            }
        }
        mx = wave_max(mx);
        float lsum = 0.f;
#pragma unroll
        for (int g = 0; g < 3; ++g)
#pragma unroll
            for (int r = 0; r < 3; ++r) {
                const float p = (sc[g][r] == -INFINITY) ? 0.f : __expf(sc[g][r] - mx);
                lsum += p;
                if (r < 2 || lane == 0) pl[g * 129 + lane + 64 * r] = p;
            }
        lsum = wave_sum(lsum);
        __builtin_amdgcn_s_waitcnt(0xc07f); asm volatile("" ::: "memory");
        float o = 0.f;
#pragma unroll
        for (int g = 0; g < 3; ++g) {
            const int hh = 4 * g + hg; const int dil = (g == 0) ? 1 : (g == 1 ? 4 : 16);
            int nk = s / dil + 1; if (nk > 129) nk = 129;
            const h16* vp = F.h + (size_t)t * NIN + C_VV + hh * 64 + lane;
            for (int delta = 0; delta < nk; ++delta) o += pl[g * 129 + delta] * (float)vp[-(long)delta * dil * NIN];
        }
        F.yb[(size_t)t * 256 + hg * 64 + lane] = (h16)(o / lsum);
        asm volatile("" ::: "memory");
    }
}

typedef float f32x16 __attribute__((ext_vector_type(16)));
typedef short v4i16_t __attribute__((ext_vector_type(4)));
__device__ __forceinline__ int crow(int r, int hi) { return (r & 3) + 8 * (r >> 2) + 4 * hi; }
__device__ __forceinline__ void ph_attn_fast(Frame& F, LAS unsigned char* ldsb) {
    const int lane = F.lane, q = lane & 31, hi = lane >> 5;
    LAS unsigned char* vl = ldsb + F.wave * 8448;
    const int vcu = (F.G % 8 == 0) ? (F.bid % 8) * (F.G / 8) + F.bid / 8 : F.bid;
    constexpr int NTASK = 8 * 12 * 32 * 4;
#if CONV_IN_ATTN
    constexpr int NA = ATTN_WAVES;
    if (F.wave >= NA) { conv_experts_dyn(F); return; }
#else
    constexpr int NA = NWAVES;
#endif
    const int R = (NTASK + F.G * NA - 1) / (F.G * NA);
    const int li = lane & 15;
    const int tr_base = (4 * hi + (li >> 2)) * 64 + (16 * ((lane >> 4) & 1) + 4 * (li & 3)) * 2;
    const int vw_kv = lane >> 3, vw_c = lane & 7;
    const int vw_off = (vw_c >> 2) * 2112 + vw_kv * 64 + (vw_c & 3) * 16;
    for (int it = 0; it < R; ++it) {
        const int task = (vcu * R + it) * NA + F.wave;
        if (task >= NTASK) break;
        const int unit = task >> 2, a = task & 3, bh = unit >> 5, blk = unit & 31;
        const int b = bh / 12, hh = bh - b * 12, g = hh >> 2, dsh = 2 * g, dil = 1 << dsh;
        const int n = blk >> dsh, r = blk & (dil - 1);
        const int Iq0 = n * 128 + 32 * a, Ik0 = Iq0 - 128;
        const int nskip = Ik0 < 0 ? ((-Ik0) >> 5) : 0;
        const float slope = exp2f(hh < 8 ? -0.5f * (float)(hh + 1) : -(float)(hh - 3));
        const float c1 = 0.125f * 1.4426950408889634f, c2 = slope * (float)dil * 1.4426950408889634f;
        const h16* hb = F.h + (size_t)b * SEQ * NIN + (size_t)r * NIN + hh * 64;
        const size_t rs = (size_t)dil * NIN;
        f16x8 qf[4];
        { const h16* qp = hb + (size_t)(Iq0 + q) * rs + C_Q + 8 * hi;
#pragma unroll
          for (int s4 = 0; s4 < 4; ++s4) qf[s4] = *(const f16x8*)(qp + 16 * s4); }
        f32x16 S[5];
        {
            f16x8 kf[3][4];
#pragma unroll
            for (int kb = 0; kb < 3; ++kb) {
                const int kbc = kb;
                const h16* kp = hb + (size_t)(Ik0 + 32 * kbc + q) * rs + C_K + 8 * hi;
#pragma unroll
                for (int s4 = 0; s4 < 4; ++s4) kf[kb][s4] = *(const f16x8*)(kp + 16 * s4);
            }
#pragma unroll
            for (int kb = 0; kb < 3; ++kb) {
#pragma unroll
                for (int e = 0; e < 16; ++e) S[kb][e] = 0.f;
#pragma unroll
                for (int s4 = 0; s4 < 4; ++s4) S[kb] = MFMA32(kf[kb][s4], qf[s4], S[kb]);
            }
        }
        {
            f16x8 kf[2][4];
#pragma unroll
            for (int kb = 3; kb < 5; ++kb) {
                const int kbc = kb;
                const h16* kp = hb + (size_t)(Ik0 + 32 * kbc + q) * rs + C_K + 8 * hi;
#pragma unroll
                for (int s4 = 0; s4 < 4; ++s4) kf[kb - 3][s4] = *(const f16x8*)(kp + 16 * s4);
            }
#pragma unroll
            for (int kb = 3; kb < 5; ++kb) {
#pragma unroll
                for (int e = 0; e < 16; ++e) S[kb][e] = 0.f;
#pragma unroll
                for (int s4 = 0; s4 < 4; ++s4) S[kb] = MFMA32(kf[kb - 3][s4], qf[s4], S[kb]);
            }
        }
        f16x8 vgA[3][4], vgB[2][4];
#pragma unroll
        for (int kb = 0; kb < 3; ++kb) {
            const int kbc = kb;
#pragma unroll
            for (int i = 0; i < 4; ++i) vgA[kb][i] = *(const f16x8*)(hb + (size_t)(Ik0 + 32 * kbc + 8 * i + vw_kv) * rs + C_VV + 8 * vw_c);
        }
        int qq = q; asm volatile("" : "+v"(qq));
        const float nb = -c2 * (float)(qq + 128 - 4 * hi);
        const int qrel = qq - 4 * hi;
        float m = -INFINITY;
#pragma unroll
        for (int kb = 0; kb < 5; ++kb)
#pragma unroll
            for (int e = 0; e < 16; ++e) {
                const int ec = (e & 3) + 8 * (e >> 2);
                float v = __builtin_fmaf(S[kb][e], c1, __builtin_fmaf(c2, (float)(32 * kb + ec), nb));
                bool ok = kb >= nskip;
                if (kb == 0) ok = ok && (ec >= qrel);
                if (kb == 4) ok = ok && (ec <= qrel);
                v = ok ? v : -INFINITY;
                S[kb][e] = v; m = fmaxf(m, v);
            }
        m = fmaxf(m, __shfl_xor(m, 32));
        float l = 0.f;
        f16x8 pf[5][2];
#pragma unroll
        for (int kb = 0; kb < 5; ++kb)
#pragma unroll
            for (int e = 0; e < 16; ++e) { const float p = __builtin_amdgcn_exp2f(S[kb][e] - m); l += p; pf[kb][e >> 3][e & 7] = (h16)p; }
        l += __shfl_xor(l, 32);
#pragma unroll
        for (int kb = 3; kb < 5; ++kb) {
            const int kbc = kb;
#pragma unroll
            for (int i = 0; i < 4; ++i) vgB[kb - 3][i] = *(const f16x8*)(hb + (size_t)(Ik0 + 32 * kbc + 8 * i + vw_kv) * rs + C_VV + 8 * vw_c);
        }
        f32x16 O[2];
#pragma unroll
        for (int e = 0; e < 16; ++e) { O[0][e] = 0.f; O[1][e] = 0.f; }
#pragma unroll
        for (int kb = 0; kb < 5; ++kb) {
            LAS unsigned char* vb = vl + (kb & 1) * 4224;
#pragma unroll
            for (int i = 0; i < 4; ++i) *(LAS f16x8*)(vb + vw_off + i * 512) = (kb < 3) ? vgA[kb < 3 ? kb : 0][i] : vgB[kb >= 3 ? kb - 3 : 0][i];
#pragma unroll
            for (int s2 = 0; s2 < 2; ++s2) {
#pragma unroll
                for (int db = 0; db < 2; ++db) {
                    const v4i16_t lo = __builtin_amdgcn_ds_read_tr16_b64_v4i16((LAS v4i16_t*)(vb + tr_base + db * 2112 + s2 * 1024));
                    const v4i16_t hi4 = __builtin_amdgcn_ds_read_tr16_b64_v4i16((LAS v4i16_t*)(vb + tr_base + db * 2112 + s2 * 1024 + 512));
                    typedef short s16x8 __attribute__((ext_vector_type(8)));
                    const s16x8 vv = (s16x8){lo[0], lo[1], lo[2], lo[3], hi4[0], hi4[1], hi4[2], hi4[3]};
                    O[db] = MFMA32(__builtin_bit_cast(f16x8, vv), pf[kb][s2], O[db]);
                }
            }
        }
        const float rl = 1.0f / l;
        const size_t tq = (size_t)b * SEQ + (size_t)(Iq0 + q) * dil + r;
        {
            LAS unsigned char* ot = vl;
#pragma unroll
            for (int db = 0; db < 2; ++db)
#pragma unroll
                for (int r4 = 0; r4 < 4; ++r4) { f16x4 w;
#pragma unroll
                    for (int e = 0; e < 4; ++e) w[e] = (h16)(O[db][4 * r4 + e] * rl);
                    const int d0 = 32 * db + 8 * r4 + 4 * hi;
                    *(LAS f16x4*)(ot + q * 128 + ((((d0 >> 3) ^ (q & 7)) << 4) | ((d0 & 7) * 2))) = w; }
#pragma unroll
            for (int j = 0; j < 4; ++j) { const int row = 8 * j + (lane >> 3), ch = lane & 7;
                const f16x8 v = *(const LAS f16x8*)(ot + row * 128 + ((ch ^ (row & 7)) << 4));
                const size_t tr = (size_t)b * SEQ + (size_t)(Iq0 + row) * dil + r;
                *(f16x8*)(F.ao + tr * 768 + hh * 64 + 8 * ch) = v; }
        }
        if (hi == 0) F.lse[tq * 12 + hh] = (m + __builtin_amdgcn_logf(l)) * 0.6931471805599453f;
    }
#if CONV_IN_ATTN
    conv_experts_dyn(F);
#endif
}
__device__ __forceinline__ void attn_merge_chunk(Frame& F, int t0) {
    for (int idx = F.tid; idx < 4096; idx += NTHREADS) {
        const int c = idx & 7, hg = (idx >> 3) & 3, t = t0 + (idx >> 5);
        const float l0 = F.lse[(size_t)t * 12 + hg], l1 = F.lse[(size_t)t * 12 + 4 + hg], l2 = F.lse[(size_t)t * 12 + 8 + hg];
        const float mx = fmaxf(l0, fmaxf(l1, l2)); float w0 = __expf(l0 - mx), w1 = __expf(l1 - mx), w2 = __expf(l2 - mx); const float inv = 1.0f / (w0 + w1 + w2);
        w0 *= inv; w1 *= inv; w2 *= inv;
        const h16* ap = F.ao + (size_t)t * 768 + hg * 64 + 8 * c;
        const f16x8 a0 = *(const f16x8*)ap, a1 = *(const f16x8*)(ap + 256), a2 = *(const f16x8*)(ap + 512);
        f16x8 o;
#pragma unroll
        for (int e = 0; e < 8; ++e) o[e] = (h16)(w0 * (float)a0[e] + w1 * (float)a1[e] + w2 * (float)a2[e]);
        *(f16x8*)(F.yb + (size_t)t * 256 + hg * 64 + 8 * c) = o;
    }
}

__device__ __forceinline__ void ph_gmlp_simple(Frame& F) {
    float* Vl = (float*)F.lds;
    float* Wl = Vl + 128 * 128;
    float* st = Wl + 128 * 129;
    const int tid = F.tid, lane = F.lane, wave = F.wave;
    for (int ch = F.bid; ch < T / 128; ch += F.G) {
        const int t0 = ch * 128;
#if USE_FAST_ATTN
        attn_merge_chunk(F, t0);
#endif
        for (int i = 0; i < 16; ++i) {
            const int tl = wave * 16 + i; const h16* vp = F.h + (size_t)(t0 + tl) * NIN + C_V;
            const f16x8 a = *(const f16x8*)(vp + 8 * lane), b = *(const f16x8*)(vp + 512 + 8 * lane);
            float s = 0.f;
#pragma unroll
            for (int j = 0; j < 8; ++j) s += (float)a[j] + (float)b[j];
            const float mean = wave_sum(s) * (1.f / 1024.f);
            float q = 0.f;
#pragma unroll
            for (int j = 0; j < 8; ++j) { const float da = (float)a[j] - mean, db = (float)b[j] - mean; q += da * da + db * db; }
            const float rstd = 1.f / sqrtf(wave_sum(q) * (1.f / 1024.f) + LN_EPS);
            if (lane == 0) { st[tl * 2] = mean; st[tl * 2 + 1] = rstd; }
        }
        __syncthreads();
        for (int g = 0; g < 8; ++g) {
            {
                const int sr = tid >> 2, c0 = (tid & 3) * 32; const float mean = st[sr * 2], rstd = st[sr * 2 + 1];
                const h16* vp = F.h + (size_t)(t0 + sr) * NIN + C_V + g * 128 + c0;
#pragma unroll
                for (int j = 0; j < 4; ++j) { const f16x8 a = *(const f16x8*)(vp + 8 * j);
#pragma unroll
                    for (int e = 0; e < 8; ++e) { const int c = c0 + 8 * j + e; Vl[sr * 128 + c] = ((float)a[e] - mean) * rstd * F.gn_g[g * 128 + c] + F.gn_b[g * 128 + c]; } }
            }
            for (int idx = tid; idx < 128 * 128; idx += NTHREADS) { const int tt = idx >> 7, ss = idx & 127; Wl[tt * 129 + ss] = (ss <= tt) ? F.sp_w[(size_t)g * 16384 + idx] : 0.f; }
            __syncthreads();
            {
                const int tt = tid >> 2, c0 = (tid & 3) * 32; float acc[32];
#pragma unroll
                for (int j = 0; j < 32; ++j) acc[j] = 0.f;
                for (int ss = 0; ss < 128; ++ss) { const float w = Wl[tt * 129 + ss];
#pragma unroll
                    for (int j = 0; j < 32; ++j) acc[j] += w * Vl[ss * 128 + c0 + j]; }
                const float sb = F.sp_b[g * 128 + tt];
                const h16* up = F.h + (size_t)(t0 + tt) * NIN + C_U + g * 128 + c0; h16* zp = F.z + (size_t)(t0 + tt) * DM + g * 128 + c0;
#pragma unroll
                for (int j = 0; j < 4; ++j) { const f16x8 uu = *(const f16x8*)(up + 8 * j); f16x8 o;
#pragma unroll
                    for (int e = 0; e < 8; ++e) o[e] = (h16)((float)uu[e] * (acc[8 * j + e] + sb));
                    *(f16x8*)(zp + 8 * j) = o; }
            }
            __syncthreads();
        }
    }
}

constexpr int GM_CB = 8256, GM_IMG = 4 * GM_CB;
__device__ __forceinline__ void gmlp_stage(Frame& F, LAS unsigned char* img, const LAS float* st, int t0, int g) {
#pragma unroll
    for (int i = 0; i < 4; ++i) {
        const int idx = F.tid + i * NTHREADS; const int sr = idx >> 4, cc = idx & 15;
        const f16x8 v = *(const f16x8*)(F.h + (size_t)(t0 + sr) * NIN + C_V + g * 128 + 8 * cc);
        const float mean = st[sr * 2], rstd = st[sr * 2 + 1];
        const f32x4 g0 = *(const f32x4*)(F.gn_g + g * 128 + 8 * cc), g1 = *(const f32x4*)(F.gn_g + g * 128 + 8 * cc + 4);
        const f32x4 b0 = *(const f32x4*)(F.gn_b + g * 128 + 8 * cc), b1 = *(const f32x4*)(F.gn_b + g * 128 + 8 * cc + 4);
        f16x8 o;
#pragma unroll
        for (int e = 0; e < 4; ++e) { o[e] = (h16)(((float)v[e] - mean) * rstd * g0[e] + b0[e]); o[4 + e] = (h16)(((float)v[4 + e] - mean) * rstd * g1[e] + b1[e]); }
        *(LAS f16x8*)(img + (cc >> 2) * GM_CB + sr * 64 + (cc & 3) * 16) = o;
    }
}
__device__ __forceinline__ void ph_gmlp_fast(Frame& F, LAS unsigned char* ldsb) {
    LAS float* st = (LAS float*)ldsb;
    LAS unsigned char* img0 = ldsb + 1024;
    const int tid = F.tid, lane = F.lane, wave = F.wave, hi = lane >> 5, li = lane & 15;
    const int cb = wave & 3, half = wave >> 2;
    const int tbA = half ? 1 : 0, tbB = half ? 2 : 3;
    const int nA = 2 * (tbA + 1), nB = 2 * (tbB + 1);
    const int tr_base = cb * GM_CB + (8 * hi + (li >> 2)) * 64 + (16 * ((lane >> 4) & 1) + 4 * (li & 3)) * 2;
    for (int ch = F.bid; ch < T / 128; ch += F.G) {
        const int t0 = ch * 128;
        attn_merge_chunk(F, t0);
        for (int i0 = 0; i0 < 16; i0 += 8) {
            f16x8 a[8], b[8];
#pragma unroll
            for (int i = 0; i < 8; ++i) { const h16* vp = F.h + (size_t)(t0 + wave * 16 + i0 + i) * NIN + C_V; a[i] = *(const f16x8*)(vp + 8 * lane); b[i] = *(const f16x8*)(vp + 512 + 8 * lane); }
#pragma unroll
            for (int i = 0; i < 8; ++i) {
                const int tl = wave * 16 + i0 + i;
                float s_ = 0.f;
#pragma unroll
                for (int j = 0; j < 8; ++j) s_ += (float)a[i][j] + (float)b[i][j];
                const float mean = wave_sum(s_) * (1.f / 1024.f);
                float qv = 0.f;
#pragma unroll
                for (int j = 0; j < 8; ++j) { const float da = (float)a[i][j] - mean, db = (float)b[i][j] - mean; qv += da * da + db * db; }
                const float rstd = 1.f / sqrtf(wave_sum(qv) * (1.f / 1024.f) + LN_EPS);
                if (lane == 0) { st[tl * 2] = mean; st[tl * 2 + 1] = rstd; }
            }
        }
        __syncthreads();
        gmlp_stage(F, img0, st, t0, 0);
        __syncthreads();
        for (int g = 0; g < 8; ++g) {
            LAS unsigned char* img = img0 + (g & 1) * GM_IMG;
            LAS unsigned char* outb = img0 + 2 * GM_IMG + (g & 1) * 32768;
            if (g < 7) gmlp_stage(F, img0 + ((g + 1) & 1) * GM_IMG, st, t0, g + 1);
            f32x16 DA, DB;
#pragma unroll
            for (int e = 0; e < 16; ++e) { DA[e] = 0.f; DB[e] = 0.f; }
            const h16* wa = F.Wc + (size_t)g * 16384 + (size_t)(32 * tbA + (lane & 31)) * 128 + 8 * hi;
            const h16* wb = F.Wc + (size_t)g * 16384 + (size_t)(32 * tbB + (lane & 31)) * 128 + 8 * hi;
#pragma unroll
            for (int ks = 0; ks < 8; ++ks) {
                if (ks < nB) {
                    const v4i16_t lo = __builtin_amdgcn_ds_read_tr16_b64_v4i16((LAS v4i16_t*)(img + tr_base + ks * 1024));
                    const v4i16_t hi4 = __builtin_amdgcn_ds_read_tr16_b64_v4i16((LAS v4i16_t*)(img + tr_base + ks * 1024 + 256));
                    typedef short s16x8 __attribute__((ext_vector_type(8)));
                    const s16x8 vv = (s16x8){lo[0], lo[1], lo[2], lo[3], hi4[0], hi4[1], hi4[2], hi4[3]};
                    const f16x8 af = __builtin_bit_cast(f16x8, vv);
                    const f16x8 bfB = *(const f16x8*)(wb + 16 * ks);
                    DB = MFMA32(af, bfB, DB);
                    if (ks < nA) { const f16x8 bfA = *(const f16x8*)(wa + 16 * ks); DA = MFMA32(af, bfA, DA); }
                }
            }
#pragma unroll
            for (int w2 = 0; w2 < 2; ++w2) {
                const int tb = w2 ? tbB : tbA; const int tt = 32 * tb + (lane & 31);
                const float sb = F.sp_b[g * 128 + tt];
#pragma unroll
                for (int r4 = 0; r4 < 4; ++r4) { f16x4 o;
#pragma unroll
                    for (int e = 0; e < 4; ++e) o[e] = (h16)((w2 ? DB[4 * r4 + e] : DA[4 * r4 + e]) + sb);
                    *(LAS f16x4*)(outb + tt * 256 + (((4 * cb + r4) ^ (tt & 15)) << 4) + 8 * hi) = o; }
            }
            __syncthreads();
#pragma unroll
            for (int i = 0; i < 4; ++i) {
                const int idx = tid + i * NTHREADS; const int tt = idx >> 4, cc = idx & 15;
                const f16x8 vm = *(const LAS f16x8*)(outb + tt * 256 + ((cc ^ (tt & 15)) << 4));
                const f16x8 uu = *(const f16x8*)(F.h + (size_t)(t0 + tt) * NIN + C_U + g * 128 + 8 * cc);
                f16x8 o;
#pragma unroll
                for (int e = 0; e < 8; ++e) o[e] = (h16)((float)uu[e] * (float)vm[e]);
                *(f16x8*)(F.z + (size_t)(t0 + tt) * DM + g * 128 + 8 * cc) = o;
            }
        }
        __syncthreads();
    }
}

__device__ __forceinline__ void ph_ln1(Frame& F) {
    const int gw = F.bid * NWAVES + F.wave, NGW = F.G * NWAVES, lane = F.lane;
    for (int m = gw; m < T; m += NGW) {
        const f32x4* rp = (const f32x4*)(F.out + (size_t)m * DM) + lane;
        f32x4 v[4]; float s = 0.f;
#pragma unroll
        for (int j = 0; j < 4; ++j) { v[j] = rp[64 * j]; s += (v[j][0] + v[j][1]) + (v[j][2] + v[j][3]); }
        const float mean = wave_sum(s) * (1.f / DM); float q = 0.f;
#pragma unroll
        for (int j = 0; j < 4; ++j) { v[j] = v[j] - mean; q += (v[j][0] * v[j][0] + v[j][1] * v[j][1]) + (v[j][2] * v[j][2] + v[j][3] * v[j][3]); }
        const float rstd = 1.f / sqrtf(wave_sum(q) * (1.f / DM) + LN_EPS);
#pragma unroll
        for (int j = 0; j < 4; ++j) { const int c = 4 * lane + 256 * j; const f32x4 g = *(const f32x4*)(F.ln1_g + c), b = *(const f32x4*)(F.ln1_b + c);
            const f32x4 o = v[j] * rstd * g + b; f16x4 w; w[0] = (h16)o[0]; w[1] = (h16)o[1]; w[2] = (h16)o[2]; w[3] = (h16)o[3];
            *(f16x4*)(F.x1 + (size_t)m * DM + c) = w; }
    }
}

template <int CTRL> __device__ __forceinline__ float dppf(float v) { const int b_ = __builtin_bit_cast(int, v); return __builtin_bit_cast(float, __builtin_amdgcn_update_dpp(b_, b_, CTRL, 0xF, 0xF, false)); }
__device__ __forceinline__ void ph_route1(Frame& F) {
    int* cnt = (int*)F.lds; int* base = cnt + 256; int* ebuf = base + 256; int* pbuf = ebuf + 1024;
    const int tid = F.tid, lane = F.lane, wave = F.wave;
    for (int ch = F.bid; ch < T / 128; ch += F.G) {
        if (tid < 256) cnt[tid] = 0;
        __syncthreads();
        for (int i = 0; i < 16; ++i) {
            const int tl = wave * 16 + i, t = ch * 128 + tl;
            const f32x4 lg = *(const f32x4*)(F.logit + (size_t)t * NEXP + 4 * lane);
            const f32x4 rb = *(const f32x4*)(F.r_b + 4 * lane);
            float sc[4], mv[4];
#pragma unroll
            for (int j = 0; j < 4; ++j) { sc[j] = sigmoidf_(lg[j]); mv[j] = sc[j] + rb[j]; }
            float m1 = fmaxf(mv[0], mv[1]), m2 = fminf(mv[0], mv[1]);
#pragma unroll
            for (int j = 2; j < 4; ++j) { const float v = mv[j]; m2 = fmaxf(m2, fminf(m1, v)); m1 = fmaxf(m1, v); }
            { float o1 = dppf<0xB1>(m1), o2 = dppf<0xB1>(m2); m2 = fmaxf(fminf(m1, o1), fmaxf(m2, o2)); m1 = fmaxf(m1, o1); }
            { float o1 = dppf<0x4E>(m1), o2 = dppf<0x4E>(m2); m2 = fmaxf(fminf(m1, o1), fmaxf(m2, o2)); m1 = fmaxf(m1, o1); }
            { float o1 = dppf<0x141>(m1), o2 = dppf<0x141>(m2); m2 = fmaxf(fminf(m1, o1), fmaxf(m2, o2)); m1 = fmaxf(m1, o1); }
            const float gs = m1 + m2; const int grp = lane >> 3;
            int rank = 0;
#pragma unroll
            for (int g = 0; g < 8; ++g) { const float og = __builtin_bit_cast(float, __builtin_amdgcn_readlane(__builtin_bit_cast(int, gs), g * 8)); rank += (og > gs || (og == gs && g < grp)) ? 1 : 0; }
            const bool gsel = rank < 4;
#pragma unroll
            for (int j = 0; j < 4; ++j) mv[j] = gsel ? mv[j] : -INFINITY;
            int my_e = 0; float my_s = 0.f, ssum = 0.f;
            for (int k = 0; k < TOPK; ++k) {
                float bv = mv[0], bsc = sc[0]; int bi = 0;
#pragma unroll
                for (int j = 1; j < 4; ++j) if (mv[j] > bv) { bv = mv[j]; bi = j; bsc = sc[j]; }
                float r = bv;
                r = fmaxf(r, dppf<0xB1>(r)); r = fmaxf(r, dppf<0x4E>(r)); r = fmaxf(r, dppf<0x141>(r)); r = fmaxf(r, dppf<0x140>(r));
                const float r0 = __builtin_bit_cast(float, __builtin_amdgcn_readlane(__builtin_bit_cast(int, r), 0)), r1 = __builtin_bit_cast(float, __builtin_amdgcn_readlane(__builtin_bit_cast(int, r), 16));
                const float r2 = __builtin_bit_cast(float, __builtin_amdgcn_readlane(__builtin_bit_cast(int, r), 32)), r3 = __builtin_bit_cast(float, __builtin_amdgcn_readlane(__builtin_bit_cast(int, r), 48));
                const float M = fmaxf(fmaxf(r0, r1), fmaxf(r2, r3));
                const int L = __builtin_ctzll(__ballot(bv == M));
                const int be = 4 * L + __builtin_amdgcn_readlane(bi, L);
                const float sv = __builtin_bit_cast(float, __builtin_amdgcn_readlane(__builtin_bit_cast(int, bsc), L));
                if (lane == L) {
#pragma unroll
                    for (int j = 0; j < 4; ++j) if (bi == j) mv[j] = -INFINITY;
                }
                ssum += sv;
                if (lane == k) { my_e = be; my_s = sv; }
            }
            if (lane < TOPK) {
                const int lp = atomicAdd(&cnt[my_e], 1);
                ebuf[tl * 8 + lane] = my_e; pbuf[tl * 8 + lane] = lp;
                F.asg_e[t * 8 + lane] = my_e; F.gate[t * 8 + lane] = my_s / ssum * ROUTED_SCALE;
            }
        }
        __syncthreads();
        if (tid < 256) { const int c = cnt[tid]; base[tid] = c ? (int)__hip_atomic_fetch_add(F.ctl + CW_CNT + tid, (unsigned)c, __ATOMIC_RELAXED, __HIP_MEMORY_SCOPE_AGENT) : 0; }
        __syncthreads();
        for (int idx = tid; idx < 1024; idx += NTHREADS) F.asg_pos[ch * 1024 + idx] = base[ebuf[idx]] + pbuf[idx];
        __syncthreads();
    }
}
__device__ __forceinline__ void ph_route2(Frame& F) {
    int* pstart = (int*)F.lds; int* cn = pstart + 257;
    const int tid = F.tid;
    if (tid < 256) cn[tid] = (int)__hip_atomic_load(F.ctl + CW_CNT + tid, __ATOMIC_RELAXED, __HIP_MEMORY_SCOPE_AGENT);
    __syncthreads();
    if (tid == 0) { int run = T; for (int e = 0; e < 256; ++e) { pstart[e] = run; run += (cn[e] + 255) & ~255; } pstart[256] = run; }
    __syncthreads();
    for (int ch = F.bid; ch < T / 128; ch += F.G) {
        for (int idx = tid; idx < 1024; idx += NTHREADS) { const int a = ch * 1024 + idx; const int e = F.asg_e[a], row = pstart[e] + F.asg_pos[a]; F.row_tok[row] = a >> 3; F.row_dst[row] = a; }
        if (tid < 128) { const int r = ch * 128 + tid; F.row_tok[r] = r; F.row_dst[r] = NASG + r; }
    }
    for (int e = F.bid; e < 256; e += F.G) {
        const int p0 = pstart[e], c = cn[e], p1 = pstart[e + 1];
        for (int row = p0 + c + tid; row < p1; row += NTHREADS) { F.row_tok[row] = 0; F.row_dst[row] = -1; }
        for (int tl = (p0 >> 8) + tid; tl < (p1 >> 8); tl += NTHREADS) F.tile_e[tl] = e;
    }
    if (F.bid == 0) {
        if (tid < 128) F.tile_e[tid] = 256;
        if (tid == 0) F.ctl[CW_NT] = (unsigned)(pstart[256] >> 8);
    }
}

__device__ __forceinline__ void ph_combine(Frame& F, LAS unsigned char* ldsb) {
    const int gw = F.bid * NWAVES + F.wave, NGW = F.G * NWAVES, lane = F.lane;
    for (int tb = gw * 2; tb < T; tb += NGW * 2) {
        f16x8 xr[2][2]; u32x4 yr[2][9]; float gt[2][8];
#pragma unroll
        for (int u = 0; u < 2; ++u) {
            const int t = tb + u;
            const h16* xp = F.x1 + (size_t)t * DM + 16 * lane; const unsigned char* yp = F.y + (size_t)t * 8 * DM + 16 * lane; const unsigned char* sp = F.y + (size_t)(NASG + t) * DM + 16 * lane;
            xr[u][0] = *(const f16x8*)xp; xr[u][1] = *(const f16x8*)(xp + 8);
#pragma unroll
            for (int k = 0; k < 8; ++k) yr[u][k] = __builtin_nontemporal_load((const u32x4*)(yp + (size_t)k * DM));
            yr[u][8] = __builtin_nontemporal_load((const u32x4*)sp);
#pragma unroll
            for (int k = 0; k < 8; ++k) gt[u][k] = F.gate[t * 8 + k] * Y_INV;
        }
#pragma unroll
        for (int u = 0; u < 2; ++u) {
            const int t = tb + u;
            float acc[16];
            __builtin_amdgcn_sched_barrier(0);
#pragma unroll
            for (int d = 0; d < 4; ++d) {
                const f32x2 s0 = __builtin_amdgcn_cvt_pk_f32_fp8((int)yr[u][8][d], false), s1 = __builtin_amdgcn_cvt_pk_f32_fp8((int)yr[u][8][d], true);
                float a0 = s0.x * Y_INV, a1 = s0.y * Y_INV, a2 = s1.x * Y_INV, a3 = s1.y * Y_INV;
#pragma unroll
                for (int k = 0; k < 8; ++k) { const f32x2 p0 = __builtin_amdgcn_cvt_pk_f32_fp8((int)yr[u][k][d], false), p1 = __builtin_amdgcn_cvt_pk_f32_fp8((int)yr[u][k][d], true);
                    a0 += gt[u][k] * p0.x; a1 += gt[u][k] * p0.y; a2 += gt[u][k] * p1.x; a3 += gt[u][k] * p1.y; }
                acc[4 * d] = a0; acc[4 * d + 1] = a1; acc[4 * d + 2] = a2; acc[4 * d + 3] = a3;
            }
#pragma unroll
            for (int e = 0; e < 8; ++e) { acc[e] += ALPHA * (float)xr[u][0][e]; acc[8 + e] += ALPHA * (float)xr[u][1][e]; }
            float s = 0.f;
#pragma unroll
            for (int j = 0; j < 16; ++j) s += acc[j];
            const float mean = wave_sum(s) * (1.f / DM); float q = 0.f;
#pragma unroll
            for (int j = 0; j < 16; ++j) { acc[j] -= mean; q += acc[j] * acc[j]; }
            const float rstd = 1.f / sqrtf(wave_sum(q) * (1.f / DM) + LN_EPS);
            LAS float* stg = (LAS float*)ldsb + F.wave * 1024;
#pragma unroll
            for (int qd = 0; qd < 4; ++qd) { f32x4 o;
#pragma unroll
                for (int e = 0; e < 4; ++e) o[e] = acc[4 * qd + e] * rstd;
                *(LAS f32x4*)(stg + 16 * lane + 4 * qd) = o; }
#pragma unroll
            for (int j = 0; j < 4; ++j) { const int c = 4 * lane + 256 * j; const f32x4 v = *(const LAS f32x4*)(stg + c);
                const f32x4 g = *(const f32x4*)(F.ln2_g + c), b = *(const f32x4*)(F.ln2_b + c);
                *(f32x4*)(F.out + (size_t)t * DM + c) = v * g + b; }
        }
    }
}

#if USE_FAST_ATTN
#define ATTN_PHASE ph_attn_fast(F, (LAS unsigned char*)lds)
#else
#define ATTN_PHASE ph_attn_simple(F)
#endif
#ifndef USE_FAST_GMLP
#define USE_FAST_GMLP 1
#endif
#if USE_FAST_GMLP
#define GMLP_PHASE ph_gmlp_fast(F, (LAS unsigned char*)lds)
#else
#define GMLP_PHASE ph_gmlp_simple(F)
#endif
#ifndef PROBE_MODE
#define PROBE_MODE 0
#endif
#ifndef DUP_MASK
#define DUP_MASK 0
#endif
#ifndef USE_FAST_GEMM
#define USE_FAST_GEMM 1
#endif
#if USE_FAST_GEMM
#define GEMM(P, E) fg::gemm_fast((LAS unsigned char*)lds, P, E)
#else
#define GEMM(P, E) gemm_simple(P, E)
#endif
enum { PH_PRO = 0, PH_INPROJ, PH_ATTN, PH_GMLP, PH_YB, PH_YA, PH_OUTW, PH_LN1, PH_ROUTER, PH_ROUTE1, PH_ROUTE2, PH_MOE1, PH_MOE2, PH_COMBINE, N_PHASES };

__global__ void __launch_bounds__(NTHREADS, 2) mk_fwd(Args args) {
    extern __shared__ __attribute__((aligned(16))) unsigned char lds[];
    Frame F;
    F.lds = lds; F.tid = threadIdx.x; F.lane = F.tid & 63; F.wave = __builtin_amdgcn_readfirstlane(F.tid >> 6); F.G = gridDim.x; F.bid = blockIdx.x;
    unsigned char* ws = args.ws;
    F.ctl = (unsigned*)(ws + WS_CTL);
    F.x = args.in[0]; F.in_w = args.in[1]; F.in_b = args.in[2]; F.gn_g = args.in[3]; F.gn_b = args.in[4]; F.sp_w = args.in[5]; F.sp_b = args.in[6]; F.pa_w = args.in[7];
    F.pb_w = args.in[8]; F.out_w = args.in[9]; F.ln1_g = args.in[10]; F.ln1_b = args.in[11]; F.r_w = args.in[12]; F.r_b = args.in[13]; F.e_wg = args.in[14]; F.e_wu = args.in[15];
    F.e_wd = args.in[16]; F.s_wg = args.in[17]; F.s_wu = args.in[18]; F.s_wd = args.in[19]; F.ln2_g = args.in[20]; F.ln2_b = args.in[21];
    F.out = args.out;
    F.WinT = (h16*)(ws + WS_WIN); F.WaT = (h16*)(ws + WS_WA); F.WoT = (h16*)(ws + WS_WO); F.WbT = (h16*)(ws + WS_WB); F.WrT = (h16*)(ws + WS_WR);
    F.W1t = ws + WS_W1T; F.W2t = ws + WS_W2T; F.x1f8 = ws + WS_X1F8; F.x16 = (h16*)(ws + WS_X16); F.x1 = (h16*)(ws + WS_X1); F.yb = (h16*)(ws + WS_YB); F.z = (h16*)(ws + WS_Z);
    F.merged = (h16*)(ws + WS_MERGED); F.h = (h16*)(ws + WS_H); F.hid = ws + WS_HID; F.y = (unsigned char*)(ws + WS_Y);
    F.logit = (float*)(ws + WS_LOGIT); F.gate = (float*)(ws + WS_GATE); F.lse = (float*)(ws + WS_LSE); F.ao = (h16*)(ws + WS_AO); F.Wc = (h16*)(ws + WS_WC);
    F.asg_e = (int*)(ws + WS_ASGE); F.asg_pos = (int*)(ws + WS_ASGP); F.row_tok = (int*)(ws + WS_ROWTOK); F.row_dst = (int*)(ws + WS_ROWDST); F.tile_e = (int*)(ws + WS_TILEE);

    volatile LAS unsigned* MISC = (volatile LAS unsigned*)((LAS unsigned char*)lds + (LDS_BYTES - 64));
    if (F.tid < 16) MISC[F.tid] = 0u;
    __syncthreads();
    XcdBarrier bar; bar.bar = F.ctl + CW_BAR; bar.x = 0; bar.st = nullptr;
    const int lo = args.ph_lo, hi = args.ph_hi;
    if (hi - lo > 1) bar = xcd_barrier_post(F.ctl + CW_BAR, MISC + 8);
#define IN(k) (lo <= (k) && (k) < hi)
#define REP(k) for (int rep_ = 0; rep_ < ((((DUP_MASK) >> (k)) & 1) ? 2 : 1); ++rep_)
#define SEAM(k) do { if (IN(k) && IN((k) + 1)) xcd_barrier(bar); } while (0)

    if (IN(PH_PRO)) REP(PH_PRO) { ph_prologue(F); } SEAM(PH_PRO);
    if (IN(PH_INPROJ)) REP(PH_INPROJ) { ProbDense P{F.x16, F.WinT, T, NIN, 1024, F.G, F.bid}; EpiInProj E{F.h, F.in_b, rep_ ? PROBE_MODE : 0}; GEMM(P, E); } SEAM(PH_INPROJ);
    if (IN(PH_ATTN)) REP(PH_ATTN) { ATTN_PHASE; } SEAM(PH_ATTN);
    if (IN(PH_GMLP)) REP(PH_GMLP) { GMLP_PHASE; } SEAM(PH_GMLP);
    if (IN(PH_YB)) REP(PH_YB) { ProbDense P{F.yb, F.WbT, T, DM, 256, F.G, F.bid}; EpiYb E{F.merged, F.h}; GEMM(P, E); }
    if (IN(PH_YA)) REP(PH_YA) { ProbDense P{F.z, F.WaT, T, DM, 1024, F.G, F.bid}; EpiYa E{F.merged, F.h}; GEMM(P, E); } SEAM(PH_YA);
    if (IN(PH_OUTW)) {
        PanelStats st{(unsigned long long*)(ws + WS_XBUF), F.ctl + CW_PANEL, LN_EPS}; EpiLn1 E{F.x1, F.x1f8, F.x, F.ln1_g, F.ln1_b, st};
        const int nround = (512 + F.G - 1) / F.G;
        for (int ri = 0; ri < nround; ++ri) { ProbDenseR P; P.A = F.merged; P.Bt = F.WoT; P.M = T; P.N = DM; P.K = 1024; P.G = F.G; P.c = F.bid; P.ri = ri; GEMM(P, E); __syncthreads(); }
    } SEAM(PH_OUTW);
    if (IN(PH_ROUTER)) REP(PH_ROUTER) { ProbDense P{F.x1, F.WrT, T, NEXP, 1024, F.G, F.bid}; EpiLogit E{F.logit}; GEMM(P, E); } SEAM(PH_ROUTER);
    if (IN(PH_ROUTE1)) REP(PH_ROUTE1) { ph_route1(F); } SEAM(PH_ROUTE1);
    if (IN(PH_ROUTE2)) REP(PH_ROUTE2) { ph_route2(F); } SEAM(PH_ROUTE2);
    if (IN(PH_MOE1)) REP(PH_MOE1) { const int NT = __builtin_amdgcn_readfirstlane((int)__hip_atomic_load(F.ctl + CW_NT, __ATOMIC_RELAXED, __HIP_MEMORY_SCOPE_AGENT));
        ProbMoe1 P{(const h16*)F.x1f8, (const h16*)F.W1t, F.row_tok, F.tile_e, NT, 512, F.G, F.bid}; EpiMoe1 E{F.hid}; GEMM(P, E); } SEAM(PH_MOE1);
    if (IN(PH_MOE2)) REP(PH_MOE2) { const int NT = __builtin_amdgcn_readfirstlane((int)__hip_atomic_load(F.ctl + CW_NT, __ATOMIC_RELAXED, __HIP_MEMORY_SCOPE_AGENT));
        ProbMoe2 P{(const h16*)F.hid, (const h16*)F.W2t, F.tile_e, NT, 128, F.G, F.bid}; EpiMoe2 E{F.y, F.row_dst, rep_ ? PROBE_MODE : 0}; GEMM(P, E); } SEAM(PH_MOE2);
    if (IN(PH_COMBINE)) REP(PH_COMBINE) { ph_combine(F, (LAS unsigned char*)lds); }
#undef IN
#undef SEAM
}

extern "C" void kernel_launch(void* const* d_in, const int* in_sizes, int n_in, void* d_out, int out_size, void* d_ws, size_t ws_size, hipStream_t stream) {
    static int grid = 0;
    if (grid == 0) {
        if (n_in != 22 || in_sizes[0] != T * DM || out_size != T * DM || ws_size < WS_END) {
            fprintf(stderr, "kernel_launch: unexpected problem: n_in %d in0 %d out %d ws %zu (need %zu); nothing launched\n", n_in, n_in > 0 ? in_sizes[0] : -1, out_size, ws_size, (size_t)WS_END);
            grid = -1; return; }
        int dev = 0, cus = 0;
        if (hipGetDevice(&dev) != hipSuccess || hipDeviceGetAttribute(&cus, hipDeviceAttributeMultiprocessorCount, dev) != hipSuccess) { grid = -1; return; }
        if (hipFuncSetAttribute((const void*)mk_fwd, hipFuncAttributeMaxDynamicSharedMemorySize, LDS_BYTES) != hipSuccess) { fprintf(stderr, "kernel_launch: hipFuncSetAttribute failed\n"); grid = -1; return; }
        int per_cu = 0;
        if (hipOccupancyMaxActiveBlocksPerMultiprocessor(&per_cu, (const void*)mk_fwd, NTHREADS, LDS_BYTES) != hipSuccess || per_cu < 1) fprintf(stderr, "kernel_launch: occupancy query reports %d\n", per_cu);
        (void)hipGetLastError();
        grid = cus;
    }
    if (grid < 0) return;
    (void)hipMemsetAsync((char*)d_ws + WS_CTL, 0, CTL_ZERO_BYTES, stream);
    Args a{};
    for (int i = 0; i < 22; ++i) a.in[i] = (const float*)d_in[i];
    a.out = (float*)d_out; a.ws = (unsigned char*)d_ws;
    constexpr int NL = MK_N_LAUNCHES;
    for (int li = 0; li < NL; ++li) {
        a.ph_lo = (NL == 1) ? 0 : li; a.ph_hi = (NL == 1) ? (int)N_PHASES : li + 1;
        hipLaunchKernelGGL(mk_fwd, dim3(grid), dim3(NTHREADS), LDS_BYTES, stream, a);
    }
}
```

```cpp
#include <hip/hip_runtime.h>
#include <cstdio>
#include <cstdint>
#include <cmath>

#ifndef USE_FAST_ATTN
#define USE_FAST_ATTN 1
#endif
#ifndef CONV_IN_ATTN
#define CONV_IN_ATTN 1
#endif
#ifndef CONV_EARLY_DEQ
#define CONV_EARLY_DEQ 2
#endif
#ifndef ATTN_WAVES
#define ATTN_WAVES 7
#endif
#ifndef MK_N_LAUNCHES
#define MK_N_LAUNCHES 1
#endif

#ifndef USE_BF16
#define USE_BF16 1
#endif
#if USE_BF16
typedef __bf16 h16;
typedef __bf16 f16x8 __attribute__((ext_vector_type(8)));
typedef __bf16 f16x4 __attribute__((ext_vector_type(4)));
typedef __bf16 f16x2 __attribute__((ext_vector_type(2)));
#define MFMA16(a, b, c) __builtin_amdgcn_mfma_f32_16x16x32_bf16(a, b, c, 0, 0, 0)
#define MFMA32(a, b, c) __builtin_amdgcn_mfma_f32_32x32x16_bf16(a, b, c, 0, 0, 0)
#else
typedef _Float16 h16;
typedef _Float16 f16x8 __attribute__((ext_vector_type(8)));
typedef _Float16 f16x4 __attribute__((ext_vector_type(4)));
typedef _Float16 f16x2 __attribute__((ext_vector_type(2)));
#define MFMA16(a, b, c) MFMA16(a, b, c)
#define MFMA32(a, b, c) MFMA32(a, b, c)
#endif
typedef float f32x4 __attribute__((ext_vector_type(4)));
typedef float f32x2 __attribute__((ext_vector_type(2)));
typedef unsigned u32x4 __attribute__((ext_vector_type(4)));
typedef unsigned u32x2 __attribute__((ext_vector_type(2)));
typedef int i32x4 __attribute__((ext_vector_type(4)));
typedef int i32x8 __attribute__((ext_vector_type(8)));
typedef long i64x2 __attribute__((ext_vector_type(2)));
#define MFMA16_F8(a0, a1, b0, b1, c, sa, sb) __builtin_amdgcn_mfma_scale_f32_16x16x128_f8f6f4( \
    __builtin_shufflevector(__builtin_bit_cast(i32x4, a0), __builtin_bit_cast(i32x4, a1), 0, 1, 2, 3, 4, 5, 6, 7), \
    __builtin_shufflevector(__builtin_bit_cast(i32x4, b0), __builtin_bit_cast(i32x4, b1), 0, 1, 2, 3, 4, 5, 6, 7), c, 0, 0, 0, sa, 0, sb)
#define LAS __attribute__((address_space(3)))

constexpr int T = 32768, DM = 1024, NIN = 6400, SEQ = 4096;
constexpr int NEXP = 256, TOPK = 8, EDIM = 256, NASG = T * TOPK;
constexpr int MAXTILES = 1408, MAXROWS = MAXTILES * 256;
constexpr int C_U = 0, C_V = 1024, C_Q = 2048, C_K = 2816, C_VV = 3584, C_GA = 4352, C_GB = 5376;
constexpr float ALPHA = 1.189207115002721f;
constexpr float LN_EPS = 1e-5f;
constexpr float ROUTED_SCALE = 2.5f;
constexpr int NWAVES = 8, NTHREADS = 512;
constexpr float SC_X1 = 16.0f, SC_W = 512.0f, SC_HID = 8.0f, F8_MAX = 448.0f;
constexpr int LDS_TILE_E = 131072 + 16384 + 2048;
constexpr int LDS_BYTES = 147456 + 3072 + 6144;

constexpr size_t MiB = 1u << 20;
constexpr size_t WS_CTL = 0, CTL_ZERO_BYTES = 1 * MiB;
constexpr size_t WS_WIN = 1 * MiB;
constexpr size_t WS_WA = 14 * MiB;
constexpr size_t WS_WO = 16 * MiB;
constexpr size_t WS_WB = 18 * MiB;
constexpr size_t WS_WR = 19 * MiB;
constexpr size_t WS_WC = 19 * MiB + 512 * 1024;
constexpr size_t WS_ASGE = 20 * MiB;
constexpr size_t WS_ASGP = 21 * MiB;
constexpr size_t WS_GATE = 22 * MiB;
constexpr size_t WS_ROWTOK = 23 * MiB;
constexpr size_t WS_ROWDST = 24 * MiB + 512 * 1024;
constexpr size_t WS_TILEE = 26 * MiB;
constexpr size_t WS_W2T = 27 * MiB;
constexpr size_t WS_X1F8 = 92 * MiB;
constexpr size_t WS_X16 = 156 * MiB;
constexpr size_t WS_X1 = WS_X16;
constexpr size_t WS_YB = 220 * MiB;
constexpr size_t WS_Z = 236 * MiB;
constexpr size_t WS_LOGIT = 236 * MiB;
constexpr size_t WS_MERGED = 300 * MiB;
constexpr size_t WS_W1T = 364 * MiB;
constexpr size_t WS_H = 621 * MiB;
constexpr size_t WS_HID = 848 * MiB;
constexpr size_t WS_Y = 220 * MiB;
constexpr size_t WS_AO = 300 * MiB;
constexpr size_t WS_LSE = 1021 * MiB;
constexpr size_t WS_XBUF = 621 * MiB;
constexpr size_t WS_END = 1024 * MiB;
static_assert(WS_H + (size_t)T * NIN * 2 <= WS_END && WS_HID + (size_t)MAXROWS * 256 * 2 <= WS_END && WS_Y + (size_t)(NASG + T) * 1024 * 2 <= WS_HID, "ws map");
static_assert(WS_W1T + (size_t)257 * 512 * 1024 <= WS_H && WS_W2T + (size_t)257 * 1024 * 256 <= WS_X1F8 && WS_X1F8 + (size_t)T * 1024 <= WS_X16, "ws map 2");
constexpr int CW_NT = 8;
constexpr int CW_CNT = 64;
constexpr int CW_BAR = 4096;
constexpr int CW_CONVQ = 1024;
constexpr int CW_PANEL = 16384;

__device__ __forceinline__ f16x8 pack8(f32x4 a, f32x4 b) {
    f16x8 r;
    r[0] = (h16)a[0]; r[1] = (h16)a[1]; r[2] = (h16)a[2]; r[3] = (h16)a[3];
    r[4] = (h16)b[0]; r[5] = (h16)b[1]; r[6] = (h16)b[2]; r[7] = (h16)b[3];
    return r;
}
__device__ __forceinline__ float sigmoidf_(float x) { return __builtin_amdgcn_rcpf(1.0f + __builtin_amdgcn_exp2f(x * -1.4426950408889634f)); }
__device__ __forceinline__ float gelu_erf(float x) { return 0.5f * x * (1.0f + erff(x * 0.7071067811865476f)); }
__device__ __forceinline__ f32x2 gelu_pk(f32x2 v) {
    const f32x2 av = __builtin_elementwise_abs(v), d = av * 0.2316418882f + 1.0f;
    f32x2 t; t.x = __builtin_amdgcn_rcpf(d.x); t.y = __builtin_amdgcn_rcpf(d.y);
    f32x2 q = t * 0.5307027145f + (-0.7265760135f); q = q * t + 0.7107068705f; q = q * t + (-0.142248368f); q = q * t + 0.127414796f; q = q * t;
    const f32x2 s = (v * v) * (-0.72134752044f);
    f32x2 e; e.x = __builtin_amdgcn_exp2f(s.x); e.y = __builtin_amdgcn_exp2f(s.y);
    const f32x2 qe = q * e; f32x2 rl; rl.x = fmaxf(v.x, 0.f); rl.y = fmaxf(v.y, 0.f);
    return rl - av * qe;
}
__device__ __forceinline__ float wave_sum(float v) {
#pragma unroll
    for (int o = 1; o < 64; o <<= 1) v += __shfl_xor(v, o);
    return v;
}
__device__ __forceinline__ float wave_max(float v) {
#pragma unroll
    for (int o = 1; o < 64; o <<= 1) v = fmaxf(v, __shfl_xor(v, o));
    return v;
}

#define XB_TMO      128
#define XB_XCNT(j)  (256  + 64 * (j))
#define XB_XSUB(j)  (1280 + 64 * (j))
#define XB_XGEN(j)  (2304 + 64 * (j))
#define XB_TOP      3328
#define XB_TOPGEN   3392
#define XCD_BAR_WORDS 3456
#define XB_SPIN_CAP (1u << 22)
__device__ __forceinline__ unsigned xb_ld(unsigned* p)              { return __hip_atomic_load(p, __ATOMIC_RELAXED, __HIP_MEMORY_SCOPE_AGENT); }
__device__ __forceinline__ unsigned xb_add(unsigned* p, unsigned v) { return __hip_atomic_fetch_add(p, v, __ATOMIC_RELAXED, __HIP_MEMORY_SCOPE_AGENT); }
__device__ __forceinline__ unsigned xb_xcc_id() { return (unsigned)__builtin_amdgcn_s_getreg((3 << 11) | 20) & 0xFu; }
#define XB_SPIN(cond, bar) do { unsigned _sp = 0; while (cond) { __builtin_amdgcn_s_sleep(1); \
    if ((++_sp & 255u) == 0u) { if (xb_ld(&(bar)[XB_TMO])) break; if (_sp > XB_SPIN_CAP) { atomicAdd(&(bar)[XB_TMO], 1u); break; } } } } while (0)
struct XcdBarrier { unsigned* bar; unsigned x; volatile LAS unsigned* st; };
__device__ __forceinline__ XcdBarrier xcd_barrier_post(unsigned* bar, volatile LAS unsigned* st) {
    XcdBarrier b; b.bar = bar; b.x = xb_xcc_id(); b.st = st;
    if (threadIdx.x == 0) (void)xb_add(&bar[XB_XCNT(b.x)], 1u);
    return b;
}
__device__ __forceinline__ void xcd_barrier_complete(unsigned* bar, unsigned x, unsigned& nloc, unsigned& nx) {
    const unsigned G = gridDim.x * gridDim.y * gridDim.z;
    unsigned sum, cnt, mine, sp = 0u;
    for (;;) {
        sum = 0u; cnt = 0u; mine = 0u;
#pragma unroll
        for (unsigned j = 0; j < 16; ++j) { const unsigned c = xb_ld(&bar[XB_XCNT(j)]); sum += c; cnt += (c > 0u) ? 1u : 0u; mine = (j == x) ? c : mine; }
        if (sum == G) break;
        __builtin_amdgcn_s_sleep(1);
        if ((++sp & 255u) == 0u) { if (xb_ld(&bar[XB_TMO])) break; if (sp > XB_SPIN_CAP) { atomicAdd(&bar[XB_TMO], 1u); break; } }
    }
    nloc = mine > 0u ? mine : 1u; nx = cnt > 0u ? cnt : 1u;
}
__device__ __forceinline__ void xcd_barrier(const XcdBarrier& b) {
    asm volatile("s_waitcnt vmcnt(0)" ::: "memory");
    __syncthreads();
    if (threadIdx.x == 0) {
        unsigned* bar = b.bar;
        __builtin_amdgcn_s_waitcnt(0);
        unsigned nloc = b.st[0], nx = b.st[1];
        if (nloc == 0u) { xcd_barrier_complete(bar, b.x, nloc, nx); b.st[0] = nloc; b.st[1] = nx; }
        const unsigned old = xb_add(&bar[XB_XSUB(b.x)], 1u);
        const unsigned gen = old / nloc;
        if (old + 1u == (gen + 1u) * nloc) {
            __builtin_amdgcn_fence(__ATOMIC_RELEASE, "agent");
            asm volatile("s_waitcnt vmcnt(0)" ::: "memory");
            const unsigned og = xb_add(&bar[XB_TOP], 1u);
            const unsigned tg = og / nx;
            if (og + 1u == (tg + 1u) * nx) xb_add(&bar[XB_TOPGEN], 1u);
            else XB_SPIN(xb_ld(&bar[XB_TOPGEN]) == tg, bar);
            __builtin_amdgcn_fence(__ATOMIC_ACQUIRE, "agent");
            xb_add(&bar[XB_XGEN(b.x)], 1u);
            asm volatile("s_waitcnt vmcnt(0)" ::: "memory");
        } else {
            XB_SPIN(xb_ld(&bar[XB_XGEN(b.x)]) == gen, bar);
            __builtin_amdgcn_fence(__ATOMIC_ACQUIRE, "agent");
            asm volatile("s_waitcnt vmcnt(0)" ::: "memory");
        }
    }
    __syncthreads();
}

struct Args { const float* in[22]; float* out; unsigned char* ws; int ph_lo, ph_hi; };
struct Frame {
    unsigned char* lds;
    unsigned* ctl;
    int tid, lane, wave, G, bid;
    const float *x, *in_w, *in_b, *gn_g, *gn_b, *sp_w, *sp_b, *pa_w, *pb_w, *out_w, *ln1_g, *ln1_b, *r_w, *r_b, *e_wg, *e_wu, *e_wd, *s_wg, *s_wu, *s_wd, *ln2_g, *ln2_b;
    float* out;
    h16 *WinT, *WaT, *WoT, *WbT, *WrT, *x16, *x1, *yb, *z, *merged, *h;
    unsigned char *W1t, *W2t, *x1f8, *hid;
    unsigned char* y;
    float *logit, *gate, *lse;
    h16* ao; h16* Wc;
    int *asg_e, *asg_pos, *row_tok, *row_dst, *tile_e;
};

#ifndef PROBE_DUP2
#define PROBE_DUP2 0
#endif
struct Unit { int pm, pn; int rep; };
template <class Prob, class Epi>
__device__ __forceinline__ void gemm_simple(const Prob& P, const Epi& E) {
    const int tid = threadIdx.x, wid = tid >> 6, lane = tid & 63, wr = wid >> 2, wc = wid & 3, fr = lane & 15, fq = lane >> 4;
    const int K = P.K;
    Unit u;
    for (int i = 0; P.next(i, u); ++i) {
        f32x4 acc[2][2][4][2];
#pragma unroll
        for (int a = 0; a < 2; ++a)
#pragma unroll
            for (int b = 0; b < 2; ++b)
#pragma unroll
                for (int m = 0; m < 4; ++m)
#pragma unroll
                    for (int n = 0; n < 2; ++n) acc[a][b][m][n] = (f32x4){0.f, 0.f, 0.f, 0.f};
        int ao[2][4];
#pragma unroll
        for (int ai = 0; ai < 2; ++ai)
#pragma unroll
            for (int m = 0; m < 4; ++m) ao[ai][m] = P.aoff(u, 128 * ai + 64 * wr + 16 * m + fr) + 8 * fq;
        const h16* ab = P.abase();
        const h16* bt = P.bt(u) + (size_t)(Epi::ADJ ? (64 * wc + 16 * (fr >> 2) + (fr & 3)) : (32 * wc + 8 * (fr >> 2) + (fr & 3))) * K + 8 * fq;
        for (int k0 = 0; k0 < K; k0 += 32) {
            f16x8 af[2][4], wf[2][2];
#pragma unroll
            for (int ai = 0; ai < 2; ++ai)
#pragma unroll
                for (int m = 0; m < 4; ++m) af[ai][m] = *(const f16x8*)(ab + ao[ai][m] + k0);
#pragma unroll
            for (int bj = 0; bj < 2; ++bj)
#pragma unroll
                for (int n = 0; n < 2; ++n) wf[bj][n] = *(const f16x8*)(bt + (size_t)((Epi::ADJ ? 8 : 128) * bj + 4 * n) * K + k0);
#pragma unroll
            for (int ai = 0; ai < 2; ++ai)
#pragma unroll
                for (int bj = 0; bj < 2; ++bj)
#pragma unroll
                    for (int m = 0; m < 4; ++m)
#pragma unroll
                        for (int n = 0; n < 2; ++n)
                            acc[ai][bj][m][n] = MFMA16(wf[bj][n], af[ai][m], acc[ai][bj][m][n]);
        }
        if constexpr (!Epi::AFTER_DRAIN) E(acc, u, wr, wc, fr, fq);
    }
}

namespace fg {
constexpr int BK = 64, HALF = 128, HTB = HALF * BK * 2, STAGE_BYTES = 8 * HTB;
__device__ __forceinline__ int lds_byte(int r, int c) { const int st = (r >> 4) * 2 + (c >> 5), rr = r & 15, cc = c & 31, ob = rr * 64 + cc * 2; return st * 1024 + (ob ^ (((ob >> 9) & 1) << 5)); }
__device__ __forceinline__ void stage_rc(int b, int& R, int& C) { const int st = b / 1024, sb = b % 1024, swz = sb ^ (((sb >> 9) & 1) << 5); R = (st >> 1) * 16 + swz / 64; C = (st & 1) * 32 + (swz % 64) / 2; }
__device__ __forceinline__ int perm32(int rho) { const int n = rho >> 4, i = rho & 15; return 8 * (i >> 2) + 4 * n + (i & 3); }

template <class Prob, class Epi>
__device__ __forceinline__ void gemm_fast(LAS unsigned char* lds, const Prob& P, const Epi& E) {
    const int tid = threadIdx.x, wid = __builtin_amdgcn_readfirstlane(tid >> 6), lane = tid & 63, wr = wid >> 2, wc = wid & 3, fr = lane & 15, fq = lane >> 4;
    const int K = P.K, nt = K / BK;
    unsigned voffB[2];
#pragma unroll
    for (int i = 0; i < 2; ++i) { int R, C; stage_rc(tid * 16 + i * 8192, R, C);
        if constexpr (Prob::F8) { const int b_ = tid * 16 + i * 8192; R = (b_ >> 11) * 16 + ((b_ >> 4) & 15); C = ((b_ >> 8) & 7) * 8; }
        const int Rb = Epi::ADJ ? (64 * (R >> 5) + 16 * ((R & 15) >> 2) + 4 * ((R >> 4) & 1) + (R & 3)) : ((R & ~31) + perm32(R & 31));
        if constexpr (Prob::F8) voffB[i] = (unsigned)(((C >> 3) * Prob::NB + Rb) * 16); else voffB[i] = (unsigned)(Rb * K + C) * 2u; }
    const size_t kstep = (size_t)(BK * 2);
    const size_t kstepB = Prob::F8 ? (size_t)8 * Prob::NB * 16 : kstep;
    const size_t hstep = Prob::F8 ? (size_t)(Epi::ADJ ? 8 : HALF) * 16 : (size_t)(Epi::ADJ ? 8 : HALF) * K * 2;
    const unsigned ldsw = (unsigned)wid * 1024u;
    const int aoff = lds_byte(wr * 64 + fr, fq * 8), boff = Prob::F8 ? (wc * 4096 + fq * 256 + fr * 16) : lds_byte(wc * 32 + fr, fq * 8);
#define FG_SA(b, h) (((b) * 2 + (h)) * HTB)
#define FG_SB(b, h) ((4 + (b) * 2 + (h)) * HTB)
#define FG_STAGEB(bufoff, gbase) do { _Pragma("unroll") for (int _i = 0; _i < 2; ++_i) { unsigned _vb = voffB[_i]; if constexpr (Prob::F8) asm volatile("" : "+v"(_vb));   \
        __builtin_amdgcn_global_load_lds((const unsigned*)((const char*)(gbase) + _vb), (LAS unsigned*)(lds + (bufoff) + ldsw + _i * 8192), 16, 0, 0); } } while (0)
#define FG_STAGEA(bufoff, gbase, vo, h) do { _Pragma("unroll") for (int _i = 0; _i < 2; ++_i) \
        __builtin_amdgcn_global_load_lds((const unsigned*)((const char*)(gbase) + (vo)[h][_i]), (LAS unsigned*)(lds + (bufoff) + ldsw + _i * 8192), 16, 0, 0); } while (0)
#define FG_LDA(dst, b, h) do { _Pragma("unroll") for (int m = 0; m < 4; ++m) _Pragma("unroll") for (int k = 0; k < 2; ++k) dst[m][k] = *(const LAS f16x8*)(lds + FG_SA(b, h) + aoff + m * 2048 + k * 1024); } while (0)
#define FG_LDB(dst, b, h) do { _Pragma("unroll") for (int n = 0; n < 2; ++n) _Pragma("unroll") for (int k = 0; k < 2; ++k) dst[n][k] = *(const LAS f16x8*)(lds + FG_SB(b, h) + boff + n * 2048 + k * 1024); } while (0)
#define FG_MMA(ai, bj, At, Bt) do { __builtin_amdgcn_s_setprio(1); _Pragma("unroll") for (int m = 0; m < 4; ++m) _Pragma("unroll") for (int n = 0; n < 2; ++n) _Pragma("unroll") for (int k = 0; k < 2; ++k) \
        acc[ai][bj][m][n] = MFMA16(Bt[n][k], At[m][k], acc[ai][bj][m][n]); __builtin_amdgcn_s_setprio(0); } while (0)
#define FG_MMA8(ai, bj, At, Bt) do { __builtin_amdgcn_s_setprio(1); _Pragma("unroll") for (int m = 0; m < 4; ++m) _Pragma("unroll") for (int n = 0; n < 2; ++n) \
        acc[ai][bj][m][n] = MFMA16_F8(Bt[n][0], Bt[n][1], At[m][0], At[m][1], acc[ai][bj][m][n], (bj) ? Prob::SCALE_B1 : Prob::SCALE_B0, (bj) ? Prob::SCALE_A1 : Prob::SCALE_A0); \
          \
        asm volatile("" : "+v"(acc[ai][bj][0][0]), "+v"(acc[ai][bj][0][1]), "+v"(acc[ai][bj][1][0]), "+v"(acc[ai][bj][1][1]), "+v"(acc[ai][bj][2][0]), "+v"(acc[ai][bj][2][1]), "+v"(acc[ai][bj][3][0]), "+v"(acc[ai][bj][3][1])); \
        __builtin_amdgcn_s_setprio(0); } while (0)
#define FG_MM(ai, bj, At, Bt) do { if constexpr (Prob::F8) FG_MMA8(ai, bj, At, Bt); else FG_MMA(ai, bj, At, Bt); } while (0)
#define FG_WAIT_V(n) asm volatile("s_waitcnt vmcnt(" #n ")" ::: "memory")
#define FG_WAIT_L(n) asm volatile("s_waitcnt lgkmcnt(" #n ")" ::: "memory")
#define FG_BAR __builtin_amdgcn_s_barrier()
#define FG_SCHED __builtin_amdgcn_sched_barrier(0)
#define FG_OFFW(par, u) do { int _t = tid; asm volatile("" : "+v"(_t)); if constexpr (Prob::GATHER) { int _R, _C; stage_rc(_t * 16, _R, _C);   \
        _Pragma("unroll") for (int _h = 0; _h < 2; ++_h) _Pragma("unroll") for (int _i = 0; _i < 2; ++_i) \
            __builtin_amdgcn_global_load_lds((const unsigned*)P.arow(u, 128 * _h + 64 * _i + _R), (LAS unsigned*)(lds + STAGE_BYTES + (par) * 8192 + _h * 4096 + _i * 2048 + wid * 256), 4, 0, 0); } else { \
        _Pragma("unroll") for (int _h = 0; _h < 2; ++_h) { u32x2 _o; _Pragma("unroll") for (int _i = 0; _i < 2; ++_i) { int _R, _C; stage_rc(_t * 16 + _i * 8192, _R, _C); \
        _o[_i] = (unsigned)(P.aoff(u, 128 * _h + _R) + _C) * 2u; } *(LAS u32x2*)(lds + STAGE_BYTES + _t * 8 + (par) * 8192 + _h * 4096) = _o; } } } while (0)
#define FG_STA(bufoff, gbase, vo, par, h) do { if constexpr (Prob::F8) { unsigned _o[2]; \
        if constexpr (Prob::GATHER) { _Pragma("unroll") for (int _i = 0; _i < 2; ++_i) _o[_i] = (unsigned)(*(const LAS int*)(offs4 + (par) * 8192 + (h) * 4096 + _i * 2048)) * (unsigned)Prob::AROW_BYTES + colb; } \
        else { const u32x2 _q = *(const LAS u32x2*)(offs + (par) * 8192 + (h) * 4096); _o[0] = _q[0]; _o[1] = _q[1]; } \
        _Pragma("unroll") for (int _i = 0; _i < 2; ++_i) \
        __builtin_amdgcn_global_load_lds((const unsigned*)((const char*)(gbase) + _o[_i]), (LAS unsigned*)(lds + (bufoff) + ldsw + _i * 8192), 16, 0, 0); } else FG_STAGEA(bufoff, gbase, vo, h); } while (0)
#define FG_VOFF(dst, u) do { _Pragma("unroll") for (int _i = 0; _i < 2; ++_i) { int _R, _C; stage_rc(tid * 16 + _i * 8192, _R, _C); _Pragma("unroll") for (int _h = 0; _h < 2; ++_h) dst[_h][_i] = (unsigned)(P.aoff(u, 128 * _h + _R) + _C) * 2u; } } while (0)
    Unit cur, nxt; int ui = 0;
    if (!P.next(0, cur)) return;
    f32x4 acc[2][2][4][2];
#pragma unroll
    for (int a = 0; a < 2; ++a)
#pragma unroll
        for (int b = 0; b < 2; ++b)
#pragma unroll
            for (int m = 0; m < 4; ++m)
#pragma unroll
                for (int n = 0; n < 2; ++n) acc[a][b][m][n] = (f32x4){0.f, 0.f, 0.f, 0.f};
    f16x8 At[4][2], B0[2][2], B1[2][2];
    unsigned vc[2][2], vn[2][2], vs[2][2];
    LAS unsigned char* offs = lds + STAGE_BYTES + tid * 8;
    LAS unsigned char* offs4 = lds + STAGE_BYTES + tid * 4; unsigned colb = 0;
    if constexpr (Prob::GATHER) { int _R, _C; stage_rc(tid * 16, _R, _C); colb = (unsigned)_C * 2u; }
    if constexpr (Prob::F8) FG_OFFW(0, cur); else FG_VOFF(vc, cur);
    if constexpr (Prob::GATHER) asm volatile("s_waitcnt vmcnt(0)" ::: "memory");
    const char* Ab = (const char*)P.abase();
    const char* cB = (const char*)P.bt(cur);
    FG_STAGEB(FG_SB(0, 0), cB); FG_STAGEB(FG_SB(0, 1), cB + hstep); FG_STA(FG_SA(0, 0), Ab, vc, 0, 0); FG_STA(FG_SA(0, 1), Ab, vc, 0, 1);
    if (wr == 1) FG_BAR;
    FG_WAIT_V(2); FG_BAR;
    FG_STAGEB(FG_SB(1, 0), cB + kstepB); FG_STA(FG_SA(1, 0), Ab + kstep, vc, 0, 0); FG_STAGEB(FG_SB(1, 1), cB + hstep + kstepB);
    FG_WAIT_V(6); FG_BAR;
    bool has_nx = P.next(1, nxt);
    const char* nB = has_nx ? (const char*)P.bt(nxt) : cB;
    for (;;) {
        const bool has_next = has_nx;
        Unit nn = nxt; const bool has_nn = has_next && P.next(ui + 2, nn);
        const char* nnB = has_nn ? (const char*)P.bt(nn) : nB;
        const int pc = ui & 1;
        if constexpr (Epi::PRELOAD) E.preload(cur, lds + STAGE_BYTES + 16384 + pc * 1024, wid, lane);
        if (has_next) { if constexpr (Prob::F8) FG_OFFW(pc ^ 1, nxt); else FG_VOFF(vn, nxt); }
        else {
#pragma unroll
            for (int _h = 0; _h < 2; ++_h)
#pragma unroll
                for (int _i = 0; _i < 2; ++_i) vn[_h][_i] = vc[_h][_i];
        }
#pragma nounroll
        for (int t = 0; t < nt; t += 2) {
            const bool last = (t == nt - 2); const int ps = (last && has_next) ? (pc ^ 1) : pc;
            const char* a1 = Ab + (size_t)(t + 1) * kstep;
            const char* a2 = last ? Ab : Ab + (size_t)(t + 2) * kstep; const char* b2 = last ? nB : cB + (size_t)(t + 2) * kstepB;
            const char* a3 = a2 + kstep; const char* b3 = b2 + kstepB;
#pragma unroll
            for (int _h = 0; _h < 2; ++_h)
#pragma unroll
                for (int _i = 0; _i < 2; ++_i) vs[_h][_i] = last ? vn[_h][_i] : vc[_h][_i];
            FG_LDB(B0, 0, 0); FG_LDB(B1, 0, 1); FG_SCHED; FG_LDA(At, 0, 0); FG_STA(FG_SA(1, 1), a1, vc, pc, 1);
            FG_WAIT_V(8); FG_WAIT_L(0); FG_BAR; FG_MM(0, 0, At, B0); FG_MM(0, 1, At, B1); FG_BAR; FG_SCHED;
            FG_LDA(At, 0, 1); FG_STAGEB(FG_SB(0, 0), b2); FG_STAGEB(FG_SB(0, 1), b2 + hstep); FG_STA(FG_SA(0, 0), a2, vs, ps, 0);
            FG_WAIT_V(8); FG_WAIT_L(0); FG_BAR; FG_MM(1, 0, At, B0); FG_MM(1, 1, At, B1); FG_BAR; FG_SCHED;
            FG_LDB(B0, 1, 0); FG_LDB(B1, 1, 1); FG_SCHED; FG_LDA(At, 1, 0); FG_STA(FG_SA(0, 1), a2, vs, ps, 1);
            FG_WAIT_V(8); FG_WAIT_L(0); FG_BAR; FG_MM(0, 0, At, B0); FG_MM(0, 1, At, B1); FG_BAR; FG_SCHED;
            FG_LDA(At, 1, 1); FG_STAGEB(FG_SB(1, 0), b3); FG_STAGEB(FG_SB(1, 1), b3 + hstep); FG_STA(FG_SA(1, 0), a3, vs, ps, 0);
            FG_WAIT_V(8); FG_WAIT_L(0); FG_BAR; FG_MM(1, 0, At, B0); FG_MM(1, 1, At, B1); FG_BAR; FG_SCHED;
        }
        if (wr == 0) FG_BAR;
        if constexpr (Epi::PRELOAD) E.run(acc, cur, wr, wc, fr, fq, lds + STAGE_BYTES + 16384 + pc * 1024);
        else if constexpr (!Epi::AFTER_DRAIN) E(acc, cur, wr, wc, fr, fq);
        if (!has_next) break;
#pragma unroll
        for (int a = 0; a < 2; ++a)
#pragma unroll
            for (int b = 0; b < 2; ++b)
#pragma unroll
                for (int m = 0; m < 4; ++m)
#pragma unroll
                    for (int n = 0; n < 2; ++n) acc[a][b][m][n] = (f32x4){0.f, 0.f, 0.f, 0.f};
        cur = nxt; nxt = nn; cB = nB; nB = nnB; has_nx = has_nn; ++ui;
#pragma unroll
        for (int _h = 0; _h < 2; ++_h)
#pragma unroll
            for (int _i = 0; _i < 2; ++_i) vc[_h][_i] = vn[_h][_i];
        if (wr == 1) FG_BAR;
    }
    FG_WAIT_V(0);
    FG_BAR;
    if constexpr (Epi::AFTER_DRAIN) E.fused(acc, cur, wr, wc, fr, fq, lds, wid, lane);
#undef FG_SA
#undef FG_SB
#undef FG_STAGEA
#undef FG_STAGEB
#undef FG_LDA
#undef FG_LDB
#undef FG_MMA
#undef FG_MMA8
#undef FG_MM
#undef FG_WAIT_V
#undef FG_WAIT_L
#undef FG_BAR
#undef FG_SCHED
#undef FG_VOFF
#undef FG_OFFW
#undef FG_STA
}
}

__device__ __forceinline__ int xcd_remap(long L, int nwg) {
    const int q = nwg >> 3, r = nwg & 7, xcd = (int)(L & 7), off = (int)(L >> 3);
    return (xcd < r ? xcd * (q + 1) : r * (q + 1) + (xcd - r) * q) + off;
}
struct ProbDense {
    static constexpr bool F8 = false; static constexpr bool GATHER = false; static constexpr int NB = 0; static constexpr int SCALE_B0 = 0x7F7F7F7F, SCALE_B1 = 0x7F7F7F7F, SCALE_A0 = 0x7F7F7F7F, SCALE_A1 = 0x7F7F7F7F;
    const h16* A; const h16* Bt; int M, N, K; int G, c;
    __device__ __forceinline__ bool next(int i, Unit& u) const {
        const int nM = M / 256, nN = N / 256, nwg = nM * nN; const long L = (long)i * G + c; if (L >= (long)nwg) return false;
        const int w = (G & 7) ? (int)L : xcd_remap(L, nwg);
        const int nig = 8 * nN, gid = w / nig, fm = gid * 8, gsz = (nM - fm) < 8 ? (nM - fm) : 8, wi = w - gid * nig;
        u.pm = fm + wi % gsz; u.pn = wi / gsz; return true;
    }
    __device__ __forceinline__ const h16* abase() const { return A; }
    __device__ __forceinline__ int aoff(const Unit& u, int r) const { return (256 * u.pm + r) * K; }
    __device__ __forceinline__ const h16* bt(const Unit& u) const { return Bt + (size_t)(256 * u.pn) * K; }
};
struct ProbDenseR : ProbDense { int ri; __device__ __forceinline__ bool next(int i, Unit& u) const { return i == 0 ? ProbDense::next(ri, u) : false; } };
struct ProbMoe1 {
    static constexpr bool F8 = true; static constexpr bool GATHER = true; static constexpr int NB = 512; static constexpr int AROW_BYTES = 1024;
    static constexpr int SCALE_B0 = 0x7A7A7A7A, SCALE_A0 = 0x77777777, SCALE_B1 = 0x7A7A7A7A, SCALE_A1 = 0x7A7A7A7A;
    const h16* X1; const h16* W1t; const int* row_tok; const LAS int* tile_e; int NT; int K; int G, c; int t0;
    __device__ __forceinline__ bool next(int i, Unit& u) const {
        const int nwg = (NT - t0) * 2; const int L = i * G + c; if (L >= nwg) return false;
        const int w = (G & 7) ? (int)L : xcd_remap(L, nwg);
        u.pm = t0 + (w >> 1); u.pn = w & 1; u.rep = 0; return true;
    }
    __device__ __forceinline__ const h16* abase() const { return X1; }
    __device__ __forceinline__ int aoff(const Unit& u, int r) const { return row_tok[256 * u.pm + r] * 512; }
    __device__ __forceinline__ const int* arow(const Unit& u, int r) const { return row_tok + 256 * u.pm + r; }
    __device__ __forceinline__ const h16* bt(const Unit& u) const { return W1t + (size_t)__builtin_amdgcn_readfirstlane(tile_e[u.pm]) * (512 * 512) + (size_t)u.pn * (256 * 8); }
};
struct ProbMoe1S {
    static constexpr bool F8 = true; static constexpr bool GATHER = false; static constexpr int NB = 512;
    static constexpr int SCALE_B0 = 0x7A7A7A7A, SCALE_A0 = 0x77777777, SCALE_B1 = 0x7A7A7A7A, SCALE_A1 = 0x7A7A7A7A;
    const h16* X1; const h16* W1s; int K; int n, r;
    __device__ __forceinline__ bool next(int i, Unit& u) const { const int L = i * n + r; if (L >= 256) return false; u.pm = L >> 1; u.pn = L & 1; u.rep = 0; return true; }
    __device__ __forceinline__ const h16* abase() const { return X1; }
    __device__ __forceinline__ int aoff(const Unit& u, int rr) const { return (256 * u.pm + rr) * 512; }
    __device__ __forceinline__ const h16* bt(const Unit& u) const { return W1s + (size_t)u.pn * (256 * 8); }
};
struct ProbMoe2 {
    static constexpr bool F8 = true; static constexpr bool GATHER = false; static constexpr int NB = 1024;
    static constexpr int SCALE_B0 = 0x7C7C7C7C, SCALE_B1 = 0x7C7C7C7C, SCALE_A0 = 0x7C7C7C7C, SCALE_A1 = 0x7C7C7C7C;
    const h16* HID; const h16* W2t; const LAS int* tile_e; int NT; int K; int G, c;
    __device__ __forceinline__ bool next(int i, Unit& u) const {
        const int nwg = NT * 4; int L = i * G + c; u.rep = 0;
#if PROBE_DUP2
        { const int nc = c < nwg ? (nwg - c + G - 1) / G : 0; if (i >= nc) { L = (i - nc) * G + c; u.rep = 1; if (i >= 2 * nc) return false; } }
#endif
        (void)L; const int Rf = NT / G; int tl, pn;
        if (i < 4 * Rf) { tl = (i >> 2) * G + c; pn = i & 3; }
        else { const int Lr = (i - 4 * Rf) * G + c; if (Lr >= (NT - Rf * G) * 4) return false; tl = Rf * G + (Lr >> 2); pn = Lr & 3; }
        u.pm = (G & 7) ? tl : xcd_remap(tl, NT); u.pn = pn; return true;
    }
    __device__ __forceinline__ const h16* abase() const { return HID; }
    __device__ __forceinline__ int aoff(const Unit& u, int r) const { return (256 * u.pm + r) * 128; }
    __device__ __forceinline__ const h16* bt(const Unit& u) const { return W2t + (size_t)__builtin_amdgcn_readfirstlane(tile_e[u.pm]) * (1024 * 128) + (size_t)u.pn * (256 * 8); }
};

__device__ __forceinline__ unsigned pk4_fp8s(f32x4 v, float sc) {
    v = v * sc;
#pragma unroll
    for (int j = 0; j < 4; ++j) v[j] = __builtin_amdgcn_fmed3f(v[j], -F8_MAX, F8_MAX);
    int w = 0; w = __builtin_amdgcn_cvt_pk_fp8_f32(v[0], v[1], w, false); w = __builtin_amdgcn_cvt_pk_fp8_f32(v[2], v[3], w, true); return (unsigned)w; }
#define EPI_LOOP_BEGIN \
    _Pragma("unroll") for (int ai = 0; ai < 2; ++ai) _Pragma("unroll") for (int m = 0; m < 4; ++m) { const int row = 256 * u.pm + 128 * ai + 64 * wr + 16 * m + fr; \
    _Pragma("unroll") for (int bj = 0; bj < 2; ++bj) { const int col = 256 * u.pn + 128 * bj + 32 * wc + 8 * fq; f32x4 v0 = acc[ai][bj][m][0], v1 = acc[ai][bj][m][1];
#define EPI_LOOP_END } }

#define EPI_FENCE asm volatile("" ::: "memory")
struct EpiInProj {
    static constexpr bool AFTER_DRAIN = false; static constexpr bool ADJ = false; static constexpr bool PRELOAD = false;
    h16* H; const float* bias; int mode;
    __device__ __forceinline__ void operator()(const f32x4 (&acc)[2][2][4][2], const Unit& u, int wr, int wc, int fr, int fq) const {
        if (mode == 2) { asm volatile("" :: "v"(acc[0][0][0][0]), "v"(acc[1][1][3][1])); return; }
        f32x4 bv[2][2];
#pragma unroll
        for (int bj = 0; bj < 2; ++bj) { const int col = 256 * u.pn + 128 * bj + 32 * wc + 8 * fq; bv[bj][0] = *(const f32x4*)(bias + col); bv[bj][1] = *(const f32x4*)(bias + col + 4); }
        EPI_FENCE;
        if (u.pn < 8) {
            EPI_LOOP_BEGIN
                v0 += bv[bj][0]; v1 += bv[bj][1];
                const f32x2 a_ = gelu_pk((f32x2){v0[0], v0[1]}), b_ = gelu_pk((f32x2){v0[2], v0[3]}), c_ = gelu_pk((f32x2){v1[0], v1[1]}), d_ = gelu_pk((f32x2){v1[2], v1[3]});
                v0 = (f32x4){a_.x, a_.y, b_.x, b_.y}; v1 = (f32x4){c_.x, c_.y, d_.x, d_.y};
                *(f16x8*)(H + (size_t)row * NIN + col) = pack8(v0, v1);
            EPI_LOOP_END
        } else {
            EPI_LOOP_BEGIN
                v0 += bv[bj][0]; v1 += bv[bj][1];
                *(f16x8*)(H + (size_t)row * NIN + col) = pack8(v0, v1);
            EPI_LOOP_END
        }
    }
};
struct EpiYb {
    static constexpr bool AFTER_DRAIN = false; static constexpr bool ADJ = false; static constexpr bool PRELOAD = false;
    h16* MG; const h16* H;
    __device__ __forceinline__ void operator()(const f32x4 (&acc)[2][2][4][2], const Unit& u, int wr, int wc, int fr, int fq) const {
        f16x8 g[2][4][2];
#pragma unroll
        for (int ai = 0; ai < 2; ++ai)
#pragma unroll
            for (int m = 0; m < 4; ++m)
#pragma unroll
                for (int bj = 0; bj < 2; ++bj) g[ai][m][bj] = *(const f16x8*)(H + (size_t)(256 * u.pm + 128 * ai + 64 * wr + 16 * m + fr) * NIN + C_GB + 256 * u.pn + 128 * bj + 32 * wc + 8 * fq);
        EPI_FENCE;
        EPI_LOOP_BEGIN
#pragma unroll
            for (int j = 0; j < 4; ++j) { v0[j] *= sigmoidf_((float)g[ai][m][bj][j]); v1[j] *= sigmoidf_((float)g[ai][m][bj][4 + j]); }
            *(f16x8*)(MG + (size_t)row * DM + col) = pack8(v0, v1);
        EPI_LOOP_END
    }
};
struct EpiYa {
    static constexpr bool AFTER_DRAIN = false; static constexpr bool ADJ = false; static constexpr bool PRELOAD = false;
    h16* MG; const h16* H;
    __device__ __forceinline__ void operator()(const f32x4 (&acc)[2][2][4][2], const Unit& u, int wr, int wc, int fr, int fq) const {
#pragma unroll
        for (int ai = 0; ai < 2; ++ai) {
            f16x8 g[4][2], t[4][2];
#pragma unroll
            for (int m = 0; m < 4; ++m)
#pragma unroll
                for (int bj = 0; bj < 2; ++bj) { const int row = 256 * u.pm + 128 * ai + 64 * wr + 16 * m + fr, col = 256 * u.pn + 128 * bj + 32 * wc + 8 * fq;
                    g[m][bj] = *(const f16x8*)(H + (size_t)row * NIN + C_GA + col); t[m][bj] = *(const f16x8*)(MG + (size_t)row * DM + col); }
            EPI_FENCE;
#pragma unroll
            for (int m = 0; m < 4; ++m)
#pragma unroll
                for (int bj = 0; bj < 2; ++bj) { const int row = 256 * u.pm + 128 * ai + 64 * wr + 16 * m + fr, col = 256 * u.pn + 128 * bj + 32 * wc + 8 * fq;
                    f32x4 v0 = acc[ai][bj][m][0], v1 = acc[ai][bj][m][1];
#pragma unroll
                    for (int j = 0; j < 4; ++j) { v0[j] = v0[j] * sigmoidf_((float)g[m][bj][j]) + (float)t[m][bj][j]; v1[j] = v1[j] * sigmoidf_((float)g[m][bj][4 + j]) + (float)t[m][bj][4 + j]; }
                    *(f16x8*)(MG + (size_t)row * DM + col) = pack8(v0, v1); }
            EPI_FENCE;
        }
    }
};
struct EpiOutW {
    static constexpr bool AFTER_DRAIN = false; static constexpr bool ADJ = false; static constexpr bool PRELOAD = false;
    float* R; const float* X;
    __device__ __forceinline__ void operator()(const f32x4 (&acc)[2][2][4][2], const Unit& u, int wr, int wc, int fr, int fq) const {
#pragma unroll
        for (int ai = 0; ai < 2; ++ai)
#pragma unroll
            for (int mh = 0; mh < 2; ++mh) {
                f32x4 xv[2][2][2];
#pragma unroll
                for (int mm = 0; mm < 2; ++mm)
#pragma unroll
                    for (int bj = 0; bj < 2; ++bj) { const int m = 2 * mh + mm; const int row = 256 * u.pm + 128 * ai + 64 * wr + 16 * m + fr, col = 256 * u.pn + 128 * bj + 32 * wc + 8 * fq;
                        xv[mm][bj][0] = *(const f32x4*)(X + (size_t)row * DM + col); xv[mm][bj][1] = *(const f32x4*)(X + (size_t)row * DM + col + 4); }
                EPI_FENCE;
#pragma unroll
                for (int mm = 0; mm < 2; ++mm)
#pragma unroll
                    for (int bj = 0; bj < 2; ++bj) { const int m = 2 * mh + mm; const int row = 256 * u.pm + 128 * ai + 64 * wr + 16 * m + fr, col = 256 * u.pn + 128 * bj + 32 * wc + 8 * fq;
                        *(f32x4*)(R + (size_t)row * DM + col) = xv[mm][bj][0] * ALPHA + acc[ai][bj][m][0]; *(f32x4*)(R + (size_t)row * DM + col + 4) = xv[mm][bj][1] * ALPHA + acc[ai][bj][m][1]; }
                EPI_FENCE;
            }
    }
};
struct PanelStats {
    unsigned long long* xbuf;
    unsigned* cnt;
    float eps;
    __device__ __forceinline__ void run(const f32x4 (&v)[2][2][4][2], const Unit& u, int wr, int wc, int fr, int fq, LAS unsigned char* lds, int wid, int lane) const {
        LAS f32x2* P = (LAS f32x2*)lds;
        LAS f32x2* S = (LAS f32x2*)(lds + 8192);
#pragma unroll
        for (int ai = 0; ai < 2; ++ai)
#pragma unroll
            for (int m = 0; m < 4; ++m) {
                float s = 0.f;
#pragma unroll
                for (int bj = 0; bj < 2; ++bj)
#pragma unroll
                    for (int n = 0; n < 2; ++n) { const f32x4 x = v[ai][bj][m][n]; s += (x[0] + x[1]) + (x[2] + x[3]); }
                s += __shfl_xor(s, 16); s += __shfl_xor(s, 32);
                const float mw = s * (1.0f / 64.0f); float q = 0.f;
#pragma unroll
                for (int bj = 0; bj < 2; ++bj)
#pragma unroll
                    for (int n = 0; n < 2; ++n) { const f32x4 d = v[ai][bj][m][n] - mw; q += (d[0] * d[0] + d[1] * d[1]) + (d[2] * d[2] + d[3] * d[3]); }
                q += __shfl_xor(q, 16); q += __shfl_xor(q, 32);
                if (fq == 0) P[(ai * 128 + wr * 64 + m * 16 + fr) * 4 + wc] = (f32x2){mw, q};
            }
        asm volatile("s_waitcnt lgkmcnt(0)" ::: "memory"); __builtin_amdgcn_s_barrier(); asm volatile("" ::: "memory");
        const int row = wid * 32 + (lane & 31);
        if (lane < 32) {
            const f32x2 a = P[row * 4 + 0], b = P[row * 4 + 1], c = P[row * 4 + 2], d = P[row * 4 + 3];
            const float mt = (a.x + b.x + c.x + d.x) * 0.25f;
            const float da = a.x - mt, db = b.x - mt, dc = c.x - mt, dd = d.x - mt;
            const float m2 = (a.y + b.y) + (c.y + d.y) + 64.0f * ((da * da + db * db) + (dc * dc + dd * dd));
            unsigned long long* slot = xbuf + ((size_t)(u.pm * 256 + row) * 4 + u.pn);
            __hip_atomic_store(slot, ((unsigned long long)__float_as_uint(m2) << 32) | __float_as_uint(mt), __ATOMIC_RELAXED, __HIP_MEMORY_SCOPE_AGENT);
        }
        asm volatile("s_waitcnt vmcnt(0)" ::: "memory");
        if (lane == 0) __hip_atomic_fetch_add(cnt + 64 * u.pm, 1u, __ATOMIC_RELAXED, __HIP_MEMORY_SCOPE_AGENT);
        if (wid == 0) {
            unsigned sp = 0;
            while ((unsigned)__builtin_amdgcn_readfirstlane(__hip_atomic_load(cnt + 64 * u.pm, __ATOMIC_RELAXED, __HIP_MEMORY_SCOPE_AGENT)) < 32u) { __builtin_amdgcn_s_sleep(2); if (++sp > (1u << 22)) break; }
            __builtin_amdgcn_fence(__ATOMIC_ACQUIRE, "agent");
        }
        asm volatile("s_waitcnt vmcnt(0) lgkmcnt(0)" ::: "memory"); __builtin_amdgcn_s_barrier(); asm volatile("" ::: "memory");
        if (lane < 32) {
            const unsigned long long* slot = xbuf + (size_t)(u.pm * 256 + row) * 4; float mt[4], m2[4]; float ms = 0.f;
#pragma unroll
            for (int t = 0; t < 4; ++t) { const unsigned long long w = __hip_atomic_load(slot + t, __ATOMIC_RELAXED, __HIP_MEMORY_SCOPE_AGENT); mt[t] = __uint_as_float((unsigned)w); m2[t] = __uint_as_float((unsigned)(w >> 32)); ms += mt[t]; }
            const float mean = ms * 0.25f; float q = 0.f;
#pragma unroll
            for (int t = 0; t < 4; ++t) { const float dm = mt[t] - mean; q += m2[t] + 256.0f * dm * dm; }
            S[row] = (f32x2){mean, 1.0f / sqrtf(q * (1.0f / 1024.0f) + eps)};
        }
        asm volatile("s_waitcnt lgkmcnt(0)" ::: "memory"); __builtin_amdgcn_s_barrier(); asm volatile("" ::: "memory");
    }
};
struct EpiLn1 {
    static constexpr bool AFTER_DRAIN = true; static constexpr bool ADJ = false; static constexpr bool PRELOAD = false;
    h16* X1; unsigned char* X1F8; const float* X; const float* g; const float* b; PanelStats st;
    __device__ __forceinline__ void operator()(const f32x4 (&)[2][2][4][2], const Unit&, int, int, int, int) const {}
    __device__ __forceinline__ void fused(f32x4 (&acc)[2][2][4][2], const Unit& u, int wr, int wc, int fr, int fq, LAS unsigned char* lds, int wid, int lane) const {
        f32x4 xv[2][2][2][2];
#define LN1_XLOAD(k, buf) { _Pragma("unroll") for (int mm = 0; mm < 2; ++mm) _Pragma("unroll") for (int bj = 0; bj < 2; ++bj) { const int m = 2 * ((k) & 1) + mm; \
            const int row = 256 * u.pm + 128 * ((k) >> 1) + 64 * wr + 16 * m + fr, col = 256 * u.pn + 128 * bj + 32 * wc + 8 * fq; \
            xv[buf][mm][bj][0] = *(const f32x4*)(X + (size_t)row * DM + col); xv[buf][mm][bj][1] = *(const f32x4*)(X + (size_t)row * DM + col + 4); } }
#define LN1_XADD(k, buf) { _Pragma("unroll") for (int mm = 0; mm < 2; ++mm) _Pragma("unroll") for (int bj = 0; bj < 2; ++bj) { const int m = 2 * ((k) & 1) + mm; \
            acc[(k) >> 1][bj][m][0] += xv[buf][mm][bj][0] * ALPHA; acc[(k) >> 1][bj][m][1] += xv[buf][mm][bj][1] * ALPHA; } \
            asm volatile("" : "+v"(acc[(k) >> 1][0][2 * ((k) & 1)][0]), "+v"(acc[(k) >> 1][0][2 * ((k) & 1) + 1][0]), "+v"(acc[(k) >> 1][1][2 * ((k) & 1)][0]), "+v"(acc[(k) >> 1][1][2 * ((k) & 1) + 1][0])); }
        LN1_XLOAD(0, 0) LN1_XLOAD(1, 1) LN1_XADD(0, 0) LN1_XLOAD(2, 0) LN1_XADD(1, 1) LN1_XLOAD(3, 1) LN1_XADD(2, 0) LN1_XADD(3, 1)
#undef LN1_XLOAD
#undef LN1_XADD
        st.run(acc, u, wr, wc, fr, fq, lds, wid, lane);
        const LAS f32x2* S = (const LAS f32x2*)(lds + 8192);
        f32x4 gv[2][2], bv[2][2];
#pragma unroll
        for (int bj = 0; bj < 2; ++bj) { const int col = 256 * u.pn + 128 * bj + 32 * wc + 8 * fq; gv[bj][0] = *(const f32x4*)(g + col); gv[bj][1] = *(const f32x4*)(g + col + 4); bv[bj][0] = *(const f32x4*)(b + col); bv[bj][1] = *(const f32x4*)(b + col + 4); }
        EPI_FENCE;
#pragma unroll
        for (int ai = 0; ai < 2; ++ai)
#pragma unroll
            for (int m = 0; m < 4; ++m) { const int rl = 128 * ai + 64 * wr + 16 * m + fr; const f32x2 sr = S[rl]; const int row = 256 * u.pm + rl;
#pragma unroll
                for (int bj = 0; bj < 2; ++bj) { const int col = 256 * u.pn + 128 * bj + 32 * wc + 8 * fq;
                    const f32x4 o0 = (acc[ai][bj][m][0] - sr.x) * sr.y * gv[bj][0] + bv[bj][0], o1 = (acc[ai][bj][m][1] - sr.x) * sr.y * gv[bj][1] + bv[bj][1];
                    *(f16x8*)(X1 + (size_t)row * DM + col) = pack8(o0, o1);
                    *(u32x2*)(X1F8 + (size_t)row * DM + col) = (u32x2){pk4_fp8s(o0, SC_X1), pk4_fp8s(o1, SC_X1)}; } }
    }
};
struct EpiLogit {
    static constexpr bool AFTER_DRAIN = false; static constexpr bool ADJ = false; static constexpr bool PRELOAD = false;
    float* L;
    __device__ __forceinline__ void operator()(const f32x4 (&acc)[2][2][4][2], const Unit& u, int wr, int wc, int fr, int fq) const {
        EPI_LOOP_BEGIN
            *(f32x4*)(L + (size_t)row * NEXP + col) = v0; *(f32x4*)(L + (size_t)row * NEXP + col + 4) = v1;
        EPI_LOOP_END
    }
};
struct EpiMoe1 {
    static constexpr bool AFTER_DRAIN = false; static constexpr bool ADJ = false; static constexpr bool PRELOAD = false;
    unsigned char* HID;
    __device__ __forceinline__ void operator()(const f32x4 (&acc)[2][2][4][2], const Unit& u, int wr, int wc, int, int) const {
        int t_ = threadIdx.x; asm volatile("" : "+v"(t_)); const int fr = t_ & 15, fq = (t_ >> 4) & 3;
#pragma unroll
        for (int ai = 0; ai < 2; ++ai)
#pragma unroll
            for (int m = 0; m < 4; ++m) {
                const int row = 256 * u.pm + 128 * ai + 64 * wr + 16 * m + fr; const int col = 128 * u.pn + 32 * wc + 8 * fq;
                f32x4 g0 = acc[ai][0][m][0], g1 = acc[ai][0][m][1], u0 = acc[ai][1][m][0], u1 = acc[ai][1][m][1];
#pragma unroll
                for (int j = 0; j < 4; ++j) { g0[j] = g0[j] * sigmoidf_(g0[j]) * u0[j]; g1[j] = g1[j] * sigmoidf_(g1[j]) * u1[j]; }
                *(u32x2*)(HID + (size_t)row * EDIM + col) = (u32x2){pk4_fp8s(g0, 1.0f), pk4_fp8s(g1, 1.0f)};
            }
    }
};
constexpr float Y_SCALE = 64.0f, Y_INV = 1.0f / 64.0f;
__device__ __forceinline__ unsigned pk4_fp8(f32x4 v) { int w = 0; w = __builtin_amdgcn_cvt_pk_fp8_f32(v[0], v[1], w, false); w = __builtin_amdgcn_cvt_pk_fp8_f32(v[2], v[3], w, true); return (unsigned)w; }
struct EpiMoe2 {
    static constexpr bool AFTER_DRAIN = false; static constexpr bool ADJ = true; static constexpr bool PRELOAD = true;
    unsigned char* Y; const int* row_dst; int mode;
    __device__ __forceinline__ void preload(const Unit& u, LAS unsigned char* rd, int wid, int lane) const {
        __builtin_amdgcn_global_load_lds((const unsigned*)(row_dst + 256 * u.pm + (wid & 3) * 64 + lane), (LAS unsigned*)(rd + (wid & 3) * 256), 4, 0, 0);
    }
    __device__ __forceinline__ void run(const f32x4 (&acc)[2][2][4][2], const Unit& u, int wr, int wc, int fr, int fq, LAS unsigned char* rd) const {
        const int md = PROBE_DUP2 ? (u.rep ? mode : 0) : 0;
        if (md == 2) { asm volatile("" :: "v"(acc[0][0][0][0]), "v"(acc[1][1][3][1])); return; }
        const int col = 256 * u.pn + 64 * wc + 16 * fq;
#pragma unroll
        for (int ai = 0; ai < 2; ++ai) {
            int dsts[4];
#pragma unroll
            for (int m = 0; m < 4; ++m) dsts[m] = *(const LAS int*)(rd + (128 * ai + 64 * wr + 16 * m + fr) * 4);
            u32x4 w[4];
#pragma unroll
            for (int m = 0; m < 4; ++m) { w[m][0] = pk4_fp8(acc[ai][0][m][0]); w[m][1] = pk4_fp8(acc[ai][0][m][1]); w[m][2] = pk4_fp8(acc[ai][1][m][0]); w[m][3] = pk4_fp8(acc[ai][1][m][1]); }
#pragma unroll
            for (int m = 0; m < 4; ++m) {
                const int dst = dsts[m];
                if (dst >= 0) { if (md == 0) *(u32x4*)(Y + (size_t)dst * DM + col) = w[m]; else asm volatile("" :: "v"(w[m])); }
            }
        }
    }
    __device__ __forceinline__ void operator()(const f32x4 (&)[2][2][4][2], const Unit&, int, int, int, int) const {}
};

__device__ __forceinline__ void tr_item(const float* W, int K, int N, int k0, int n0, h16* dst, float* scr, int lane) {
    (void)scr;
    const int lk = lane & 7, ln = lane >> 3;
    const float* src = W + (size_t)(k0 + 8 * lk) * N + n0 + 4 * ln;
    f32x4 v[8];
#pragma unroll
    for (int i = 0; i < 8; ++i) v[i] = __builtin_nontemporal_load((const f32x4*)(src + (size_t)i * N));
#pragma unroll
    for (int j = 0; j < 4; ++j) { f16x8 o;
#pragma unroll
        for (int i = 0; i < 8; ++i) o[i] = (h16)v[i][j];
        *(f16x8*)(dst + (size_t)(4 * ln + j) * K + k0 + 8 * lk) = o; }
}
constexpr int CONV_N1 = 257 * 128 + 64, CONV_N2 = 256 * 64, CONV_NF = 2;
__device__ __forceinline__ void conv_down_addr(const Frame& F, int e, int r, const float*& src, int& N, unsigned char*& dst) {
    const float* wd = e < 256 ? F.e_wd + (size_t)e * 256 * 1024 : F.s_wd; unsigned char* w2 = F.W2t + (size_t)e * 1024 * 256;
    const int kb = r >> 2, nq = r & 3; src = wd + (size_t)kb * 16 * 1024 + nq * 256; N = 1024; dst = w2 + ((size_t)kb * 1024 + nq * 256) * 16;
}
__device__ __forceinline__ void conv_item_addr(const Frame& F, int it, const float*& src, int& N, unsigned char*& dst) {
    if (it >= 257 * 128) { conv_down_addr(F, 256, it - 257 * 128, src, N, dst); return; }
    const int e = it >> 7, r = it & 127;
    const float* wg = e < 256 ? F.e_wg + (size_t)e * 1024 * 256 : F.s_wg;
    const float* wu = e < 256 ? F.e_wu + (size_t)e * 1024 * 256 : F.s_wu;
    unsigned char* w1 = F.W1t + (size_t)e * 512 * 1024;
    if (r < 64) { src = wg + (size_t)r * 4096; N = 256; dst = w1 + (size_t)r * (512 * 16); }
    else { src = wu + (size_t)(r - 64) * 4096; N = 256; dst = w1 + (size_t)(r - 64) * (512 * 16) + 128 * 16; }
}
#define CONV_LOAD(u, itv) { const float* sp; conv_item_addr(F, itv, sp, Nn[u], d[u]); const float* p = sp + 4 * lane; \
        _Pragma("unroll") for (int i = 0; i < 16; ++i) v[u][i] = __builtin_nontemporal_load((const f32x4*)(p + (size_t)i * Nn[u])); }
#define CONV_STORE(u) { _Pragma("unroll") for (int j = 0; j < 4; ++j) { u32x4 o; \
        _Pragma("unroll") for (int i4 = 0; i4 < 4; ++i4) { int w = 0; \
            w = __builtin_amdgcn_cvt_pk_fp8_f32(v[u][4 * i4][j] * SC_W, v[u][4 * i4 + 1][j] * SC_W, w, false); w = __builtin_amdgcn_cvt_pk_fp8_f32(v[u][4 * i4 + 2][j] * SC_W, v[u][4 * i4 + 3][j] * SC_W, w, true); o[i4] = (unsigned)w; } \
        *(LAS u32x4*)(cl + (4 * lane + j + (lane >> 2)) * 16) = o; }   \
        _Pragma("unroll") for (int s_ = 0; s_ < 4; ++s_) { const u32x4 o = *(const LAS u32x4*)(cl + (68 * s_ + lane + (lane >> 4)) * 16); \
            const int off_ = (Nn[u] == 256 && s_ >= 2) ? (256 * 16 + (s_ - 2) * 1024) : s_ * 1024;        \
            __builtin_nontemporal_store(o, (u32x4*)(d[u] + off_ + lane * 16)); } }
__device__ __forceinline__ void conv_experts(Frame& F, int gw, int NGW) {
    const int lane = F.lane; LAS unsigned char* cl = (LAS unsigned char*)F.lds + F.wave * 4096;
    constexpr int NIT = CONV_N1, NF = CONV_NF;
    for (int it = gw; it < NIT; it += NF * NGW) {
        f32x4 v[NF][16]; unsigned char* d[NF]; int Nn[NF]; bool ok[NF];
#pragma unroll
        for (int u = 0; u < NF; ++u) { const int itu = it + u * NGW; ok[u] = itu < NIT; CONV_LOAD(u, ok[u] ? itu : it) }
#pragma unroll
        for (int u = 0; u < NF; ++u) { if (ok[u]) CONV_STORE(u) }
    }
}
__device__ __forceinline__ void conv_experts_dyn(Frame& F, LAS unsigned char* cl, int max_deq = 0x7fffffff) {
    const int lane = F.lane;
    constexpr int NIT = CONV_N1, NF = CONV_NF, CH = 4, PER = NIT / 8;
    const int x = F.bid & 7; unsigned* ctr = F.ctl + CW_CONVQ + 64 * x;
    const int lo = x * PER, hi = (x == 7) ? NIT : lo + PER;
    for (int dq = 0; dq < max_deq; ++dq) {
        unsigned b0 = 0;
        if (lane == 0) b0 = __hip_atomic_fetch_add(ctr, (unsigned)CH, __ATOMIC_RELAXED, __HIP_MEMORY_SCOPE_AGENT);
        const int base = lo + (int)__builtin_amdgcn_readfirstlane(b0);
        if (base >= hi) break;
        const int end = base + CH < hi ? base + CH : hi;
        for (int it = base; it < end; it += NF) {
            f32x4 v[NF][16]; unsigned char* d[NF]; int Nn[NF]; bool ok[NF];
#pragma unroll
            for (int u = 0; u < NF; ++u) { const int itu = it + u; ok[u] = itu < end; CONV_LOAD(u, ok[u] ? itu : it) }
#pragma unroll
            for (int u = 0; u < NF; ++u) { if (ok[u]) CONV_STORE(u) }
        }
    }
}
__device__ __forceinline__ void ph_prologue(Frame& F) {
    float* scr = (float*)(F.lds + F.wave * 16384);
    const int gw = F.bid * NWAVES + F.wave, NGW = F.G * NWAVES;
    constexpr int I_IN = 16 * 200, I_A = 16 * 32, I_B = 4 * 32, I_O = 16 * 32, I_R = 16 * 8, I_SMALL = I_IN + I_A + I_B + I_O + I_R;
    auto small_item = [&](int r, const float*& W, int& K, int& N, int& k0, int& n0, h16*& dst) {
        if (r < I_IN) { const int kb = r / 200, nb = r % 200; W = F.in_w; K = 1024; N = NIN; k0 = 64 * kb; n0 = 32 * nb; dst = F.WinT + (size_t)(32 * nb) * 1024; return; } r -= I_IN;
        if (r < I_A) { const int kb = r / 32, nb = r % 32; W = F.pa_w; K = 1024; N = 1024; k0 = 64 * kb; n0 = 32 * nb; dst = F.WaT + (size_t)(32 * nb) * 1024; return; } r -= I_A;
        if (r < I_B) { const int kb = r / 32, nb = r % 32; W = F.pb_w; K = 256; N = 1024; k0 = 64 * kb; n0 = 32 * nb; dst = F.WbT + (size_t)(32 * nb) * 256; return; } r -= I_B;
        if (r < I_O) { const int kb = r / 32, nb = r % 32; W = F.out_w; K = 1024; N = 1024; k0 = 64 * kb; n0 = 32 * nb; dst = F.WoT + (size_t)(32 * nb) * 1024; return; } r -= I_O;
        { const int kb = r / 8, nb = r % 8; W = F.r_w; K = 1024; N = 256; k0 = 64 * kb; n0 = 32 * nb; dst = F.WrT + (size_t)(32 * nb) * 1024; }
    };
    constexpr int SMAX = 3;
    f32x4 sv[SMAX][8];
    { const int lk = F.lane & 7, ln = F.lane >> 3;
#pragma unroll
      for (int u = 0; u < SMAX; ++u) { const int it = gw + u * NGW; const float* W; int K, N, k0, n0; h16* dst; small_item(it < I_SMALL ? it : gw % I_SMALL, W, K, N, k0, n0, dst);
          const float* src = W + (size_t)(k0 + 8 * lk) * N + n0 + 4 * ln;
#pragma unroll
          for (int i = 0; i < 8; ++i) sv[u][i] = __builtin_nontemporal_load((const f32x4*)(src + (size_t)i * N)); } }
    for (int it = gw + SMAX * NGW; it < I_SMALL; it += NGW) {
        const float* W; int K, N, k0, n0; h16* dst; small_item(it, W, K, N, k0, n0, dst); tr_item(W, K, N, k0, n0, dst, scr, F.lane); }
#if !CONV_IN_ATTN
    conv_experts(F, F.bid * NWAVES + F.wave, F.G * NWAVES);
#endif
    for (int i = F.bid * NTHREADS + F.tid; i < 8 * 128 * 128; i += F.G * NTHREADS) { const int tt = (i >> 7) & 127, ss = i & 127; F.Wc[i] = (ss <= tt) ? (h16)F.sp_w[i] : (h16)0.f; }
    const size_t nth = (size_t)F.G * NTHREADS; const size_t n8 = (size_t)T * DM / 8;
    for (size_t i = (size_t)F.bid * NTHREADS + F.tid; i < n8; i += 4 * nth) {
        f32x4 a[4], b[4];
#pragma unroll
        for (int u = 0; u < 4; ++u) { const size_t j = i + u * nth; if (j < n8) { a[u] = __builtin_nontemporal_load((const f32x4*)(F.x + j * 8)); b[u] = __builtin_nontemporal_load((const f32x4*)(F.x + j * 8 + 4)); } }
#pragma unroll
        for (int u = 0; u < 4; ++u) { const size_t j = i + u * nth; if (j < n8) *(f16x8*)(F.x16 + j * 8) = pack8(a[u], b[u]); }
    }
    { const int lk = F.lane & 7, ln = F.lane >> 3;
#pragma unroll
      for (int u = 0; u < SMAX; ++u) { const int it = gw + u * NGW; if (it < I_SMALL) { const float* W; int K, N, k0, n0; h16* dst; small_item(it, W, K, N, k0, n0, dst);
#pragma unroll
          for (int j = 0; j < 4; ++j) { f16x8 o;
#pragma unroll
              for (int i = 0; i < 8; ++i) o[i] = (h16)sv[u][i][j];
              *(f16x8*)(dst + (size_t)(4 * ln + j) * K + k0 + 8 * lk) = o; } } } }
}

__device__ __forceinline__ void ph_attn_simple(Frame& F) {
    float* pl = (float*)(F.lds) + F.wave * 512;
    const int gw = F.bid * NWAVES + F.wave, NGW = F.G * NWAVES;
    const int lane = F.lane;
    for (int it = gw; it < T * 4; it += NGW) {
        const int t = it >> 2, hg = it & 3; const int s = t & (SEQ - 1);
        float sc[3][3];
        float mx = -INFINITY;
#pragma unroll
        for (int g = 0; g < 3; ++g) {
            const int hh = 4 * g + hg; const int dil = (g == 0) ? 1 : (g == 1 ? 4 : 16);
            const float slope = exp2f(hh < 8 ? -0.5f * (float)(hh + 1) : -(float)(hh - 3));
            const h16* qp = F.h + (size_t)t * NIN + C_Q + hh * 64;
            f16x8 q[8];
#pragma unroll
            for (int j = 0; j < 8; ++j) q[j] = *(const f16x8*)(qp + 8 * j);
#pragma unroll
            for (int r = 0; r < 3; ++r) {
                const int delta = lane + 64 * r; const bool valid = (r < 2 || lane == 0) && (s - delta * dil >= 0);
                float v = -INFINITY;
                if (valid) {
                    const h16* kp = F.h + (size_t)(t - delta * dil) * NIN + C_K + hh * 64;
                    float d = 0.f;
#pragma unroll
                    for (int j = 0; j < 8; ++j) { const f16x8 kk = *(const f16x8*)(kp + 8 * j);
#pragma unroll
                        for (int e = 0; e < 8; ++e) d += (float)q[j][e] * (float)kk[e]; }
                    v = d * 0.125f - slope * (float)(delta * dil);
                }
                sc[g][r] = v; mx = fmaxf(mx, v);
            }
        }
        mx = wave_max(mx);
        float lsum = 0.f;
#pragma unroll
        for (int g = 0; g < 3; ++g)
#pragma unroll
            for (int r = 0; r < 3; ++r) {
                const float p = (sc[g][r] == -INFINITY) ? 0.f : __expf(sc[g][r] - mx);
                lsum += p;
                if (r < 2 || lane == 0) pl[g * 129 + lane + 64 * r] = p;
            }
        lsum = wave_sum(lsum);
        __builtin_amdgcn_s_waitcnt(0xc07f); asm volatile("" ::: "memory");
        float o = 0.f;
#pragma unroll
        for (int g = 0; g < 3; ++g) {
            const int hh = 4 * g + hg; const int dil = (g == 0) ? 1 : (g == 1 ? 4 : 16);
            int nk = s / dil + 1; if (nk > 129) nk = 129;
            const h16* vp = F.h + (size_t)t * NIN + C_VV + hh * 64 + lane;
            for (int delta = 0; delta < nk; ++delta) o += pl[g * 129 + delta] * (float)vp[-(long)delta * dil * NIN];
        }
        F.yb[(size_t)t * 256 + hg * 64 + lane] = (h16)(o / lsum);
        asm volatile("" ::: "memory");
    }
}

typedef float f32x16 __attribute__((ext_vector_type(16)));
typedef short v4i16_t __attribute__((ext_vector_type(4)));
__device__ __forceinline__ int crow(int r, int hi) { return (r & 3) + 8 * (r >> 2) + 4 * hi; }
__device__ __forceinline__ void ph_attn_fast(Frame& F, LAS unsigned char* ldsb) {
    const int lane = F.lane, q = lane & 31, hi = lane >> 5;
    LAS unsigned char* vl = ldsb + F.wave * 16640;
    const int vcu = (F.G % 8 == 0) ? (F.bid % 8) * (F.G / 8) + F.bid / 8 : F.bid;
    constexpr int NTASK = 8 * 12 * 32 * 4;
#if CONV_IN_ATTN
    constexpr int NA = ATTN_WAVES;
    if (F.wave >= NA) { conv_experts_dyn(F, vl); return; }
#else
    constexpr int NA = NWAVES;
#endif
    const int R = (NTASK + F.G * NA - 1) / (F.G * NA);
    const int li = lane & 15;
    const int tr_base = (4 * hi + (li >> 2)) * 64 + (16 * ((lane >> 4) & 1) + 4 * (li & 3)) * 2;
    const int vw_kv = lane >> 3, vw_c = lane & 7;
    const int vw_off = (vw_c >> 2) * 2112 + vw_kv * 64 + (vw_c & 3) * 16;
    for (int it = 0; it < R; ++it) {
        const int task = (vcu * R + it) * NA + F.wave;
        if (task >= NTASK) break;
        const int unit = task >> 2, a = task & 3, bh = unit >> 5, blk = unit & 31;
        const int b = bh / 12, hh = bh - b * 12, g = hh >> 2, dsh = 2 * g, dil = 1 << dsh;
        const int n = blk >> dsh, r = blk & (dil - 1);
        const int Iq0 = n * 128 + 32 * a, Ik0 = Iq0 - 128;
        const int nskip = Ik0 < 0 ? ((-Ik0) >> 5) : 0;
        const float slope = exp2f(hh < 8 ? -0.5f * (float)(hh + 1) : -(float)(hh - 3));
        const float c1 = 0.125f * 1.4426950408889634f, c2 = slope * (float)dil * 1.4426950408889634f;
        const h16* hb = F.h + (size_t)b * SEQ * NIN + (size_t)r * NIN + hh * 64;
        const size_t rs = (size_t)dil * NIN;
        f16x8 qf[4];
        { const h16* qp = hb + (size_t)(Iq0 + q) * rs + C_Q + 8 * hi;
#pragma unroll
          for (int s4 = 0; s4 < 4; ++s4) qf[s4] = *(const f16x8*)(qp + 16 * s4); }
        f32x16 S[5];
        LAS unsigned char* kt0 = vl + 8448;
#define ATT_K_BATCH(KB0, NB) { f16x8 kg[NB][4]; \
            _Pragma("unroll") for (int kb = 0; kb < NB; ++kb) _Pragma("unroll") for (int i = 0; i < 4; ++i) \
                kg[kb][i] = *(const f16x8*)(hb + (size_t)(Ik0 + 32 * (KB0 + kb) + 8 * i + vw_kv) * rs + C_K + 8 * vw_c); \
            _Pragma("unroll") for (int kb = 0; kb < NB; ++kb) { LAS unsigned char* kt = kt0 + ((KB0 + kb) & 1) * 4096; \
                _Pragma("unroll") for (int i = 0; i < 4; ++i) { const int kv_ = 8 * i + vw_kv; *(LAS f16x8*)(kt + kv_ * 128 + ((vw_c ^ ((kv_ >> 1) & 7)) << 4)) = kg[kb][i]; } \
                _Pragma("unroll") for (int e = 0; e < 16; ++e) S[KB0 + kb][e] = 0.f; \
                _Pragma("unroll") for (int s4 = 0; s4 < 4; ++s4) { const f16x8 kf_ = *(const LAS f16x8*)(kt + q * 128 + (((2 * s4 + hi) ^ ((q >> 1) & 7)) << 4)); \
                    S[KB0 + kb] = MFMA32(kf_, qf[s4], S[KB0 + kb]); } } }
        ATT_K_BATCH(0, 3)
        ATT_K_BATCH(3, 2)
#undef ATT_K_BATCH
        f16x8 vgA[3][4], vgB[2][4];
#pragma unroll
        for (int kb = 0; kb < 3; ++kb) {
            const int kbc = kb;
#pragma unroll
            for (int i = 0; i < 4; ++i) vgA[kb][i] = *(const f16x8*)(hb + (size_t)(Ik0 + 32 * kbc + 8 * i + vw_kv) * rs + C_VV + 8 * vw_c);
        }
        int qq = q; asm volatile("" : "+v"(qq));
        const float nb = -c2 * (float)(qq + 128 - 4 * hi);
        const int qrel = qq - 4 * hi;
        float m = -INFINITY;
#pragma unroll
        for (int kb = 0; kb < 5; ++kb)
#pragma unroll
            for (int e = 0; e < 16; ++e) {
                const int ec = (e & 3) + 8 * (e >> 2);
                float v = __builtin_fmaf(S[kb][e], c1, __builtin_fmaf(c2, (float)(32 * kb + ec), nb));
                bool ok = kb >= nskip;
                if (kb == 0) ok = ok && (ec >= qrel);
                if (kb == 4) ok = ok && (ec <= qrel);
                v = ok ? v : -INFINITY;
                S[kb][e] = v; m = fmaxf(m, v);
            }
        m = fmaxf(m, __shfl_xor(m, 32));
        float l = 0.f;
        f16x8 pf[5][2];
#pragma unroll
        for (int kb = 0; kb < 5; ++kb)
#pragma unroll
            for (int e = 0; e < 16; ++e) { const float p = __builtin_amdgcn_exp2f(S[kb][e] - m); l += p; pf[kb][e >> 3][e & 7] = (h16)p; }
        l += __shfl_xor(l, 32);
#pragma unroll
        for (int kb = 3; kb < 5; ++kb) {
            const int kbc = kb;
#pragma unroll
            for (int i = 0; i < 4; ++i) vgB[kb - 3][i] = *(const f16x8*)(hb + (size_t)(Ik0 + 32 * kbc + 8 * i + vw_kv) * rs + C_VV + 8 * vw_c);
        }
        f32x16 O[2];
#pragma unroll
        for (int e = 0; e < 16; ++e) { O[0][e] = 0.f; O[1][e] = 0.f; }
#pragma unroll
        for (int kb = 0; kb < 5; ++kb) {
            LAS unsigned char* vb = vl + (kb & 1) * 4224;
#pragma unroll
            for (int i = 0; i < 4; ++i) *(LAS f16x8*)(vb + vw_off + i * 512) = (kb < 3) ? vgA[kb < 3 ? kb : 0][i] : vgB[kb >= 3 ? kb - 3 : 0][i];
#pragma unroll
            for (int s2 = 0; s2 < 2; ++s2) {
#pragma unroll
                for (int db = 0; db < 2; ++db) {
                    const v4i16_t lo = __builtin_amdgcn_ds_read_tr16_b64_v4i16((LAS v4i16_t*)(vb + tr_base + db * 2112 + s2 * 1024));
                    const v4i16_t hi4 = __builtin_amdgcn_ds_read_tr16_b64_v4i16((LAS v4i16_t*)(vb + tr_base + db * 2112 + s2 * 1024 + 512));
                    typedef short s16x8 __attribute__((ext_vector_type(8)));
                    const s16x8 vv = (s16x8){lo[0], lo[1], lo[2], lo[3], hi4[0], hi4[1], hi4[2], hi4[3]};
                    O[db] = MFMA32(__builtin_bit_cast(f16x8, vv), pf[kb][s2], O[db]);
                }
            }
        }
        const float rl = 1.0f / l;
        const size_t tq = (size_t)b * SEQ + (size_t)(Iq0 + q) * dil + r;
        {
            LAS unsigned char* ot = vl;
#pragma unroll
            for (int db = 0; db < 2; ++db)
#pragma unroll
                for (int r4 = 0; r4 < 4; ++r4) { f16x4 w;
#pragma unroll
                    for (int e = 0; e < 4; ++e) w[e] = (h16)(O[db][4 * r4 + e] * rl);
                    const int d0 = 32 * db + 8 * r4 + 4 * hi;
                    *(LAS f16x4*)(ot + q * 128 + ((((d0 >> 3) ^ (q & 7)) << 4) | ((d0 & 7) * 2))) = w; }
#pragma unroll
            for (int j = 0; j < 4; ++j) { const int row = 8 * j + (lane >> 3), ch = lane & 7;
                const f16x8 v = *(const LAS f16x8*)(ot + row * 128 + ((ch ^ (row & 7)) << 4));
                const size_t tr = (size_t)b * SEQ + (size_t)(Iq0 + row) * dil + r;
                *(f16x8*)(F.ao + tr * 768 + hh * 64 + 8 * ch) = v; }
        }
        if (hi == 0) F.lse[tq * 12 + hh] = (m + __builtin_amdgcn_logf(l)) * 0.6931471805599453f;
    }
#if CONV_IN_ATTN
    conv_experts_dyn(F, vl);
#endif
}
__device__ __forceinline__ void attn_merge_chunk(Frame& F, int t0) {
#pragma unroll
    for (int bt = 0; bt < 2; ++bt) {
        float l0[4], l1[4], l2[4]; f16x8 a0[4], a1[4], a2[4];
#pragma unroll
        for (int u = 0; u < 4; ++u) {
            const int idx = F.tid + (4 * bt + u) * NTHREADS; const int c = idx & 7, hg = (idx >> 3) & 3, t = t0 + (idx >> 5);
            l0[u] = F.lse[(size_t)t * 12 + hg]; l1[u] = F.lse[(size_t)t * 12 + 4 + hg]; l2[u] = F.lse[(size_t)t * 12 + 8 + hg];
            const h16* ap = F.ao + (size_t)t * 768 + hg * 64 + 8 * c;
            a0[u] = *(const f16x8*)ap; a1[u] = *(const f16x8*)(ap + 256); a2[u] = *(const f16x8*)(ap + 512);
        }
#pragma unroll
        for (int u = 0; u < 4; ++u) {
            const int idx = F.tid + (4 * bt + u) * NTHREADS; const int c = idx & 7, hg = (idx >> 3) & 3, t = t0 + (idx >> 5);
            const float mx = fmaxf(l0[u], fmaxf(l1[u], l2[u])); float w0 = __expf(l0[u] - mx), w1 = __expf(l1[u] - mx), w2 = __expf(l2[u] - mx); const float inv = 1.0f / (w0 + w1 + w2);
            w0 *= inv; w1 *= inv; w2 *= inv;
            f16x8 o;
#pragma unroll
            for (int e = 0; e < 8; ++e) o[e] = (h16)(w0 * (float)a0[u][e] + w1 * (float)a1[u][e] + w2 * (float)a2[u][e]);
            *(f16x8*)(F.yb + (size_t)t * 256 + hg * 64 + 8 * c) = o;
        }
    }
}

__device__ __forceinline__ void ph_gmlp_simple(Frame& F) {
    float* Vl = (float*)F.lds;
    float* Wl = Vl + 128 * 128;
    float* st = Wl + 128 * 129;
    const int tid = F.tid, lane = F.lane, wave = F.wave;
    for (int ch = F.bid; ch < T / 128; ch += F.G) {
        const int t0 = ch * 128;
#if USE_FAST_ATTN
        attn_merge_chunk(F, t0);
#endif
        for (int i = 0; i < 16; ++i) {
            const int tl = wave * 16 + i; const h16* vp = F.h + (size_t)(t0 + tl) * NIN + C_V;
            const f16x8 a = *(const f16x8*)(vp + 8 * lane), b = *(const f16x8*)(vp + 512 + 8 * lane);
            float s = 0.f;
#pragma unroll
            for (int j = 0; j < 8; ++j) s += (float)a[j] + (float)b[j];
            const float mean = wave_sum(s) * (1.f / 1024.f);
            float q = 0.f;
#pragma unroll
            for (int j = 0; j < 8; ++j) { const float da = (float)a[j] - mean, db = (float)b[j] - mean; q += da * da + db * db; }
            const float rstd = 1.f / sqrtf(wave_sum(q) * (1.f / 1024.f) + LN_EPS);
            if (lane == 0) { st[tl * 2] = mean; st[tl * 2 + 1] = rstd; }
        }
        __syncthreads();
        for (int g = 0; g < 8; ++g) {
            {
                const int sr = tid >> 2, c0 = (tid & 3) * 32; const float mean = st[sr * 2], rstd = st[sr * 2 + 1];
                const h16* vp = F.h + (size_t)(t0 + sr) * NIN + C_V + g * 128 + c0;
#pragma unroll
                for (int j = 0; j < 4; ++j) { const f16x8 a = *(const f16x8*)(vp + 8 * j);
#pragma unroll
                    for (int e = 0; e < 8; ++e) { const int c = c0 + 8 * j + e; Vl[sr * 128 + c] = ((float)a[e] - mean) * rstd * F.gn_g[g * 128 + c] + F.gn_b[g * 128 + c]; } }
            }
            for (int idx = tid; idx < 128 * 128; idx += NTHREADS) { const int tt = idx >> 7, ss = idx & 127; Wl[tt * 129 + ss] = (ss <= tt) ? F.sp_w[(size_t)g * 16384 + idx] : 0.f; }
            __syncthreads();
            {
                const int tt = tid >> 2, c0 = (tid & 3) * 32; float acc[32];
#pragma unroll
                for (int j = 0; j < 32; ++j) acc[j] = 0.f;
                for (int ss = 0; ss < 128; ++ss) { const float w = Wl[tt * 129 + ss];
#pragma unroll
                    for (int j = 0; j < 32; ++j) acc[j] += w * Vl[ss * 128 + c0 + j]; }
                const float sb = F.sp_b[g * 128 + tt];
                const h16* up = F.h + (size_t)(t0 + tt) * NIN + C_U + g * 128 + c0; h16* zp = F.z + (size_t)(t0 + tt) * DM + g * 128 + c0;
#pragma unroll
                for (int j = 0; j < 4; ++j) { const f16x8 uu = *(const f16x8*)(up + 8 * j); f16x8 o;
#pragma unroll
                    for (int e = 0; e < 8; ++e) o[e] = (h16)((float)uu[e] * (acc[8 * j + e] + sb));
                    *(f16x8*)(zp + 8 * j) = o; }
            }
            __syncthreads();
        }
    }
}

constexpr int GM_CB = 8256, GM_IMG = 4 * GM_CB;
__device__ __forceinline__ void gmlp_stage(Frame& F, LAS unsigned char* img, const LAS float* st, int t0, int g) {
#pragma unroll
    for (int i = 0; i < 4; ++i) {
        const int idx = F.tid + i * NTHREADS; const int sr = idx >> 4, cc = idx & 15;
        const f16x8 v = *(const f16x8*)(F.h + (size_t)(t0 + sr) * NIN + C_V + g * 128 + 8 * cc);
        const float mean = st[sr * 2], rstd = st[sr * 2 + 1];
        const f32x4 g0 = *(const f32x4*)(F.gn_g + g * 128 + 8 * cc), g1 = *(const f32x4*)(F.gn_g + g * 128 + 8 * cc + 4);
        const f32x4 b0 = *(const f32x4*)(F.gn_b + g * 128 + 8 * cc), b1 = *(const f32x4*)(F.gn_b + g * 128 + 8 * cc + 4);
        f16x8 o;
#pragma unroll
        for (int e = 0; e < 4; ++e) { o[e] = (h16)(((float)v[e] - mean) * rstd * g0[e] + b0[e]); o[4 + e] = (h16)(((float)v[4 + e] - mean) * rstd * g1[e] + b1[e]); }
        *(LAS f16x8*)(img + (cc >> 2) * GM_CB + sr * 64 + (cc & 3) * 16) = o;
    }
}
__device__ __forceinline__ void ph_gmlp_fast(Frame& F, LAS unsigned char* ldsb) {
    LAS float* st = (LAS float*)ldsb;
    LAS unsigned char* img0 = ldsb + 1024;
    const int tid = F.tid, lane = F.lane, wave = F.wave, hi = lane >> 5, li = lane & 15;
    const int cb = wave & 3, half = wave >> 2;
    const int tbA = half ? 1 : 0, tbB = half ? 2 : 3;
    const int nA = 2 * (tbA + 1), nB = 2 * (tbB + 1);
    const int tr_base = cb * GM_CB + (8 * hi + (li >> 2)) * 64 + (16 * ((lane >> 4) & 1) + 4 * (li & 3)) * 2;
    for (int ch = F.bid; ch < T / 128; ch += F.G) {
        const int t0 = ch * 128;
        attn_merge_chunk(F, t0);
        for (int i0 = 0; i0 < 16; i0 += 8) {
            f16x8 a[8], b[8];
#pragma unroll
            for (int i = 0; i < 8; ++i) { const h16* vp = F.h + (size_t)(t0 + wave * 16 + i0 + i) * NIN + C_V; a[i] = *(const f16x8*)(vp + 8 * lane); b[i] = *(const f16x8*)(vp + 512 + 8 * lane); }
#pragma unroll
            for (int i = 0; i < 8; ++i) {
                const int tl = wave * 16 + i0 + i;
                float s_ = 0.f;
#pragma unroll
                for (int j = 0; j < 8; ++j) s_ += (float)a[i][j] + (float)b[i][j];
                const float mean = wave_sum(s_) * (1.f / 1024.f);
                float qv = 0.f;
#pragma unroll
                for (int j = 0; j < 8; ++j) { const float da = (float)a[i][j] - mean, db = (float)b[i][j] - mean; qv += da * da + db * db; }
                const float rstd = 1.f / sqrtf(wave_sum(qv) * (1.f / 1024.f) + LN_EPS);
                if (lane == 0) { st[tl * 2] = mean; st[tl * 2 + 1] = rstd; }
            }
        }
        __syncthreads();
        gmlp_stage(F, img0, st, t0, 0);
        __syncthreads();
        for (int g = 0; g < 8; ++g) {
            LAS unsigned char* img = img0 + (g & 1) * GM_IMG;
            LAS unsigned char* outb = img0 + 2 * GM_IMG + (g & 1) * 32768;
            f16x8 uq[4];
#pragma unroll
            for (int i = 0; i < 4; ++i) { const int idx = tid + i * NTHREADS; uq[i] = *(const f16x8*)(F.h + (size_t)(t0 + (idx >> 4)) * NIN + C_U + g * 128 + 8 * (idx & 15)); }
            if (g < 7) gmlp_stage(F, img0 + ((g + 1) & 1) * GM_IMG, st, t0, g + 1);
            f32x16 DA, DB;
#pragma unroll
            for (int e = 0; e < 16; ++e) { DA[e] = 0.f; DB[e] = 0.f; }
            const h16* wa = F.Wc + (size_t)g * 16384 + (size_t)(32 * tbA + (lane & 31)) * 128 + 8 * hi;
            const h16* wb = F.Wc + (size_t)g * 16384 + (size_t)(32 * tbB + (lane & 31)) * 128 + 8 * hi;
#pragma unroll
            for (int ks = 0; ks < 8; ++ks) {
                if (ks < nB) {
                    const v4i16_t lo = __builtin_amdgcn_ds_read_tr16_b64_v4i16((LAS v4i16_t*)(img + tr_base + ks * 1024));
                    const v4i16_t hi4 = __builtin_amdgcn_ds_read_tr16_b64_v4i16((LAS v4i16_t*)(img + tr_base + ks * 1024 + 256));
                    typedef short s16x8 __attribute__((ext_vector_type(8)));
                    const s16x8 vv = (s16x8){lo[0], lo[1], lo[2], lo[3], hi4[0], hi4[1], hi4[2], hi4[3]};
                    const f16x8 af = __builtin_bit_cast(f16x8, vv);
                    const f16x8 bfB = *(const f16x8*)(wb + 16 * ks);
                    DB = MFMA32(af, bfB, DB);
                    if (ks < nA) { const f16x8 bfA = *(const f16x8*)(wa + 16 * ks); DA = MFMA32(af, bfA, DA); }
                }
            }
#pragma unroll
            for (int w2 = 0; w2 < 2; ++w2) {
                const int tb = w2 ? tbB : tbA; const int tt = 32 * tb + (lane & 31);
                const float sb = F.sp_b[g * 128 + tt];
#pragma unroll
                for (int r4 = 0; r4 < 4; ++r4) { f16x4 o;
#pragma unroll
                    for (int e = 0; e < 4; ++e) o[e] = (h16)((w2 ? DB[4 * r4 + e] : DA[4 * r4 + e]) + sb);
                    *(LAS f16x4*)(outb + tt * 256 + (((4 * cb + r4) ^ (tt & 15)) << 4) + 8 * hi) = o; }
            }
            __syncthreads();
#pragma unroll
            for (int i = 0; i < 4; ++i) {
                const int idx = tid + i * NTHREADS; const int tt = idx >> 4, cc = idx & 15;
                const f16x8 vm = *(const LAS f16x8*)(outb + tt * 256 + ((cc ^ (tt & 15)) << 4));
                const f16x8 uu = uq[i];
                f16x8 o;
#pragma unroll
                for (int e = 0; e < 8; ++e) o[e] = (h16)((float)uu[e] * (float)vm[e]);
                *(f16x8*)(F.z + (size_t)(t0 + tt) * DM + g * 128 + 8 * cc) = o;
            }
        }
        __syncthreads();
    }
}

__device__ __forceinline__ void ph_ln1(Frame& F) {
    const int gw = F.bid * NWAVES + F.wave, NGW = F.G * NWAVES, lane = F.lane;
    for (int m = gw; m < T; m += NGW) {
        const f32x4* rp = (const f32x4*)(F.out + (size_t)m * DM) + lane;
        f32x4 v[4]; float s = 0.f;
#pragma unroll
        for (int j = 0; j < 4; ++j) { v[j] = rp[64 * j]; s += (v[j][0] + v[j][1]) + (v[j][2] + v[j][3]); }
        const float mean = wave_sum(s) * (1.f / DM); float q = 0.f;
#pragma unroll
        for (int j = 0; j < 4; ++j) { v[j] = v[j] - mean; q += (v[j][0] * v[j][0] + v[j][1] * v[j][1]) + (v[j][2] * v[j][2] + v[j][3] * v[j][3]); }
        const float rstd = 1.f / sqrtf(wave_sum(q) * (1.f / DM) + LN_EPS);
#pragma unroll
        for (int j = 0; j < 4; ++j) { const int c = 4 * lane + 256 * j; const f32x4 g = *(const f32x4*)(F.ln1_g + c), b = *(const f32x4*)(F.ln1_b + c);
            const f32x4 o = v[j] * rstd * g + b; f16x4 w; w[0] = (h16)o[0]; w[1] = (h16)o[1]; w[2] = (h16)o[2]; w[3] = (h16)o[3];
            *(f16x4*)(F.x1 + (size_t)m * DM + c) = w; }
    }
}

template <int CTRL> __device__ __forceinline__ float dppf(float v) { const int b_ = __builtin_bit_cast(int, v); return __builtin_bit_cast(float, __builtin_amdgcn_update_dpp(b_, b_, CTRL, 0xF, 0xF, false)); }
__device__ __forceinline__ void ph_route1(Frame& F) {
    int* cnt = (int*)F.lds; int* base = cnt + 256; int* ebuf = base + 256; int* pbuf = ebuf + 1024;
    const int tid = F.tid, lane = F.lane, wave = F.wave;
    const f32x4 rb = *(const f32x4*)(F.r_b + 4 * lane);
    LAS unsigned char* cl = (LAS unsigned char*)F.lds + 16384 + wave * 4352;
    int cit = F.bid * NWAVES + wave; const int cstep = F.G * NWAVES;
    for (int ch = F.bid; ch < T / 128; ch += F.G) {
        if (tid < 256) cnt[tid] = 0;
        __syncthreads();
        auto route_token = [&](int i, const f32x4 lg) {
            const int tl = wave * 16 + i, t = ch * 128 + tl;
            float sc[4], mv[4];
#pragma unroll
            for (int j = 0; j < 4; ++j) { sc[j] = sigmoidf_(lg[j]); mv[j] = sc[j] + rb[j]; }
            float m1 = fmaxf(mv[0], mv[1]), m2 = fminf(mv[0], mv[1]);
#pragma unroll
            for (int j = 2; j < 4; ++j) { const float v = mv[j]; m2 = fmaxf(m2, fminf(m1, v)); m1 = fmaxf(m1, v); }
            { float o1 = dppf<0xB1>(m1), o2 = dppf<0xB1>(m2); m2 = fmaxf(fminf(m1, o1), fmaxf(m2, o2)); m1 = fmaxf(m1, o1); }
            { float o1 = dppf<0x4E>(m1), o2 = dppf<0x4E>(m2); m2 = fmaxf(fminf(m1, o1), fmaxf(m2, o2)); m1 = fmaxf(m1, o1); }
            { float o1 = dppf<0x141>(m1), o2 = dppf<0x141>(m2); m2 = fmaxf(fminf(m1, o1), fmaxf(m2, o2)); m1 = fmaxf(m1, o1); }
            const float gs = m1 + m2; const int grp = lane >> 3;
            int rank = 0;
#pragma unroll
            for (int g = 0; g < 8; ++g) { const float og = __builtin_bit_cast(float, __builtin_amdgcn_readlane(__builtin_bit_cast(int, gs), g * 8)); rank += (og > gs || (og == gs && g < grp)) ? 1 : 0; }
            const bool gsel = rank < 4;
#pragma unroll
            for (int j = 0; j < 4; ++j) mv[j] = gsel ? mv[j] : -INFINITY;
            int my_e = 0; float my_s = 0.f, ssum = 0.f;
            for (int k = 0; k < TOPK; ++k) {
                float bv = mv[0], bsc = sc[0]; int bi = 0;
#pragma unroll
                for (int j = 1; j < 4; ++j) if (mv[j] > bv) { bv = mv[j]; bi = j; bsc = sc[j]; }
                float r = bv;
                r = fmaxf(r, dppf<0xB1>(r)); r = fmaxf(r, dppf<0x4E>(r)); r = fmaxf(r, dppf<0x141>(r)); r = fmaxf(r, dppf<0x140>(r));
                const float r0 = __builtin_bit_cast(float, __builtin_amdgcn_readlane(__builtin_bit_cast(int, r), 0)), r1 = __builtin_bit_cast(float, __builtin_amdgcn_readlane(__builtin_bit_cast(int, r), 16));
                const float r2 = __builtin_bit_cast(float, __builtin_amdgcn_readlane(__builtin_bit_cast(int, r), 32)), r3 = __builtin_bit_cast(float, __builtin_amdgcn_readlane(__builtin_bit_cast(int, r), 48));
                const float M = fmaxf(fmaxf(r0, r1), fmaxf(r2, r3));
                const int L = __builtin_ctzll(__ballot(bv == M));
                const int be = 4 * L + __builtin_amdgcn_readlane(bi, L);
                const float sv = __builtin_bit_cast(float, __builtin_amdgcn_readlane(__builtin_bit_cast(int, bsc), L));
                if (lane == L) {
#pragma unroll
                    for (int j = 0; j < 4; ++j) if (bi == j) mv[j] = -INFINITY;
                }
                ssum += sv;
                if (lane == k) { my_e = be; my_s = sv; }
            }
            if (lane < TOPK) {
                const int lp = atomicAdd(&cnt[my_e], 1);
                ebuf[tl * 8 + lane] = my_e; pbuf[tl * 8 + lane] = lp;
                F.asg_e[t * 8 + lane] = my_e; F.gate[t * 8 + lane] = my_s / ssum * ROUTED_SCALE;
            }
        };
#define ROUTE_PAIRS(RIDE) \
        for (int i = 0; i < 16; i += 2) { \
            f32x4 v[1][16]; unsigned char* d[1]; int Nn[1]; const float* sp; \
            const int cit_ = (RIDE) ? cit : 0; conv_down_addr(F, cit_ >> 6, cit_ & 63, sp, Nn[0], d[0]); const float* p_ = sp + 4 * lane; \
            const f32x4 lga = *(const f32x4*)(F.logit + (size_t)(ch * 128 + wave * 16 + i) * NEXP + 4 * lane); \
            if (RIDE) { _Pragma("unroll") for (int q = 0; q < 8; ++q) v[0][q] = __builtin_nontemporal_load((const f32x4*)(p_ + (size_t)q * 1024)); } \
            route_token(i, lga); \
            const f32x4 lgb = *(const f32x4*)(F.logit + (size_t)(ch * 128 + wave * 16 + i + 1) * NEXP + 4 * lane); \
            if (RIDE) { _Pragma("unroll") for (int q = 8; q < 16; ++q) v[0][q] = __builtin_nontemporal_load((const f32x4*)(p_ + (size_t)q * 1024)); } \
            route_token(i + 1, lgb); \
            if (RIDE) { CONV_STORE(0) cit += cstep; } \
        }
        if (F.G == 256) { ROUTE_PAIRS(1) } else { ROUTE_PAIRS(0) }
#undef ROUTE_PAIRS
        __syncthreads();
        if (tid < 256) { const int c = cnt[tid]; base[tid] = c ? (int)__hip_atomic_fetch_add(F.ctl + CW_CNT + tid, (unsigned)c, __ATOMIC_RELAXED, __HIP_MEMORY_SCOPE_AGENT) : 0; }
        __syncthreads();
        for (int idx = tid; idx < 1024; idx += NTHREADS) F.asg_pos[ch * 1024 + idx] = base[ebuf[idx]] + pbuf[idx];
        __syncthreads();
    }
    for (; cit < CONV_N2; cit += cstep) {
        f32x4 v[1][16]; unsigned char* d[1]; int Nn[1]; const float* sp; conv_down_addr(F, cit >> 6, cit & 63, sp, Nn[0], d[0]); const float* p_ = sp + 4 * lane;
#pragma unroll
        for (int q = 0; q < 16; ++q) v[0][q] = __builtin_nontemporal_load((const f32x4*)(p_ + (size_t)q * 1024));
        CONV_STORE(0)
    }
}
__device__ __forceinline__ void ph_route2(Frame& F) {
    int* pstart = (int*)F.lds; int* cn = pstart + 257;
    const int tid = F.tid;
    if (tid < 256) cn[tid] = (int)__hip_atomic_load(F.ctl + CW_CNT + tid, __ATOMIC_RELAXED, __HIP_MEMORY_SCOPE_AGENT);
    __syncthreads();
    if (tid == 0) { int run = T; for (int e = 0; e < 256; ++e) { pstart[e] = run; run += (cn[e] + 255) & ~255; } pstart[256] = run; }
    __syncthreads();
    for (int ch = F.bid; ch < T / 128; ch += F.G) {
        for (int idx = tid; idx < 1024; idx += NTHREADS) { const int a = ch * 1024 + idx; const int e = F.asg_e[a], row = pstart[e] + F.asg_pos[a]; F.row_tok[row] = a >> 3; F.row_dst[row] = a; }
        if (tid < 128) { const int r = ch * 128 + tid; F.row_tok[r] = r; F.row_dst[r] = NASG + r; }
    }
    for (int e = F.bid; e < 256; e += F.G) {
        const int p0 = pstart[e], c = cn[e], p1 = pstart[e + 1];
        for (int row = p0 + c + tid; row < p1; row += NTHREADS) { F.row_tok[row] = 0; F.row_dst[row] = -1; }
        for (int tl = (p0 >> 8) + tid; tl < (p1 >> 8); tl += NTHREADS) F.tile_e[tl] = e;
    }
    if (F.bid == 0) {
        if (tid < 128) F.tile_e[tid] = 256;
        if (tid == 0) F.ctl[CW_NT] = (unsigned)(pstart[256] >> 8);
    }
}

__device__ __forceinline__ void ph_combine(Frame& F, LAS unsigned char* ldsb) {
    const int gw = F.bid * NWAVES + F.wave, NGW = F.G * NWAVES, lane = F.lane;
    for (int tb = gw * 2; tb < T; tb += NGW * 2) {
        f16x8 xr[2][2]; u32x4 yr[2][9]; float gt[2][8];
#pragma unroll
        for (int u = 0; u < 2; ++u) {
            const int t = tb + u;
            const h16* xp = F.x1 + (size_t)t * DM + 16 * lane; const unsigned char* yp = F.y + (size_t)t * 8 * DM + 16 * lane; const unsigned char* sp = F.y + (size_t)(NASG + t) * DM + 16 * lane;
            xr[u][0] = *(const f16x8*)xp; xr[u][1] = *(const f16x8*)(xp + 8);
#pragma unroll
            for (int k = 0; k < 8; ++k) yr[u][k] = __builtin_nontemporal_load((const u32x4*)(yp + (size_t)k * DM));
            yr[u][8] = __builtin_nontemporal_load((const u32x4*)sp);
#pragma unroll
            for (int k = 0; k < 8; ++k) gt[u][k] = F.gate[t * 8 + k] * Y_INV;
        }
#pragma unroll
        for (int u = 0; u < 2; ++u) {
            const int t = tb + u;
            float acc[16];
            __builtin_amdgcn_sched_barrier(0);
#pragma unroll
            for (int d = 0; d < 4; ++d) {
                const f32x2 s0 = __builtin_amdgcn_cvt_pk_f32_fp8((int)yr[u][8][d], false), s1 = __builtin_amdgcn_cvt_pk_f32_fp8((int)yr[u][8][d], true);
                float a0 = s0.x * Y_INV, a1 = s0.y * Y_INV, a2 = s1.x * Y_INV, a3 = s1.y * Y_INV;
#pragma unroll
                for (int k = 0; k < 8; ++k) { const f32x2 p0 = __builtin_amdgcn_cvt_pk_f32_fp8((int)yr[u][k][d], false), p1 = __builtin_amdgcn_cvt_pk_f32_fp8((int)yr[u][k][d], true);
                    a0 += gt[u][k] * p0.x; a1 += gt[u][k] * p0.y; a2 += gt[u][k] * p1.x; a3 += gt[u][k] * p1.y; }
                acc[4 * d] = a0; acc[4 * d + 1] = a1; acc[4 * d + 2] = a2; acc[4 * d + 3] = a3;
            }
#pragma unroll
            for (int e = 0; e < 8; ++e) { acc[e] += ALPHA * (float)xr[u][0][e]; acc[8 + e] += ALPHA * (float)xr[u][1][e]; }
            float s = 0.f;
#pragma unroll
            for (int j = 0; j < 16; ++j) s += acc[j];
            const float mean = wave_sum(s) * (1.f / DM); float q = 0.f;
#pragma unroll
            for (int j = 0; j < 16; ++j) { acc[j] -= mean; q += acc[j] * acc[j]; }
            const float rstd = 1.f / sqrtf(wave_sum(q) * (1.f / DM) + LN_EPS);
            LAS float* stg = (LAS float*)ldsb + F.wave * 1024;
#pragma unroll
            for (int qd = 0; qd < 4; ++qd) { f32x4 o;
#pragma unroll
                for (int e = 0; e < 4; ++e) o[e] = acc[4 * qd + e] * rstd;
                *(LAS f32x4*)(stg + 16 * lane + 4 * qd) = o; }
#pragma unroll
            for (int j = 0; j < 4; ++j) { const int c = 4 * lane + 256 * j; const f32x4 v = *(const LAS f32x4*)(stg + c);
                const f32x4 g = *(const f32x4*)(F.ln2_g + c), b = *(const f32x4*)(F.ln2_b + c);
                *(f32x4*)(F.out + (size_t)t * DM + c) = v * g + b; }
        }
    }
}

#if USE_FAST_ATTN
#define ATTN_PHASE ph_attn_fast(F, (LAS unsigned char*)lds)
#else
#define ATTN_PHASE ph_attn_simple(F)
#endif
#ifndef USE_FAST_GMLP
#define USE_FAST_GMLP 1
#endif
#if USE_FAST_GMLP
#define GMLP_PHASE ph_gmlp_fast(F, (LAS unsigned char*)lds)
#else
#define GMLP_PHASE ph_gmlp_simple(F)
#endif
#ifndef PROBE_MODE
#define PROBE_MODE 0
#endif
#ifndef DUP_MASK
#define DUP_MASK 0
#endif
#ifndef USE_FAST_GEMM
#define USE_FAST_GEMM 1
#endif
#if USE_FAST_GEMM
#define GEMM(P, E) fg::gemm_fast((LAS unsigned char*)lds, P, E)
#else
#define GEMM(P, E) gemm_simple(P, E)
#endif
enum { PH_PRO = 0, PH_INPROJ, PH_ATTN, PH_GMLP, PH_YB, PH_YA, PH_OUTW, PH_LN1, PH_ROUTER, PH_ROUTE1, PH_ROUTE2, PH_MOE1, PH_MOE2, PH_COMBINE, N_PHASES };

__global__ void __launch_bounds__(NTHREADS, 2) mk_fwd(Args args) {
    extern __shared__ __attribute__((aligned(16))) unsigned char lds[];
    Frame F;
    F.lds = lds; F.tid = threadIdx.x; F.lane = F.tid & 63; F.wave = __builtin_amdgcn_readfirstlane(F.tid >> 6); F.G = gridDim.x; F.bid = blockIdx.x;
    unsigned char* ws = args.ws;
    F.ctl = (unsigned*)(ws + WS_CTL);
    F.x = args.in[0]; F.in_w = args.in[1]; F.in_b = args.in[2]; F.gn_g = args.in[3]; F.gn_b = args.in[4]; F.sp_w = args.in[5]; F.sp_b = args.in[6]; F.pa_w = args.in[7];
    F.pb_w = args.in[8]; F.out_w = args.in[9]; F.ln1_g = args.in[10]; F.ln1_b = args.in[11]; F.r_w = args.in[12]; F.r_b = args.in[13]; F.e_wg = args.in[14]; F.e_wu = args.in[15];
    F.e_wd = args.in[16]; F.s_wg = args.in[17]; F.s_wu = args.in[18]; F.s_wd = args.in[19]; F.ln2_g = args.in[20]; F.ln2_b = args.in[21];
    F.out = args.out;
    F.WinT = (h16*)(ws + WS_WIN); F.WaT = (h16*)(ws + WS_WA); F.WoT = (h16*)(ws + WS_WO); F.WbT = (h16*)(ws + WS_WB); F.WrT = (h16*)(ws + WS_WR);
    F.W1t = ws + WS_W1T; F.W2t = ws + WS_W2T; F.x1f8 = ws + WS_X1F8; F.x16 = (h16*)(ws + WS_X16); F.x1 = (h16*)(ws + WS_X1); F.yb = (h16*)(ws + WS_YB); F.z = (h16*)(ws + WS_Z);
    F.merged = (h16*)(ws + WS_MERGED); F.h = (h16*)(ws + WS_H); F.hid = ws + WS_HID; F.y = (unsigned char*)(ws + WS_Y);
    F.logit = (float*)(ws + WS_LOGIT); F.gate = (float*)(ws + WS_GATE); F.lse = (float*)(ws + WS_LSE); F.ao = (h16*)(ws + WS_AO); F.Wc = (h16*)(ws + WS_WC);
    F.asg_e = (int*)(ws + WS_ASGE); F.asg_pos = (int*)(ws + WS_ASGP); F.row_tok = (int*)(ws + WS_ROWTOK); F.row_dst = (int*)(ws + WS_ROWDST); F.tile_e = (int*)(ws + WS_TILEE);

    volatile LAS unsigned* MISC = (volatile LAS unsigned*)((LAS unsigned char*)lds + (LDS_BYTES - 64));
    if (F.tid < 16) MISC[F.tid] = 0u;
    __syncthreads();
    XcdBarrier bar; bar.bar = F.ctl + CW_BAR; bar.x = 0; bar.st = nullptr;
    const int lo = args.ph_lo, hi = args.ph_hi;
    if (hi - lo > 1) bar = xcd_barrier_post(F.ctl + CW_BAR, MISC + 8);
#define IN(k) (lo <= (k) && (k) < hi)
#define REP(k) for (int rep_ = 0; rep_ < ((((DUP_MASK) >> (k)) & 1) ? 2 : 1); ++rep_)
#define SEAM(k) do { if (IN(k) && IN((k) + 1)) xcd_barrier(bar); } while (0)

    if (IN(PH_PRO)) REP(PH_PRO) { ph_prologue(F); } SEAM(PH_PRO);
    if (IN(PH_INPROJ)) REP(PH_INPROJ) { ProbDense P{F.x16, F.WinT, T, NIN, 1024, F.G, F.bid}; EpiInProj E{F.h, F.in_b, rep_ ? PROBE_MODE : 0}; GEMM(P, E);
        if (CONV_IN_ATTN && CONV_EARLY_DEQ > 0 && (long)12 * F.G + F.bid >= (long)(T / 256) * (NIN / 256) && F.G == 256) conv_experts_dyn(F, (LAS unsigned char*)lds + F.wave * 8448, CONV_EARLY_DEQ); } SEAM(PH_INPROJ);
    if (IN(PH_ATTN)) REP(PH_ATTN) { ATTN_PHASE; } SEAM(PH_ATTN);
    if (IN(PH_GMLP)) REP(PH_GMLP) { GMLP_PHASE; } SEAM(PH_GMLP);
    if (IN(PH_YB)) REP(PH_YB) { ProbDense P{F.yb, F.WbT, T, DM, 256, F.G, F.bid}; EpiYb E{F.merged, F.h}; GEMM(P, E); }
    if (IN(PH_YA)) REP(PH_YA) { ProbDense P{F.z, F.WaT, T, DM, 1024, F.G, F.bid}; EpiYa E{F.merged, F.h}; GEMM(P, E); } SEAM(PH_YA);
    if (IN(PH_OUTW)) {
        PanelStats st{(unsigned long long*)(ws + WS_XBUF), F.ctl + CW_PANEL, LN_EPS}; EpiLn1 E{F.x1, F.x1f8, F.x, F.ln1_g, F.ln1_b, st};
        const int nround = (512 + F.G - 1) / F.G;
        for (int ri = 0; ri < nround; ++ri) { ProbDenseR P; P.A = F.merged; P.Bt = F.WoT; P.M = T; P.N = DM; P.K = 1024; P.G = F.G; P.c = F.bid; P.ri = ri; GEMM(P, E); __syncthreads(); }
    } SEAM(PH_OUTW);
    const bool early_shared = (F.G == 256) && lo <= PH_ROUTER && PH_MOE1 < hi;
    if (IN(PH_ROUTER)) REP(PH_ROUTER) {
        if (early_shared && F.bid >= 128) { ProbMoe1S P{(const h16*)F.x1f8, (const h16*)(F.W1t + (size_t)256 * 512 * 1024), 512, 128, F.bid - 128}; EpiMoe1 E{F.hid}; GEMM(P, E); }
        else { ProbDense P{F.x1, F.WrT, T, NEXP, 1024, F.G, F.bid}; EpiLogit E{F.logit}; GEMM(P, E); } } SEAM(PH_ROUTER);
    if (IN(PH_ROUTE1)) REP(PH_ROUTE1) { ph_route1(F); } SEAM(PH_ROUTE1);
    if (IN(PH_ROUTE2)) REP(PH_ROUTE2) { ph_route2(F); } SEAM(PH_ROUTE2);
    if (IN(PH_MOE1)) REP(PH_MOE1) { const int NT = __builtin_amdgcn_readfirstlane((int)__hip_atomic_load(F.ctl + CW_NT, __ATOMIC_RELAXED, __HIP_MEMORY_SCOPE_AGENT));
        LAS int* te = (LAS int*)((LAS unsigned char*)lds + LDS_TILE_E); for (int i_ = F.tid; i_ < NT; i_ += NTHREADS) te[i_] = F.tile_e[i_]; __syncthreads();
        ProbMoe1 P{(const h16*)F.x1f8, (const h16*)F.W1t, F.row_tok, te, NT, 512, F.G, F.bid, early_shared ? 128 : 0}; EpiMoe1 E{F.hid}; GEMM(P, E); } SEAM(PH_MOE1);
    if (IN(PH_MOE2)) REP(PH_MOE2) { const int NT = __builtin_amdgcn_readfirstlane((int)__hip_atomic_load(F.ctl + CW_NT, __ATOMIC_RELAXED, __HIP_MEMORY_SCOPE_AGENT));
        LAS int* te = (LAS int*)((LAS unsigned char*)lds + LDS_TILE_E); for (int i_ = F.tid; i_ < NT; i_ += NTHREADS) te[i_] = F.tile_e[i_]; __syncthreads();
        ProbMoe2 P{(const h16*)F.hid, (const h16*)F.W2t, te, NT, 128, F.G, F.bid}; EpiMoe2 E{F.y, F.row_dst, PROBE_DUP2 ? PROBE_MODE : 0}; GEMM(P, E); } SEAM(PH_MOE2);
    if (IN(PH_COMBINE)) REP(PH_COMBINE) { ph_combine(F, (LAS unsigned char*)lds); }
#undef IN
#undef SEAM
}

extern "C" void kernel_launch(void* const* d_in, const int* in_sizes, int n_in, void* d_out, int out_size, void* d_ws, size_t ws_size, hipStream_t stream) {
    static int grid = 0;
    if (grid == 0) {
        if (n_in != 22 || in_sizes[0] != T * DM || out_size != T * DM || ws_size < WS_END) {
            fprintf(stderr, "kernel_launch: unexpected problem: n_in %d in0 %d out %d ws %zu (need %zu); nothing launched\n", n_in, n_in > 0 ? in_sizes[0] : -1, out_size, ws_size, (size_t)WS_END);
            grid = -1; return; }
        int dev = 0, cus = 0;
        if (hipGetDevice(&dev) != hipSuccess || hipDeviceGetAttribute(&cus, hipDeviceAttributeMultiprocessorCount, dev) != hipSuccess) { grid = -1; return; }
        if (hipFuncSetAttribute((const void*)mk_fwd, hipFuncAttributeMaxDynamicSharedMemorySize, LDS_BYTES) != hipSuccess) { fprintf(stderr, "kernel_launch: hipFuncSetAttribute failed\n"); grid = -1; return; }
        int per_cu = 0;
        if (hipOccupancyMaxActiveBlocksPerMultiprocessor(&per_cu, (const void*)mk_fwd, NTHREADS, LDS_BYTES) != hipSuccess || per_cu < 1) fprintf(stderr, "kernel_launch: occupancy query reports %d\n", per_cu);
        (void)hipGetLastError();
        grid = cus;
    }
    if (grid < 0) return;
    (void)hipMemsetAsync((char*)d_ws + WS_CTL, 0, CTL_ZERO_BYTES, stream);
    Args a{};
    for (int i = 0; i < 22; ++i) a.in[i] = (const float*)d_in[i];
    a.out = (float*)d_out; a.ws = (unsigned char*)d_ws;
    constexpr int NL = MK_N_LAUNCHES;
    for (int li = 0; li < NL; ++li) {
        a.ph_lo = (NL == 1) ? 0 : li; a.ph_hi = (NL == 1) ? (int)N_PHASES : li + 1;
        hipLaunchKernelGGL(mk_fwd, dim3(grid), dim3(NTHREADS), LDS_BYTES, stream, a);
    }
}
```
